# Optimizing an MI355X kernel written in HIP

```python
import jax
import jax.numpy as jnp
from jax import lax
import numpy as np

D_MODEL = 1024
BATCH = 16
SEQ = 2048
DEPTH = 2

Q_BLOCK = 128
LN_EPS = 1e-5
GLA_HEADS = 4
GLA_DK = 48
GLA_DV = 96
GLA_GATE_RANK = 16
GLA_TAU = 16.0
GLA_CHUNK = 64
DSA_HEADS = 5
DSA_DH = 64
DSA_LATENT = 128
IDX_HEADS = 8
IDX_DIM = 64
DSA_TOPK_MAX = 256
SB_HEADS = 5
SB_DH = 64
GLA_WIDTH = GLA_HEADS * GLA_DV
DSA_WIDTH = DSA_HEADS * DSA_DH
SB_WIDTH = SB_HEADS * SB_DH
MIX_WIDTH = GLA_WIDTH + DSA_WIDTH + SB_WIDTH
MEM_TOKENS = 256
MEM_HEADS = 4
MEM_DH = D_MODEL // MEM_HEADS
D_FF = 4 * D_MODEL
ALPHA = (2.0 * DEPTH) ** 0.25
BETA = (8.0 * DEPTH) ** -0.25
ALIBI_SLOPES = tuple(2.0 ** (-8.0 * (i + 1) / DSA_HEADS) for i in range(DSA_HEADS))
COL_SIZES = (
    GLA_HEADS * GLA_DK,
    GLA_HEADS * GLA_DK,
    GLA_WIDTH,
    GLA_GATE_RANK,
    GLA_WIDTH,
    DSA_WIDTH,
    DSA_DH,
    DSA_LATENT,
    IDX_HEADS * IDX_DIM,
    IDX_DIM,
    IDX_HEADS,
    SB_WIDTH,
    SB_WIDTH,
    SB_WIDTH,
)
P_IN = sum(COL_SIZES)
SPLIT_POINTS = tuple(int(v) for v in np.cumsum(COL_SIZES)[:-1])

kernel_name = 'hybrid_gla_dsa_stickbreaking_deepnorm'


def layer_norm(x, g, b):
    xf = x.astype(jnp.float32)
    mu = jnp.mean(xf, axis=-1, keepdims=True)
    var = jnp.mean(jnp.square(xf - mu), axis=-1, keepdims=True)
    return ((xf - mu) * lax.rsqrt(var + LN_EPS) * g + b).astype(x.dtype)


def gla_mixer(q, k, v, gate_lr, g, gate_w2, gate_b, norm_g):
    B, L = q.shape[0], q.shape[1]
    H, dk, dv, C = GLA_HEADS, GLA_DK, GLA_DV, GLA_CHUNK
    N = L // C
    f32 = jnp.float32
    log_a = jax.nn.log_sigmoid((gate_lr @ gate_w2 + gate_b).astype(f32)) / GLA_TAU
    log_a = log_a.reshape(B, N, C, H, dk)
    qf = q.astype(f32).reshape(B, N, C, H, dk) * (dk ** -0.5)
    kf = k.astype(f32).reshape(B, N, C, H, dk)
    vf = v.astype(f32).reshape(B, N, C, H, dv)
    bcum = jnp.cumsum(log_a, axis=2)
    b_last = bcum[:, :, -1]
    q_t = qf * jnp.exp(bcum)
    k_t = kf * jnp.exp(-bcum)
    k_end = kf * jnp.exp(b_last[:, :, None] - bcum)
    causal = jnp.tril(jnp.ones((C, C), dtype=bool))
    scores = jnp.einsum('bnchd,bnshd->bnhcs', q_t, k_t)
    scores = jnp.where(causal, scores, 0.0)
    o_intra = jnp.einsum('bnhcs,bnshv->bnchv', scores, vf)
    dS = jnp.einsum('bnchd,bnchv->nbhdv', k_end, vf)
    decay = jnp.exp(jnp.moveaxis(b_last, 1, 0))

    def step(S, inp):
        dS_n, dec_n = inp
        return dec_n[..., None] * S + dS_n, S

    S0 = jnp.zeros((B, H, dk, dv), f32)
    _, S_prev = lax.scan(step, S0, (dS, decay))
    o_inter = jnp.einsum('bnchd,nbhdv->bnchv', q_t, S_prev)
    o = (o_intra + o_inter).reshape(B, L, H, dv)
    o = o * lax.rsqrt(jnp.mean(jnp.square(o), axis=-1, keepdims=True) + LN_EPS) * norm_g
    o = o * jax.nn.silu(g.astype(f32))
    return o.reshape(B, L, H * dv).astype(q.dtype)


def dsa_mixer(q, k_sh, v_lat, iq, ik, iw, w_uv):
    B, L = q.shape[0], q.shape[1]
    f32 = jnp.float32
    topk = min(DSA_TOPK_MAX, L // 4)
    nb = L // Q_BLOCK
    key_pos = jnp.arange(L)
    kv = jnp.concatenate([k_sh, v_lat], axis=-1)
    slopes = jnp.asarray(ALIBI_SLOPES, f32)
    idx_scale = (IDX_HEADS ** -0.5) * (IDX_DIM ** -0.5)

    def block(i):
        t0 = i * Q_BLOCK
        qb = lax.dynamic_slice_in_dim(q, t0, Q_BLOCK, axis=1)
        iqb = lax.dynamic_slice_in_dim(iq, t0, Q_BLOCK, axis=1)
        iwb = lax.dynamic_slice_in_dim(iw, t0, Q_BLOCK, axis=1)
        qpos = t0 + jnp.arange(Q_BLOCK)
        causal = key_pos[None, :] <= qpos[:, None]
        rel = jax.nn.relu(jnp.einsum('bthd,bsd->bths', iqb, ik).astype(f32))
        isc = jnp.einsum('bths,bth->bts', rel, iwb.astype(f32)) * idx_scale
        isc = jnp.where(causal[None], isc, -jnp.inf)
        _, idx = lax.top_k(isc, topk)
        valid = idx <= qpos[None, :, None]
        sel = jax.vmap(lambda a, j: a[j])(kv, idx)
        k_sel = sel[..., :DSA_DH]
        v_sel = sel[..., DSA_DH:]
        dist = (qpos[None, :, None] - idx).astype(f32)
        s = jnp.einsum('bthd,btkd->bhtk', qb, k_sel).astype(f32) * (DSA_DH ** -0.5)
        s = s - slopes[None, :, None, None] * dist[:, None]
        s = jnp.where(valid[:, None], s, -jnp.inf)
        p = jax.nn.softmax(s, axis=-1).astype(v_sel.dtype)
        o_lat = jnp.einsum('bhtk,btkc->bthc', p, v_sel)
        o = jnp.einsum('bthc,hcd->bthd', o_lat, w_uv)
        return o.reshape(B, Q_BLOCK, DSA_WIDTH)

    out = lax.map(block, jnp.arange(nb))
    return jnp.moveaxis(out, 0, 1).reshape(B, L, DSA_WIDTH)


def sb_mixer(q, k, v):
    B, L = q.shape[0], q.shape[1]
    f32 = jnp.float32
    nb = L // Q_BLOCK
    key_pos = jnp.arange(L)

    def block(i):
        t0 = i * Q_BLOCK
        qb = lax.dynamic_slice_in_dim(q, t0, Q_BLOCK, axis=1)
        qpos = t0 + jnp.arange(Q_BLOCK)
        strict = key_pos[None, :] < qpos[:, None]
        z = jnp.einsum('bthd,bshd->bhts', qb, k).astype(f32) * (SB_DH ** -0.5)
        log_1mb = jnp.where(strict, jax.nn.log_sigmoid(-z), 0.0)
        rev = lax.cumsum(log_1mb, axis=3, reverse=True)
        suffix = jnp.concatenate([rev[..., 1:], jnp.zeros_like(rev[..., :1])], axis=-1)
        w = jnp.where(strict, jnp.exp(jax.nn.log_sigmoid(z) + suffix), 0.0)
        o = jnp.einsum('bhts,bshd->bthd', w.astype(v.dtype), v)
        return o.reshape(B, Q_BLOCK, SB_WIDTH)

    out = lax.map(block, jnp.arange(nb))
    return jnp.moveaxis(out, 0, 1).reshape(B, L, SB_WIDTH)


def hybrid_mixer(h, w_in, gate_w2, gate_b, gla_norm_g, w_uv, w_out):
    B, L = h.shape[0], h.shape[1]
    proj = h @ w_in
    (gq, gk, gv, glr, gg, dq, dk, dv, iq, ik, iw, sq, sk, sv) = jnp.split(proj, SPLIT_POINTS, axis=-1)
    o_gla = gla_mixer(gq.reshape(B, L, GLA_HEADS, GLA_DK), gk.reshape(B, L, GLA_HEADS, GLA_DK),
                      gv.reshape(B, L, GLA_HEADS, GLA_DV), glr, gg.reshape(B, L, GLA_HEADS, GLA_DV),
                      gate_w2, gate_b, gla_norm_g)
    o_dsa = dsa_mixer(dq.reshape(B, L, DSA_HEADS, DSA_DH), dk, dv,
                      iq.reshape(B, L, IDX_HEADS, IDX_DIM), ik, iw, w_uv)
    o_sb = sb_mixer(sq.reshape(B, L, SB_HEADS, SB_DH), sk.reshape(B, L, SB_HEADS, SB_DH),
                    sv.reshape(B, L, SB_HEADS, SB_DH))
    o = jnp.concatenate([o_gla, o_dsa, o_sb], axis=-1)
    return o @ w_out


def mem_attn(h, mem, w_q, w_kv, w_o):
    B, L = h.shape[0], h.shape[1]
    M = mem.shape[1]
    q = (h @ w_q).reshape(B, L, MEM_HEADS, MEM_DH)
    kv = mem @ w_kv
    k = kv[..., :D_MODEL].reshape(B, M, MEM_HEADS, MEM_DH)
    v = kv[..., D_MODEL:].reshape(B, M, MEM_HEADS, MEM_DH)
    s = jnp.einsum('blhd,bmhd->bhlm', q, k).astype(jnp.float32) * (MEM_DH ** -0.5)
    p = jax.nn.softmax(s, axis=-1).astype(v.dtype)
    o = jnp.einsum('bhlm,bmhd->blhd', p, v).reshape(B, L, D_MODEL)
    return o @ w_o


def sq_relu_mlp(h, w_up, b_up, w_down, b_down):
    u = jax.nn.relu(h @ w_up + b_up)
    return (u * u) @ w_down + b_down


def setup_inputs(seed: int = 0) -> dict:
    key = jax.random.key(seed)
    ks = jax.random.split(key, 26)
    f32 = jnp.float32

    def nrm(k, shape, scale):
        return jax.random.normal(k, shape, f32) * scale

    def gain(k, shape):
        return 1.0 + 0.02 * jax.random.normal(k, shape, f32)

    return {
        'x': nrm(ks[0], (BATCH, SEQ, D_MODEL), 1.0),
        'mem': nrm(ks[1], (BATCH, MEM_TOKENS, D_MODEL), 1.0),
        'ln_in_g': gain(ks[2], (D_MODEL,)),
        'ln_in_b': nrm(ks[3], (D_MODEL,), 0.02),
        'w_in': nrm(ks[4], (DEPTH, D_MODEL, P_IN), D_MODEL ** -0.5),
        'gla_gate_w2': nrm(ks[5], (DEPTH, GLA_GATE_RANK, GLA_HEADS * GLA_DK), GLA_GATE_RANK ** -0.5),
        'gla_gate_b': nrm(ks[6], (DEPTH, GLA_HEADS * GLA_DK), 0.1),
        'gla_norm_g': gain(ks[7], (DEPTH, GLA_DV)),
        'dsa_w_uv': nrm(ks[8], (DEPTH, DSA_HEADS, DSA_LATENT, DSA_DH), DSA_LATENT ** -0.5),
        'w_out': nrm(ks[9], (DEPTH, MIX_WIDTH, D_MODEL), BETA * MIX_WIDTH ** -0.5),
        'ln_mix_g': gain(ks[10], (DEPTH, D_MODEL)),
        'ln_mix_b': nrm(ks[11], (DEPTH, D_MODEL), 0.02),
        'w_mem_q': nrm(ks[12], (DEPTH, D_MODEL, D_MODEL), D_MODEL ** -0.5),
        'w_mem_kv': nrm(ks[13], (DEPTH, D_MODEL, 2 * D_MODEL), D_MODEL ** -0.5),
        'w_mem_o': nrm(ks[14], (DEPTH, D_MODEL, D_MODEL), BETA * D_MODEL ** -0.5),
        'ln_mem_g': gain(ks[15], (DEPTH, D_MODEL)),
        'ln_mem_b': nrm(ks[16], (DEPTH, D_MODEL), 0.02),
        'w_up': nrm(ks[17], (DEPTH, D_MODEL, D_FF), D_MODEL ** -0.5),
        'b_up': nrm(ks[18], (DEPTH, D_FF), 0.02),
        'w_down': nrm(ks[19], (DEPTH, D_FF, D_MODEL), BETA * D_FF ** -0.5),
        'b_down': nrm(ks[20], (DEPTH, D_MODEL), 0.02),
        'ln_ffn_g': gain(ks[21], (DEPTH, D_MODEL)),
        'ln_ffn_b': nrm(ks[22], (DEPTH, D_MODEL), 0.02),
    }


def reference(x, mem, ln_in_g, ln_in_b, w_in, gla_gate_w2, gla_gate_b, gla_norm_g, dsa_w_uv,
              w_out, ln_mix_g, ln_mix_b, w_mem_q, w_mem_kv, w_mem_o, ln_mem_g, ln_mem_b,
              w_up, b_up, w_down, b_down, ln_ffn_g, ln_ffn_b):
    h = layer_norm(x, ln_in_g, ln_in_b)
    for l in range(DEPTH):
        f = hybrid_mixer(h, w_in[l], gla_gate_w2[l], gla_gate_b[l], gla_norm_g[l], dsa_w_uv[l], w_out[l])
        h = layer_norm(ALPHA * h + f, ln_mix_g[l], ln_mix_b[l])
        f = mem_attn(h, mem, w_mem_q[l], w_mem_kv[l], w_mem_o[l])
        h = layer_norm(ALPHA * h + f, ln_mem_g[l], ln_mem_b[l])
        f = sq_relu_mlp(h, w_up[l], b_up[l], w_down[l], b_down[l])
        h = layer_norm(ALPHA * h + f, ln_ffn_g[l], ln_ffn_b[l])
    return h
```

```cpp
#include <hip/hip_runtime.h>
#include <hip/hip_cooperative_groups.h>
#include <cstdio>
#include <cstdint>
namespace pg8 {
#define PG8_LAS __attribute__((address_space(3)))
typedef unsigned short bf16_t;
typedef short bf16x8 __attribute__((ext_vector_type(8)));
typedef float f32x4 __attribute__((ext_vector_type(4)));
typedef unsigned u32x4 __attribute__((ext_vector_type(4)));
constexpr int BM = 256, BK = 64, HALF = 128, HTB = HALF * BK * 2  , STAGE_BYTES = 8 * HTB, NXCD = 8, WGM = 8;

__host__ __device__ __forceinline__ int lds_byte(int r, int c) { const int st = (r >> 4) * 2 + (c >> 5), rr = r & 15, cc = c & 31, ob = rr * 64 + cc * 2; return st * 1024 + (ob ^ (((ob >> 9) & 1) << 5)); }
__host__ __device__ __forceinline__ void stage_rc(int b, int& R, int& C) { const int st = b / 1024, sb = b % 1024, swz = sb ^ (((sb >> 9) & 1) << 5); R = (st >> 1) * 16 + swz / 64; C = (st & 1) * 32 + (swz % 64) / 2; }
__host__ __device__ __forceinline__ int perm32(int rho) { const int n = rho >> 4, i = rho & 15; return 8 * (i >> 2) + 4 * n + (i & 3); }

struct Unit { int pm, pn; };
struct Gemm { const bf16_t* A; const bf16_t* Bt; int M, N, K; };

struct StaticOrder {
    int nM, nN, nwg, G, c;
    __host__ __device__ void init(int M, int N, int G_, int c_) { nM = M / BM; nN = N / BM; nwg = nM * nN; G = G_; c = c_; }
    __host__ __device__ bool next(int i, Unit& u) const {
        const long L = (long)i * G + c; if (L >= nwg) return false;
        int wgid = (int)L; { const int q = nwg / NXCD, r = nwg % NXCD, xcd = wgid % NXCD, off = wgid / NXCD; wgid = (xcd < r ? xcd * (q + 1) : r * (q + 1) + (xcd - r) * q) + off; }
        const int nig = WGM * nN, gid = wgid / nig, fm = gid * WGM, gsz = (nM - fm) < WGM ? (nM - fm) : WGM;
        u.pm = fm + ((wgid % nig) % gsz); u.pn = (wgid % nig) / gsz; return true;
    }
    __device__ __forceinline__ void a_ready(const Unit&) const {}
    __device__ __forceinline__ void done(const Unit&) const {}
};

__device__ __forceinline__ unsigned cvt_pk_bf16(float lo, float hi) { unsigned r; asm volatile("v_cvt_pk_bf16_f32 %0, %1, %2" : "=v"(r) : "v"(lo), "v"(hi)); return r; }
typedef float f32x2 __attribute__((ext_vector_type(2)));
template <int ACT  > struct EpiBf16 {
    static constexpr bool PERM = true, AFTER_DRAIN = false; static_assert(ACT == 0 || ACT == 2, "EpiBf16: ACT is 0 (none) or 2 (squared relu)");
    bf16_t* O; int ldc; const float* bias; int split_cols; size_t split_stride; float scale0;
    __device__ __forceinline__ void operator()(const f32x4 (&acc)[2][2][4][2], const Unit& u, int wr, int wc, int fr, int fq) const {
        const int row0 = u.pm * BM + wr * 64 + fr; int colt = u.pn * BM; bf16_t* base = O;
        float sc = 1.f; if (split_cols) { const int t = colt / split_cols; base += (size_t)t * split_stride; colt -= t * split_cols; if (t == 0) sc = scale0; }
        const int col0 = colt + wc * 32 + 8 * fq, bcol0 = u.pn * BM + wc * 32 + 8 * fq;
        f32x4 bv[2][2];
#pragma unroll
        for (int bj = 0; bj < 2; ++bj)
#pragma unroll
            for (int n = 0; n < 2; ++n) bv[bj][n] = bias ? *(const f32x4*)(bias + bcol0 + bj * HALF + 4 * n) : (f32x4){0.f, 0.f, 0.f, 0.f};
#pragma unroll
        for (int ai = 0; ai < 2; ++ai)
#pragma unroll
            for (int m = 0; m < 4; ++m) { bf16_t* rowp = base + (size_t)(row0 + ai * HALF + m * 16) * ldc + col0;
#pragma unroll
                for (int bj = 0; bj < 2; ++bj) { f32x4 v0 = acc[ai][bj][m][0] + bv[bj][0], v1 = acc[ai][bj][m][1] + bv[bj][1];
                    if (ACT == 2) { const f32x4 z4 = (f32x4){0.f, 0.f, 0.f, 0.f}; v0 = __builtin_elementwise_max(v0, z4); v1 = __builtin_elementwise_max(v1, z4); v0 = v0 * v0; v1 = v1 * v1; }
                    v0 = v0 * sc; v1 = v1 * sc; u32x4 w; w.x = cvt_pk_bf16(v0[0], v0[1]); w.y = cvt_pk_bf16(v0[2], v0[3]); w.z = cvt_pk_bf16(v1[0], v1[1]); w.w = cvt_pk_bf16(v1[2], v1[3]);
                    *(u32x4*)(rowp + bj * HALF) = w; } }
    }
};

struct EpiY {
    static constexpr bool PERM = false, AFTER_DRAIN = false;
    float* Y; const bf16_t* R; int ldc; const float* bias; float alpha;
    __device__ __forceinline__ void operator()(const f32x4 (&acc)[2][2][4][2], const Unit& u, int wr, int wc, int fr, int fq) const {
        const int row0 = u.pm * BM + wr * 64 + fr, col0 = u.pn * BM + wc * 32 + 4 * fq;
#pragma unroll
        for (int ai = 0; ai < 2; ++ai)
#pragma unroll
            for (int m = 0; m < 4; ++m) { const size_t roff = (size_t)(row0 + ai * HALF + m * 16) * ldc;
#pragma unroll
                for (int bj = 0; bj < 2; ++bj)
#pragma unroll
                    for (int n = 0; n < 2; ++n) { const int col = col0 + bj * HALF + n * 16;
                        const f32x4 bv = bias ? *(const f32x4*)(bias + col) : (f32x4){0.f, 0.f, 0.f, 0.f};
                        const uint2 rr = *(const uint2*)(R + roff + col);
                        f32x4 rv; rv[0] = __uint_as_float(rr.x << 16); rv[1] = __uint_as_float(rr.x & 0xffff0000u); rv[2] = __uint_as_float(rr.y << 16); rv[3] = __uint_as_float(rr.y & 0xffff0000u);
                        *(f32x4*)(Y + roff + col) = acc[ai][bj][m][n] + bv + rv * alpha; } }
    }
};

struct PanelStats {
    unsigned* xbuf;
    unsigned* cnt;
    unsigned* tmo;
    int ntn; float eps;
    unsigned code;
    __device__ __forceinline__ bool run(const f32x4 (&v)[2][2][4][2], const Unit& u, int wr, int wc, int fr, int fq, PG8_LAS unsigned char* lds, int wid, int lane) const {
        typedef float f32x2v __attribute__((ext_vector_type(2)));
        PG8_LAS f32x2v* P = (PG8_LAS f32x2v*)lds;
        PG8_LAS f32x2v* S = (PG8_LAS f32x2v*)(lds + 8192);
        PG8_LAS unsigned* flag = (PG8_LAS unsigned*)(lds + 8192 + 2048);
#pragma unroll
        for (int ai = 0; ai < 2; ++ai)
#pragma unroll
            for (int m = 0; m < 4; ++m) {
                float s = 0.f;
#pragma unroll
                for (int bj = 0; bj < 2; ++bj)
#pragma unroll
                    for (int n = 0; n < 2; ++n) { const f32x4 x = v[ai][bj][m][n]; s += (x[0] + x[1]) + (x[2] + x[3]); }
                s += __shfl_xor(s, 16); s += __shfl_xor(s, 32);
                const float mw = s * (1.0f / 64.0f); float q = 0.f;
#pragma unroll
                for (int bj = 0; bj < 2; ++bj)
#pragma unroll
                    for (int n = 0; n < 2; ++n) { const f32x4 d = v[ai][bj][m][n] - mw; q += (d[0] * d[0] + d[1] * d[1]) + (d[2] * d[2] + d[3] * d[3]); }
                q += __shfl_xor(q, 16); q += __shfl_xor(q, 32);
                if (fq == 0) P[(ai * HALF + wr * 64 + m * 16 + fr) * 4 + wc] = (f32x2v){mw, q};
            }
        asm volatile("s_waitcnt lgkmcnt(0)" ::: "memory"); __builtin_amdgcn_s_barrier(); asm volatile("" ::: "memory");
#if defined(BROKEN_EXCHANGE_NO_WAIT)
#warning BROKEN CONTROL BUILD: the row-statistics exchange does not wait; results are wrong by design
        if (blockIdx.x >= 64) { const long long t0_ = clock64(); while (clock64() - t0_ < 60000) __builtin_amdgcn_s_sleep(8); }
#endif
        const int row = wid * 32 + (lane & 31);
        if (lane < 32) {
            const f32x2v a = P[row * 4 + 0], b = P[row * 4 + 1], c = P[row * 4 + 2], d = P[row * 4 + 3];
            const float mt = (a.x + b.x + c.x + d.x) * 0.25f;
            const float da = a.x - mt, db = b.x - mt, dc = c.x - mt, dd = d.x - mt;
            const float m2 = (a.y + b.y) + (c.y + d.y) + 64.0f * ((da * da + db * db) + (dc * dc + dd * dd));
            unsigned long long* slot = (unsigned long long*)xbuf + ((size_t)(u.pm * BM + row) * 4 + u.pn);
            __hip_atomic_store(slot, ((unsigned long long)__float_as_uint(m2) << 32) | __float_as_uint(mt), __ATOMIC_RELAXED, __HIP_MEMORY_SCOPE_AGENT);
        }
        asm volatile("s_waitcnt vmcnt(0)" ::: "memory");
        if (lane == 0) __hip_atomic_fetch_add(cnt + 64 * u.pm, 1u, __ATOMIC_RELAXED, __HIP_MEMORY_SCOPE_AGENT);
        if (wid == 0) {
            bool dead = false; const unsigned long long t0 = __builtin_amdgcn_s_memrealtime(); const unsigned want = 8u * (unsigned)ntn;
            for (;;) {
#if defined(BROKEN_EXCHANGE_NO_WAIT)
                break;
#endif
                if ((unsigned)__builtin_amdgcn_readfirstlane(__hip_atomic_load(cnt + 64 * u.pm, __ATOMIC_RELAXED, __HIP_MEMORY_SCOPE_AGENT)) >= want) break;
                if (__builtin_amdgcn_s_memrealtime() - t0 > 2000000ull) {
                    if (lane == 0) { unsigned expect = 0u; __hip_atomic_compare_exchange_strong(tmo + 1, &expect, code | (unsigned)(u.pm & 0xff), __ATOMIC_RELAXED, __ATOMIC_RELAXED, __HIP_MEMORY_SCOPE_AGENT);
                                     __hip_atomic_store(tmo, 1u, __ATOMIC_RELAXED, __HIP_MEMORY_SCOPE_AGENT); }
                    dead = true; break; }
                __builtin_amdgcn_s_sleep(2);
            }
            __builtin_amdgcn_fence(__ATOMIC_ACQUIRE, "agent");
            if (lane == 0) flag[0] = dead ? 1u : 0u;
        }
        asm volatile("s_waitcnt vmcnt(0) lgkmcnt(0)" ::: "memory"); __builtin_amdgcn_s_barrier(); asm volatile("" ::: "memory");
        const bool bad = flag[0] != 0u;
        if (lane < 32) {
            const unsigned long long* slot = (const unsigned long long*)xbuf + (size_t)(u.pm * BM + row) * 4; float mt[4], m2[4]; float ms = 0.f;
#pragma unroll
            for (int t = 0; t < 4; ++t) { if (t < ntn) { const unsigned long long w = __hip_atomic_load(slot + t, __ATOMIC_RELAXED, __HIP_MEMORY_SCOPE_AGENT); mt[t] = __uint_as_float((unsigned)w); m2[t] = __uint_as_float((unsigned)(w >> 32)); } else { mt[t] = 0.f; m2[t] = 0.f; } ms += mt[t]; }
            const float mean = ms / (float)ntn; float q = 0.f;
#pragma unroll
            for (int t = 0; t < 4; ++t) if (t < ntn) { const float dm = mt[t] - mean; q += m2[t] + 256.0f * dm * dm; }
            S[row] = (f32x2v){mean, 1.0f / sqrtf(q / (256.0f * (float)ntn) + eps)};
        }
        asm volatile("s_waitcnt lgkmcnt(0)" ::: "memory"); __builtin_amdgcn_s_barrier(); asm volatile("" ::: "memory");
        return bad;
    }
};
struct EpiLnRes {
    static constexpr bool PERM = false, AFTER_DRAIN = true;
    const float* base; float* out; int ldc; const float* bias; PanelStats st; unsigned poison;
    __device__ __forceinline__ void fused(f32x4 (&acc)[2][2][4][2], const Unit& u, int wr, int wc, int fr, int fq, PG8_LAS unsigned char* lds, int wid, int lane) const {
        typedef float f32x2v __attribute__((ext_vector_type(2)));
        const PG8_LAS f32x2v* S = (const PG8_LAS f32x2v*)(lds + 8192);
        const int col0 = u.pn * BM + wc * 32 + 4 * fq;
#pragma unroll
        for (int bj = 0; bj < 2; ++bj)
#pragma unroll
            for (int n = 0; n < 2; ++n) { const f32x4 bv = bias ? *(const f32x4*)(bias + col0 + bj * HALF + n * 16) : (f32x4){0.f, 0.f, 0.f, 0.f};
#pragma unroll
                for (int ai = 0; ai < 2; ++ai)
#pragma unroll
                    for (int m = 0; m < 4; ++m) acc[ai][bj][m][n] += bv; }
        f32x4 pre[4][2][2];
#pragma unroll
        for (int m = 0; m < 4; ++m) { const size_t off = (size_t)(u.pm * BM + wr * 64 + m * 16 + fr) * ldc + col0;
#pragma unroll
            for (int bj = 0; bj < 2; ++bj)
#pragma unroll
                for (int n = 0; n < 2; ++n) pre[m][bj][n] = *(const f32x4*)(base + off + bj * HALF + n * 16); }
        const bool bad = st.run(acc, u, wr, wc, fr, fq, lds, wid, lane) || poison != 0u;
        const float qnan = __builtin_nanf("");
#pragma unroll
        for (int ai = 0; ai < 2; ++ai)
#pragma unroll
            for (int m = 0; m < 4; ++m) { const int r = ai * HALF + wr * 64 + m * 16 + fr; const f32x2v sr = S[r]; const size_t off = (size_t)(u.pm * BM + r) * ldc + col0;
#pragma unroll
                for (int bj = 0; bj < 2; ++bj)
#pragma unroll
                    for (int n = 0; n < 2; ++n) { const f32x4 bs = ai == 0 ? pre[m][bj][n] : *(const f32x4*)(base + off + bj * HALF + n * 16); f32x4 o = bs + (acc[ai][bj][m][n] - sr.x) * sr.y;
                        if (bad) o = (f32x4){qnan, qnan, qnan, qnan}; *(f32x4*)(out + off + bj * HALF + n * 16) = o; }
                if (m & 1) asm volatile("" ::: "memory"); }
    }
};
struct EpiLnResLn {
    static constexpr bool PERM = false, AFTER_DRAIN = true;
    const float* base; float* out; bf16_t* xn; int ldc; const float* bias; PanelStats st1, st2; unsigned poison;
    __device__ __forceinline__ void fused(f32x4 (&acc)[2][2][4][2], const Unit& u, int wr, int wc, int fr, int fq, PG8_LAS unsigned char* lds, int wid, int lane) const {
        typedef float f32x2v __attribute__((ext_vector_type(2))); typedef unsigned u32x2v __attribute__((ext_vector_type(2)));
        const PG8_LAS f32x2v* S = (const PG8_LAS f32x2v*)(lds + 8192);
        const int col0 = u.pn * BM + wc * 32 + 4 * fq;
#pragma unroll
        for (int bj = 0; bj < 2; ++bj)
#pragma unroll
            for (int n = 0; n < 2; ++n) { const f32x4 bv = bias ? *(const f32x4*)(bias + col0 + bj * HALF + n * 16) : (f32x4){0.f, 0.f, 0.f, 0.f};
#pragma unroll
                for (int ai = 0; ai < 2; ++ai)
#pragma unroll
                    for (int m = 0; m < 4; ++m) acc[ai][bj][m][n] += bv; }
        bool bad = st1.run(acc, u, wr, wc, fr, fq, lds, wid, lane) || poison != 0u;
        const float qnan = __builtin_nanf("");
#pragma unroll
        for (int ai = 0; ai < 2; ++ai)
#pragma unroll
            for (int m = 0; m < 4; ++m) { const int r = ai * HALF + wr * 64 + m * 16 + fr; const f32x2v sr = S[r]; const size_t off = (size_t)(u.pm * BM + r) * ldc + col0;
#pragma unroll
                for (int bj = 0; bj < 2; ++bj)
#pragma unroll
                    for (int n = 0; n < 2; ++n) { const f32x4 bs = *(const f32x4*)(base + off + bj * HALF + n * 16); acc[ai][bj][m][n] = bs + (acc[ai][bj][m][n] - sr.x) * sr.y; }
                asm volatile("" : "+v"(acc[ai][0][m][0]), "+v"(acc[ai][0][m][1]), "+v"(acc[ai][1][m][0]), "+v"(acc[ai][1][m][1]));
                if (m & 1) asm volatile("" ::: "memory"); }
        const bool bad1 = bad;
        bad = st2.run(acc, u, wr, wc, fr, fq, lds, wid, lane) || bad;
#pragma unroll
        for (int ai = 0; ai < 2; ++ai)
#pragma unroll
            for (int m = 0; m < 4; ++m) { const int r = ai * HALF + wr * 64 + m * 16 + fr; const f32x2v sr = S[r]; const size_t off = (size_t)(u.pm * BM + r) * ldc + col0;
#pragma unroll
                for (int bj = 0; bj < 2; ++bj)
#pragma unroll
                    for (int n = 0; n < 2; ++n) { const f32x4 x1 = acc[ai][bj][m][n]; *(f32x4*)(out + off + bj * HALF + n * 16) = bad1 ? (f32x4){qnan, qnan, qnan, qnan} : x1;
                        const f32x4 o = (x1 - sr.x) * sr.y; u32x2v w; w.x = cvt_pk_bf16(o[0], o[1]); w.y = cvt_pk_bf16(o[2], o[3]);
                        if (bad) { w.x = 0x7fc07fc0u; w.y = 0x7fc07fc0u; } *(u32x2v*)(xn + off + bj * HALF + n * 16) = w; }
                asm volatile("" ::: "memory"); }
    }
};

template <class Epi, class Sched, bool ALIGN_EPI = false, bool SP2 = false>
__device__ __forceinline__ void gemm_phase(PG8_LAS unsigned char* lds, const Gemm g, const Sched& S, const Epi& E) {
    const int tid = threadIdx.x, wid = __builtin_amdgcn_readfirstlane(tid >> 6), lane = tid & 63, wr = wid >> 2, wc = wid & 3, fr = lane & 15, fq = lane >> 4;
    const int K = g.K, nt = K / BK;
    unsigned voffA[2], voffB[2];
#pragma unroll
    for (int i = 0; i < 2; ++i) { int R, C; stage_rc(tid * 16 + i * 8192, R, C); const int Rb = Epi::PERM ? ((R & ~31) + perm32(R & 31)) : R;
        voffA[i] = (unsigned)(R * K + C) * 2u; voffB[i] = (unsigned)(Rb * K + C) * 2u; }
    const size_t kstep = (size_t)(BK * 2);
    const size_t hstep = (size_t)HALF * K * 2;
    const size_t tstep = 2 * hstep;
    const unsigned ldsw = (unsigned)wid * 1024u;
    const int aoff = lds_byte(wr * 64 + fr, fq * 8), boff = lds_byte(wc * 32 + fr, fq * 8);
#define PG8_SA(b, h) (((b) * 2 + (h)) * HTB)
#define PG8_SB(b, h) ((4 + (b) * 2 + (h)) * HTB)
#define PG8_STAGE(bufoff, gbase, voff) do { _Pragma("unroll") for (int _i = 0; _i < 2; ++_i) \
        __builtin_amdgcn_global_load_lds((const unsigned*)((const char*)(gbase) + (voff)[_i]), (PG8_LAS unsigned*)(lds + (bufoff) + ldsw + _i * 8192), 16, 0, 0); } while (0)
#define PG8_LDA(dst, b, h) do { _Pragma("unroll") for (int m = 0; m < 4; ++m) _Pragma("unroll") for (int k = 0; k < 2; ++k) dst[m][k] = *(const PG8_LAS bf16x8*)(lds + PG8_SA(b, h) + aoff + m * 2048 + k * 1024); } while (0)
#define PG8_LDB(dst, b, h) do { _Pragma("unroll") for (int n = 0; n < 2; ++n) _Pragma("unroll") for (int k = 0; k < 2; ++k) dst[n][k] = *(const PG8_LAS bf16x8*)(lds + PG8_SB(b, h) + boff + n * 2048 + k * 1024); } while (0)
#define PG8_MMA(ai, bj, At, Bt) do { __builtin_amdgcn_s_setprio(1); _Pragma("unroll") for (int m = 0; m < 4; ++m) _Pragma("unroll") for (int n = 0; n < 2; ++n) _Pragma("unroll") for (int k = 0; k < 2; ++k) \
        acc[ai][bj][m][n] = __builtin_amdgcn_mfma_f32_16x16x32_bf16(Bt[n][k], At[m][k], acc[ai][bj][m][n], 0, 0, 0); __builtin_amdgcn_s_setprio(0); } while (0)
#define PG8_WAIT_V(n) asm volatile("s_waitcnt vmcnt(" #n ")" ::: "memory")
#define PG8_WAIT_L(n) asm volatile("s_waitcnt lgkmcnt(" #n ")" ::: "memory")
#define PG8_BAR __builtin_amdgcn_s_barrier()
#define PG8_SCHED __builtin_amdgcn_sched_barrier(0)
    Unit cur, nxt; int ui = 0;
    if (!S.next(0, cur)) return;
    f32x4 acc[2][2][4][2];
#pragma unroll
    for (int a = 0; a < 2; ++a)
#pragma unroll
        for (int b = 0; b < 2; ++b)
#pragma unroll
            for (int m = 0; m < 4; ++m)
#pragma unroll
                for (int n = 0; n < 2; ++n) acc[a][b][m][n] = (f32x4){0.f, 0.f, 0.f, 0.f};
    bf16x8 At[4][2], B0[2][2], B1[2][2];
    const char* cA = (const char*)g.A + (size_t)cur.pm * tstep; const char* cB = (const char*)g.Bt + (size_t)cur.pn * tstep;
    S.a_ready(cur);
    if constexpr (SP2) {
        PG8_STAGE(PG8_SB(0, 0), cB, voffB); PG8_STAGE(PG8_SB(0, 1), cB + hstep, voffB); PG8_STAGE(PG8_SA(0, 0), cA, voffA); PG8_STAGE(PG8_SA(0, 1), cA + hstep, voffA);
        if (wr == 1) PG8_BAR;
        PG8_WAIT_V(2); PG8_BAR;
        PG8_STAGE(PG8_SB(1, 0), cB + kstep, voffB); PG8_STAGE(PG8_SA(1, 0), cA + kstep, voffA); PG8_STAGE(PG8_SB(1, 1), cB + hstep + kstep, voffB);
        PG8_WAIT_V(6); PG8_BAR;
    } else {
        PG8_STAGE(PG8_SB(0, 0), cB, voffB); PG8_STAGE(PG8_SA(0, 0), cA, voffA); PG8_STAGE(PG8_SB(0, 1), cB + hstep, voffB); PG8_STAGE(PG8_SA(0, 1), cA + hstep, voffA);
        if (wr == 1) PG8_BAR;
        PG8_WAIT_V(4); PG8_BAR;
        PG8_STAGE(PG8_SB(1, 0), cB + kstep, voffB); PG8_STAGE(PG8_SA(1, 0), cA + kstep, voffA); PG8_STAGE(PG8_SB(1, 1), cB + hstep + kstep, voffB);
        PG8_WAIT_V(6); PG8_BAR;
    }
    for (;;) {
        const bool has_next = S.next(ui + 1, nxt);
        const char* nA = has_next ? (const char*)g.A + (size_t)nxt.pm * tstep : cA; const char* nB = has_next ? (const char*)g.Bt + (size_t)nxt.pn * tstep : cB;
        for (int t = 0; t < nt; t += 2) {
            const bool last = (t == nt - 2);
            const char* a1 = cA + (size_t)(t + 1) * kstep;
            const char* a2 = last ? nA : cA + (size_t)(t + 2) * kstep; const char* b2 = last ? nB : cB + (size_t)(t + 2) * kstep;
            const char* a3 = a2 + kstep; const char* b3 = b2 + kstep;
            if (last && has_next) S.a_ready(nxt);
            if constexpr (SP2) {
            PG8_LDB(B0, 0, 0); PG8_LDB(B1, 0, 1); PG8_SCHED; PG8_LDA(At, 0, 0); PG8_STAGE(PG8_SA(1, 1), a1 + hstep, voffA);
            PG8_WAIT_V(8); PG8_WAIT_L(0); PG8_BAR; PG8_MMA(0, 0, At, B0); PG8_MMA(0, 1, At, B1); PG8_BAR; PG8_SCHED;
            PG8_LDA(At, 0, 1); PG8_STAGE(PG8_SB(0, 0), b2, voffB); PG8_STAGE(PG8_SB(0, 1), b2 + hstep, voffB); PG8_STAGE(PG8_SA(0, 0), a2, voffA);
            PG8_WAIT_V(8); PG8_WAIT_L(0); PG8_BAR; PG8_MMA(1, 0, At, B0); PG8_MMA(1, 1, At, B1); PG8_BAR; PG8_SCHED;
            PG8_LDB(B0, 1, 0); PG8_LDB(B1, 1, 1); PG8_SCHED; PG8_LDA(At, 1, 0); PG8_STAGE(PG8_SA(0, 1), a2 + hstep, voffA);
            PG8_WAIT_V(8); PG8_WAIT_L(0); PG8_BAR; PG8_MMA(0, 0, At, B0); PG8_MMA(0, 1, At, B1); PG8_BAR; PG8_SCHED;
            PG8_LDA(At, 1, 1); PG8_STAGE(PG8_SB(1, 0), b3, voffB); PG8_STAGE(PG8_SB(1, 1), b3 + hstep, voffB); PG8_STAGE(PG8_SA(1, 0), a3, voffA);
            PG8_WAIT_V(8); PG8_WAIT_L(0); PG8_BAR; PG8_MMA(1, 0, At, B0); PG8_MMA(1, 1, At, B1); PG8_BAR; PG8_SCHED;
            } else {
            PG8_LDB(B0, 0, 0); PG8_SCHED; PG8_LDA(At, 0, 0); PG8_STAGE(PG8_SA(1, 1), a1 + hstep, voffA);
            PG8_WAIT_L(8); PG8_BAR; PG8_WAIT_L(0); PG8_MMA(0, 0, At, B0); PG8_BAR; PG8_SCHED;
            PG8_LDB(B1, 0, 1); PG8_STAGE(PG8_SB(0, 0), b2, voffB);
            PG8_BAR; PG8_WAIT_L(0); PG8_MMA(0, 1, At, B1); PG8_BAR;
            PG8_LDA(At, 0, 1); PG8_STAGE(PG8_SA(0, 0), a2, voffA);
            PG8_BAR; PG8_WAIT_L(0); PG8_MMA(1, 0, At, B0); PG8_BAR; PG8_SCHED;
            PG8_STAGE(PG8_SB(0, 1), b2 + hstep, voffB);
            PG8_WAIT_V(6); PG8_BAR; PG8_MMA(1, 1, At, B1); PG8_BAR;
            PG8_LDB(B0, 1, 0); PG8_SCHED; PG8_LDA(At, 1, 0); PG8_STAGE(PG8_SA(0, 1), a2 + hstep, voffA);
            PG8_WAIT_L(8); PG8_BAR; PG8_WAIT_L(0); PG8_MMA(0, 0, At, B0); PG8_BAR; PG8_SCHED;
            PG8_LDB(B1, 1, 1); PG8_STAGE(PG8_SB(1, 0), b3, voffB);
            PG8_BAR; PG8_WAIT_L(0); PG8_MMA(0, 1, At, B1); PG8_BAR;
            PG8_LDA(At, 1, 1); PG8_STAGE(PG8_SA(1, 0), a3, voffA);
            PG8_BAR; PG8_WAIT_L(0); PG8_MMA(1, 0, At, B0); PG8_BAR; PG8_SCHED;
            PG8_STAGE(PG8_SB(1, 1), b3 + hstep, voffB);
            PG8_WAIT_V(6); PG8_BAR; PG8_MMA(1, 1, At, B1); PG8_BAR;
            }
        }
        if constexpr (ALIGN_EPI) { if (wr == 0) PG8_BAR; }
        if constexpr (!Epi::AFTER_DRAIN) { E(acc, cur, wr, wc, fr, fq); S.done(cur); }
        if (!has_next) break;
#pragma unroll
        for (int a = 0; a < 2; ++a)
#pragma unroll
            for (int b = 0; b < 2; ++b)
#pragma unroll
                for (int m = 0; m < 4; ++m)
#pragma unroll
                    for (int n = 0; n < 2; ++n) acc[a][b][m][n] = (f32x4){0.f, 0.f, 0.f, 0.f};
        cur = nxt; cA = nA; cB = nB; ++ui;
        if constexpr (ALIGN_EPI) { if (wr == 1) PG8_BAR; }
    }
    PG8_WAIT_V(0);
    if constexpr (!ALIGN_EPI) { if (wr == 0) PG8_BAR; }
    PG8_BAR;
    if constexpr (Epi::AFTER_DRAIN) { E.fused(acc, cur, wr, wc, fr, fq, lds, wid, lane); S.done(cur); }
#undef PG8_SA
#undef PG8_SB
#undef PG8_STAGE
#undef PG8_LDA
#undef PG8_LDB
#undef PG8_MMA
#undef PG8_WAIT_V
#undef PG8_WAIT_L
#undef PG8_BAR
#undef PG8_SCHED
}
}
#define GAS __attribute__((address_space(1)))
#define LAS __attribute__((address_space(3)))
typedef unsigned short bf16;
typedef unsigned v4u __attribute__((ext_vector_type(4)));
typedef float f32x4 __attribute__((ext_vector_type(4)));
typedef short bf16x8 __attribute__((ext_vector_type(8)));
typedef GAS unsigned gu32;
typedef GAS unsigned long long gu64;
#define RLX_AGENT __ATOMIC_RELAXED, __HIP_MEMORY_SCOPE_AGENT
#define LDS_WAIT() asm volatile("s_waitcnt lgkmcnt(0)" ::: "memory")
#define VM_WAIT() asm volatile("s_waitcnt vmcnt(0)" ::: "memory")
__device__ __forceinline__ unsigned long long rt() { return __builtin_amdgcn_s_memrealtime(); }
__device__ __forceinline__ unsigned f2bf(float f) { unsigned u = __builtin_bit_cast(unsigned, f); return (u + 0x7fffu + ((u >> 16) & 1u)) >> 16; }
__device__ __forceinline__ unsigned pk2(float lo, float hi) { return f2bf(lo) | (f2bf(hi) << 16); }

#define XB_TMO      128
#define XB_XCNT(j)  (256  + 64 * (j))
#define XB_XSUB(j)  (1280 + 64 * (j))
#define XB_XGEN(j)  (2304 + 64 * (j))
#define XB_TOP      3328
#define XB_TOPGEN   3392
#define XCD_BAR_WORDS 3456
#define XB_SPIN_CAP (1u << 18)

__device__ __forceinline__ unsigned xb_ld(unsigned* p)              { return __hip_atomic_load(p, __ATOMIC_RELAXED, __HIP_MEMORY_SCOPE_AGENT); }
__device__ __forceinline__ unsigned xb_add(unsigned* p, unsigned v) { return __hip_atomic_fetch_add(p, v, __ATOMIC_RELAXED, __HIP_MEMORY_SCOPE_AGENT); }
__device__ __forceinline__ unsigned xb_xcc_id() { return (unsigned)__builtin_amdgcn_s_getreg((3 << 11) | 20) & 0xFu; }
#define XB_SPIN(cond, bar) do { unsigned _sp = 0; while (cond) { __builtin_amdgcn_s_sleep(1); \
    if ((++_sp & 255u) == 0u) { if (xb_ld(&(bar)[XB_TMO])) break; if (_sp > XB_SPIN_CAP) { atomicAdd(&(bar)[XB_TMO], 1u); break; } } } } while (0)

struct XcdBarrier {
    unsigned* bar; unsigned x;
    volatile LAS unsigned* st;
};

__device__ __forceinline__ XcdBarrier xcd_barrier_post(unsigned* bar, volatile LAS unsigned* st) {
    XcdBarrier b; b.bar = bar; b.x = xb_xcc_id(); b.st = st;
    if (threadIdx.x == 0) (void)xb_add(&bar[XB_XCNT(b.x)], 1u);
    return b;
}
__device__ __forceinline__ void xcd_barrier_complete(unsigned* bar, unsigned x, unsigned& nloc, unsigned& nx) {
    const unsigned G = gridDim.x * gridDim.y * gridDim.z;
    unsigned sum, cnt, mine, sp = 0u;
    for (;;) {
        sum = 0u; cnt = 0u; mine = 0u;
#pragma unroll
        for (unsigned j = 0; j < 16; ++j) { const unsigned c = xb_ld(&bar[XB_XCNT(j)]); sum += c; cnt += (c > 0u) ? 1u : 0u; mine = (j == x) ? c : mine; }
        if (sum == G) break;
        __builtin_amdgcn_s_sleep(1);
        if ((++sp & 255u) == 0u) { if (xb_ld(&bar[XB_TMO])) break; if (sp > XB_SPIN_CAP) { atomicAdd(&bar[XB_TMO], 1u); break; } }
    }
    nloc = mine > 0u ? mine : 1u; nx = cnt > 0u ? cnt : 1u;
}

__device__ __forceinline__ void xcd_barrier(const XcdBarrier& b) {
    asm volatile("s_waitcnt vmcnt(0)" ::: "memory");
    __syncthreads();
    if (threadIdx.x == 0) {
        unsigned* bar = b.bar;
        __builtin_amdgcn_s_waitcnt(0);
        unsigned nloc = b.st[0], nx = b.st[1];
        if (nloc == 0u) { xcd_barrier_complete(bar, b.x, nloc, nx); b.st[0] = nloc; b.st[1] = nx; }
        const unsigned old = xb_add(&bar[XB_XSUB(b.x)], 1u);
        const unsigned gen = old / nloc;
        if (old + 1u == (gen + 1u) * nloc) {
            __builtin_amdgcn_fence(__ATOMIC_RELEASE, "agent");
            asm volatile("s_waitcnt vmcnt(0)" ::: "memory");
            const unsigned og = xb_add(&bar[XB_TOP], 1u);
            const unsigned tg = og / nx;
            if (og + 1u == (tg + 1u) * nx) xb_add(&bar[XB_TOPGEN], 1u);
            else XB_SPIN(xb_ld(&bar[XB_TOPGEN]) == tg, bar);
            __builtin_amdgcn_fence(__ATOMIC_ACQUIRE, "agent");
            xb_add(&bar[XB_XGEN(b.x)], 1u);
            asm volatile("s_waitcnt vmcnt(0)" ::: "memory");
        } else {
            XB_SPIN(xb_ld(&bar[XB_XGEN(b.x)]) == gen, bar);
            __builtin_amdgcn_fence(__ATOMIC_ACQUIRE, "agent");
            asm volatile("s_waitcnt vmcnt(0)" ::: "memory");
        }
    }
    __syncthreads();
}

constexpr int D = 1024, BATCH = 16, SEQ = 2048, DEPTH = 2, M = BATCH * SEQ;
constexpr int PIN = 3224, PINP = 3328;
constexpr int C_GQ = 0, C_GK = 192, C_GV = 384, C_GLR = 768, C_GG = 784, C_DQ = 1168, C_DK = 1488, C_DV = 1552, C_IQ = 1680, C_IK = 2192, C_IW = 2256, C_SQ = 2264, C_SK = 2584, C_SV = 2904;
constexpr int O_GLA = 0, O_DSA = 384, O_SB = 704;
constexpr int MEMT = 256, MKV = BATCH * MEMT, FF = 4096;
constexpr float LN_EPS = 1e-5f;
constexpr float ALPHA = 1.4142135623730951f;
constexpr float IDX_SCALE = 0.04419417382415922f;
constexpr float GLA_QSCALE = 0.14433756729740643f;
constexpr int NWAVES = 8;
constexpr int LDS_BYTES = 147456;
constexpr int RING_OFF = 0, RING_BYTES = 131072, LDSCTL_OFF = RING_BYTES, MISC_OFF = LDSCTL_OFF + 320;

constexpr size_t MiB = 1u << 20;
constexpr size_t WS_CTL = 0, CTL_ZERO_BYTES = 1 * MiB;
constexpr size_t LW_IN = 0, LW_OUT = (size_t)PINP * D, LW_MQ = LW_OUT + (size_t)D * D, LW_MKV = LW_MQ + (size_t)D * D, LW_MO = LW_MKV + 2 * (size_t)D * D,
                 LW_UP = LW_MO + (size_t)D * D, LW_DN = LW_UP + (size_t)FF * D, LW_END = LW_DN + (size_t)D * FF;
constexpr size_t WS_W = 2 * MiB;
constexpr size_t WS_MEMB = 68 * MiB;
constexpr size_t WS_KVMEM = 76 * MiB;
constexpr size_t WS_H = 108 * MiB;
constexpr size_t WS_PROJ = 172 * MiB;
constexpr size_t WS_OBUF = 380 * MiB;
constexpr size_t WS_QMEM = 444 * MiB;
constexpr size_t WS_UBUF = 172 * MiB;
constexpr size_t WS_END = 508 * MiB;
static_assert(WS_W + 2 * LW_END * 2 <= WS_MEMB && WS_UBUF + (size_t)M * FF * 2 <= WS_QMEM, "ws map");
constexpr int CW_BAR = 4096;


__device__ __forceinline__ float bf2f(bf16 v) { return __uint_as_float((unsigned)v << 16); }
__device__ __forceinline__ float wave_sum(float v) {
#pragma unroll
    for (int o = 1; o < 64; o <<= 1) v += __shfl_xor(v, o);
    return v;
}
__device__ __forceinline__ float wave_max(float v) {
#pragma unroll
    for (int o = 1; o < 64; o <<= 1) v = fmaxf(v, __shfl_xor(v, o));
    return v;
}
__device__ __forceinline__ int wave_sum_i(int v) {
#pragma unroll
    for (int o = 1; o < 64; o <<= 1) v += __shfl_xor(v, o);
    return v;
}
__device__ __forceinline__ void unpack8(const uint4 u, float (&f)[8]) {
    f[0] = __uint_as_float(u.x << 16); f[1] = __uint_as_float(u.x & 0xffff0000u); f[2] = __uint_as_float(u.y << 16); f[3] = __uint_as_float(u.y & 0xffff0000u);
    f[4] = __uint_as_float(u.z << 16); f[5] = __uint_as_float(u.z & 0xffff0000u); f[6] = __uint_as_float(u.w << 16); f[7] = __uint_as_float(u.w & 0xffff0000u);
}

__global__ void k_transpose_w(const float* __restrict__ W, int K, int N, bf16* __restrict__ Wt) {
    __shared__ float t[32][33];
    const int n0 = blockIdx.x * 32, k0 = blockIdx.y * 32;
    for (int i = threadIdx.y; i < 32; i += 8) { const int k = k0 + i, n = n0 + threadIdx.x; t[i][threadIdx.x] = (n < N) ? W[(size_t)k * N + n] : 0.f; }
    __syncthreads();
    for (int i = threadIdx.y; i < 32; i += 8) { const int n = n0 + i, k = k0 + threadIdx.x; Wt[(size_t)n * K + k] = (bf16)f2bf(t[threadIdx.x][i]); }
}
__global__ void k_cvt_bf16(const float* __restrict__ src, bf16* __restrict__ dst, size_t n4) {
    const size_t i = (size_t)blockIdx.x * blockDim.x + threadIdx.x; if (i >= n4) return;
    const float4 v = ((const float4*)src)[i]; uint2 o; o.x = pk2(v.x, v.y); o.y = pk2(v.z, v.w); ((uint2*)dst)[i] = o;
}
__global__ void __launch_bounds__(256) k_ln_rows(const float* src, const float* __restrict__ g, const float* __restrict__ b, bf16* dstb, float* dstf, int rows) {
    const int row = (int)((blockIdx.x * (size_t)blockDim.x + threadIdx.x) >> 6), lane = threadIdx.x & 63;
    if (row >= rows) return;
    const float4* xr = (const float4*)(src + (size_t)row * D) + lane;
    float4 v[4]; float s = 0.f;
#pragma unroll
    for (int j = 0; j < 4; ++j) { v[j] = xr[64 * j]; s += (v[j].x + v[j].y) + (v[j].z + v[j].w); }
    const float mean = wave_sum(s) * (1.f / D); float s2 = 0.f;
#pragma unroll
    for (int j = 0; j < 4; ++j) { v[j].x -= mean; v[j].y -= mean; v[j].z -= mean; v[j].w -= mean; s2 += (v[j].x * v[j].x + v[j].y * v[j].y) + (v[j].z * v[j].z + v[j].w * v[j].w); }
    const float rstd = 1.f / sqrtf(wave_sum(s2) * (1.f / D) + LN_EPS);
#pragma unroll
    for (int j = 0; j < 4; ++j) {
        const float4 gg = ((const float4*)g)[lane + 64 * j], bb = ((const float4*)b)[lane + 64 * j];
        float4 y; y.x = v[j].x * rstd * gg.x + bb.x; y.y = v[j].y * rstd * gg.y + bb.y; y.z = v[j].z * rstd * gg.z + bb.z; y.w = v[j].w * rstd * gg.w + bb.w;
        uint2 o; o.x = pk2(y.x, y.y); o.y = pk2(y.z, y.w); ((uint2*)(dstb + (size_t)row * D))[lane + 64 * j] = o;
        if (dstf) ((float4*)(dstf + (size_t)row * D))[lane + 64 * j] = y;
    }
}
__global__ void k_gla_gate(const bf16* __restrict__ proj, const float* __restrict__ w2, const float* __restrict__ gb, float* __restrict__ gl) {
    const size_t idx = (size_t)blockIdx.x * 256 + threadIdx.x; if (idx >= (size_t)M * 192) return;
    const int t = (int)(idx / 192), j = (int)(idx % 192);
    float acc = 0.f;
#pragma unroll
    for (int r = 0; r < 16; ++r) acc += bf2f(proj[(size_t)t * PINP + C_GLR + r]) * w2[r * 192 + j];
    acc += gb[j];
    const float ls = fminf(acc, 0.f) - log1pf(expf(-fabsf(acc)));
    gl[idx] = ls * (1.f / 16.f);
}
__global__ void __launch_bounds__(128) k_gla_rec(const bf16* __restrict__ proj, const float* __restrict__ gl, float* __restrict__ oraw) {
    const int b = blockIdx.x >> 2, h = blockIdx.x & 3, tid = threadIdx.x;
    __shared__ float sq[32][48], sk[32][48], sa[32][48];
    float S[48];
#pragma unroll
    for (int d = 0; d < 48; ++d) S[d] = 0.f;
    for (int t0 = 0; t0 < SEQ; t0 += 32) {
        __syncthreads();
        for (int i = tid; i < 32 * 48; i += 128) { const int tt = i / 48, d = i % 48; const size_t row = (size_t)b * SEQ + t0 + tt;
            sq[tt][d] = bf2f(proj[row * PINP + C_GQ + h * 48 + d]) * GLA_QSCALE; sk[tt][d] = bf2f(proj[row * PINP + C_GK + h * 48 + d]); sa[tt][d] = expf(gl[row * 192 + h * 48 + d]); }
        __syncthreads();
        if (tid < 96) {
            for (int tt = 0; tt < 32; ++tt) { const size_t row = (size_t)b * SEQ + t0 + tt; const float v = bf2f(proj[row * PINP + C_GV + h * 96 + tid]); float o = 0.f;
#pragma unroll
                for (int d = 0; d < 48; ++d) { S[d] = sa[tt][d] * S[d] + sk[tt][d] * v; o += sq[tt][d] * S[d]; }
                oraw[row * 384 + h * 96 + tid] = o; }
        }
    }
}
__global__ void __launch_bounds__(256) k_gla_fin(const bf16* __restrict__ proj, const float* __restrict__ oraw, const float* __restrict__ ng, bf16* __restrict__ obuf) {
    const int gw = (int)((blockIdx.x * (size_t)256 + threadIdx.x) >> 6), lane = threadIdx.x & 63; if (gw >= M * 4) return;
    const int t = gw >> 2, h = gw & 3;
    const float o0 = oraw[(size_t)t * 384 + h * 96 + lane], o1 = lane < 32 ? oraw[(size_t)t * 384 + h * 96 + 64 + lane] : 0.f;
    const float ss = wave_sum(o0 * o0 + o1 * o1);
    const float r = 1.f / sqrtf(ss * (1.f / 96.f) + LN_EPS);
    { const float g = bf2f(proj[(size_t)t * PINP + C_GG + h * 96 + lane]); const float y = o0 * r * ng[lane] * (g / (1.f + expf(-g))); obuf[(size_t)t * D + O_GLA + h * 96 + lane] = (bf16)f2bf(y); }
    if (lane < 32) { const float g = bf2f(proj[(size_t)t * PINP + C_GG + h * 96 + 64 + lane]); const float y = o1 * r * ng[64 + lane] * (g / (1.f + expf(-g))); obuf[(size_t)t * D + O_GLA + h * 96 + 64 + lane] = (bf16)f2bf(y); }
}
__global__ void __launch_bounds__(256) k_sb(const bf16* __restrict__ proj, bf16* __restrict__ obuf) {
    const int wid = threadIdx.x >> 6, lane = threadIdx.x & 63;
    const int gw = blockIdx.x * 4 + wid; if (gw >= M * 5) return;
    const int tok = gw / 5, hd = gw % 5, b = tok / SEQ, t = tok % SEQ;
    float q[64];
    { const uint4* qr = (const uint4*)(proj + (size_t)tok * PINP + C_SQ + hd * 64);
#pragma unroll
      for (int i = 0; i < 8; ++i) { float f[8]; unpack8(qr[i], f);
#pragma unroll
          for (int e = 0; e < 8; ++e) q[8 * i + e] = f[e] * 0.125f; } }
    float o = 0.f, carry = 0.f;
    for (int base = t - 1; base >= 0; base -= 64) {
        const int s = base - lane; const bool valid = s >= 0;
        float z = 0.f;
        if (valid) { const uint4* kr = (const uint4*)(proj + ((size_t)b * SEQ + s) * PINP + C_SK + hd * 64);
#pragma unroll
            for (int i = 0; i < 8; ++i) { float f[8]; unpack8(kr[i], f);
#pragma unroll
                for (int e = 0; e < 8; ++e) z += q[8 * i + e] * f[e]; } }
        const float sp = fmaxf(z, 0.f) + log1pf(expf(-fabsf(z)));
        const float l = valid ? -sp : 0.f;
        float inc = l;
#pragma unroll
        for (int off = 1; off < 64; off <<= 1) { const float y = __shfl_up(inc, off); if (lane >= off) inc += y; }
        const float w = valid ? expf((z - sp) + (inc - l) + carry) : 0.f;
        const float tot = __shfl(inc, 63);
        const int nv = (base + 1 < 64) ? base + 1 : 64;
        for (int i = 0; i < nv; ++i) { const float wi = __shfl(w, i); o += wi * bf2f(proj[((size_t)b * SEQ + (base - i)) * PINP + C_SV + hd * 64 + lane]); }
        carry += tot;
        if (carry < -104.f) break;
    }
    obuf[(size_t)tok * D + O_SB + hd * 64 + lane] = (bf16)f2bf(o);
}
__global__ void __launch_bounds__(128) k_dsa(const bf16* __restrict__ proj, const float* __restrict__ wuv, bf16* __restrict__ obuf) {
    __shared__ float s_iq[2][512];
    __shared__ float s_q[2][320];
    __shared__ unsigned s_key[2][2048];
    __shared__ int s_idx[2][256];
    __shared__ float s_p[2][5][256];
    __shared__ float s_ol[2][5][128];
    const int wid = threadIdx.x >> 6, lane = threadIdx.x & 63;
    const int tok = blockIdx.x * 2 + wid, b = tok / SEQ, t = tok % SEQ;
    const bf16* prow = proj + (size_t)tok * PINP;
    for (int i = lane; i < 512; i += 64) s_iq[wid][i] = bf2f(prow[C_IQ + i]);
    for (int i = lane; i < 320; i += 64) s_q[wid][i] = bf2f(prow[C_DQ + i]);
    float iw[8];
#pragma unroll
    for (int h = 0; h < 8; ++h) iw[h] = bf2f(prow[C_IW + h]);
    __syncthreads();
    for (int j = 0; j < 32; ++j) {
        const int s = lane + 64 * j; unsigned kk = 0u;
        if (s <= t) {
            float kf[64];
            const uint4* kr = (const uint4*)(proj + ((size_t)b * SEQ + s) * PINP + C_IK);
#pragma unroll
            for (int i = 0; i < 8; ++i) { float f[8]; unpack8(kr[i], f);
#pragma unroll
                for (int e = 0; e < 8; ++e) kf[8 * i + e] = f[e]; }
            float isc = 0.f;
#pragma unroll
            for (int h = 0; h < 8; ++h) { float dot = 0.f;
#pragma unroll
                for (int d = 0; d < 64; ++d) dot += s_iq[wid][h * 64 + d] * kf[d];
                isc += fmaxf(dot, 0.f) * iw[h]; }
            isc *= IDX_SCALE;
            const unsigned u = __float_as_uint(isc); kk = (u & 0x80000000u) ? ~u : (u | 0x80000000u);
        }
        s_key[wid][s] = kk;
    }
    int nsel;
    const unsigned long long lt_mask = (lane == 0) ? 0ull : (~0ull >> (64 - lane));
    if (t + 1 <= 256) {
        nsel = t + 1;
        for (int i = lane; i < nsel; i += 64) s_idx[wid][i] = i;
    } else {
        unsigned prefix = 0u;
        for (int bit = 31; bit >= 0; --bit) {
            const unsigned cand = prefix | (1u << bit); int c = 0;
            for (int j = 0; j < 32; ++j) c += (s_key[wid][lane + 64 * j] >= cand) ? 1 : 0;
            c = wave_sum_i(c);
            if (c >= 256) prefix = cand;
        }
        int cg = 0;
        for (int j = 0; j < 32; ++j) cg += (s_key[wid][lane + 64 * j] > prefix) ? 1 : 0;
        cg = wave_sum_i(cg);
        const int need = 256 - cg;
        int base_sel = 0, base_tie = 0;
        for (int j = 0; j < 32; ++j) {
            const unsigned k = s_key[wid][lane + 64 * j]; const bool gt = k > prefix, eq = (k == prefix);
            const unsigned long long beq = __ballot(eq); const int tie_rank = base_tie + __popcll(beq & lt_mask);
            const bool sel = gt || (eq && tie_rank < need);
            const unsigned long long bs = __ballot(sel); const int pos = base_sel + __popcll(bs & lt_mask);
            if (sel) s_idx[wid][pos] = lane + 64 * j;
            base_sel += __popcll(bs); base_tie += __popcll(beq);
        }
        nsel = 256;
    }
    __syncthreads();
    const float slope[5] = {0.32987697769322355f, 0.1088188204120155f, 0.03589682359365735f, 0.011841535675862483f, 0.00390625f};
    float sc[5][4];
#pragma unroll
    for (int m = 0; m < 4; ++m) {
        const int kidx = lane + 64 * m;
        if (kidx < nsel) {
            const int si = s_idx[wid][kidx];
            float kf[64];
            const uint4* kr = (const uint4*)(proj + ((size_t)b * SEQ + si) * PINP + C_DK);
#pragma unroll
            for (int i = 0; i < 8; ++i) { float f[8]; unpack8(kr[i], f);
#pragma unroll
                for (int e = 0; e < 8; ++e) kf[8 * i + e] = f[e]; }
#pragma unroll
            for (int h = 0; h < 5; ++h) { float dot = 0.f;
#pragma unroll
                for (int d = 0; d < 64; ++d) dot += s_q[wid][h * 64 + d] * kf[d];
                sc[h][m] = dot * 0.125f - slope[h] * (float)(t - si); }
        } else {
#pragma unroll
            for (int h = 0; h < 5; ++h) sc[h][m] = -INFINITY;
        }
    }
#pragma unroll
    for (int h = 0; h < 5; ++h) {
        const float mx = wave_max(fmaxf(fmaxf(sc[h][0], sc[h][1]), fmaxf(sc[h][2], sc[h][3])));
        float e[4], se = 0.f;
#pragma unroll
        for (int m = 0; m < 4; ++m) { e[m] = (lane + 64 * m < nsel) ? expf(sc[h][m] - mx) : 0.f; se += e[m]; }
        const float inv = 1.f / wave_sum(se);
#pragma unroll
        for (int m = 0; m < 4; ++m) s_p[wid][h][lane + 64 * m] = e[m] * inv;
    }
    __syncthreads();
    float a0[5], a1[5];
#pragma unroll
    for (int h = 0; h < 5; ++h) { a0[h] = 0.f; a1[h] = 0.f; }
    for (int k = 0; k < nsel; ++k) {
        const int si = s_idx[wid][k]; const bf16* vr = proj + ((size_t)b * SEQ + si) * PINP + C_DV;
        const float v0 = bf2f(vr[lane]), v1 = bf2f(vr[lane + 64]);
#pragma unroll
        for (int h = 0; h < 5; ++h) { const float p = s_p[wid][h][k]; a0[h] += p * v0; a1[h] += p * v1; }
    }
#pragma unroll
    for (int h = 0; h < 5; ++h) { s_ol[wid][h][lane] = a0[h]; s_ol[wid][h][lane + 64] = a1[h]; }
    __syncthreads();
#pragma unroll
    for (int h = 0; h < 5; ++h) { float o = 0.f;
        for (int c = 0; c < 128; ++c) o += s_ol[wid][h][c] * wuv[(h * 128 + c) * 64 + lane];
        obuf[(size_t)tok * D + O_DSA + h * 64 + lane] = (bf16)f2bf(o); }
}
__global__ void __launch_bounds__(256) k_memattn(const bf16* __restrict__ qmem, const bf16* __restrict__ kv, bf16* __restrict__ obuf) {
    __shared__ float s_q[4][256], s_p[4][256];
    const int wid = threadIdx.x >> 6, lane = threadIdx.x & 63;
    const int gw = blockIdx.x * 4 + wid, tok = gw >> 2, hd = gw & 3, b = tok / SEQ;
#pragma unroll
    for (int i = 0; i < 4; ++i) s_q[wid][lane + 64 * i] = bf2f(qmem[(size_t)tok * D + hd * 256 + lane + 64 * i]);
    __syncthreads();
    float sc[4];
#pragma unroll
    for (int j = 0; j < 4; ++j) { const int m = lane + 64 * j; const uint4* kr = (const uint4*)(kv + ((size_t)b * MEMT + m) * 2048 + hd * 256); float dot = 0.f;
        for (int i = 0; i < 32; ++i) { float f[8]; unpack8(kr[i], f);
#pragma unroll
            for (int e = 0; e < 8; ++e) dot += s_q[wid][8 * i + e] * f[e]; }
        sc[j] = dot * 0.0625f; }
    const float mx = wave_max(fmaxf(fmaxf(sc[0], sc[1]), fmaxf(sc[2], sc[3])));
    float e[4], se = 0.f;
#pragma unroll
    for (int j = 0; j < 4; ++j) { e[j] = expf(sc[j] - mx); se += e[j]; }
    const float inv = 1.f / wave_sum(se);
#pragma unroll
    for (int j = 0; j < 4; ++j) s_p[wid][lane + 64 * j] = e[j] * inv;
    __syncthreads();
    float o[4] = {0.f, 0.f, 0.f, 0.f};
    for (int m = 0; m < MEMT; ++m) { const float p = s_p[wid][m]; const bf16* vr = kv + ((size_t)b * MEMT + m) * 2048 + 1024 + hd * 256;
#pragma unroll
        for (int i = 0; i < 4; ++i) o[i] += p * bf2f(vr[lane + 64 * i]); }
#pragma unroll
    for (int i = 0; i < 4; ++i) obuf[(size_t)tok * D + hd * 256 + lane + 64 * i] = (bf16)f2bf(o[i]);
}

struct Args { const float* in[23]; float* out; unsigned char* ws; int ph_lo, ph_hi; };
static_assert(sizeof(Args) == 23 * 8 + 8 + 8 + 8, "Args has no padding");

enum Phase { PH_KV0 = 0, PH_KV1 = 1, PH_L0 = 2, PH_PER_LAYER = 6, PH_END = PH_L0 + DEPTH * PH_PER_LAYER };

__global__ void __launch_bounds__(NWAVES * 64, 2) mk_fwd(Args args) {
    extern __shared__ __attribute__((aligned(16))) unsigned char lds[];
    LAS unsigned char* L = (LAS unsigned char*)lds;
    unsigned char* ws = args.ws;
    const int G = gridDim.x;
    bf16* Hb = (bf16*)(ws + WS_H); bf16* PROJ = (bf16*)(ws + WS_PROJ); bf16* OBUF = (bf16*)(ws + WS_OBUF); bf16* QMEM = (bf16*)(ws + WS_QMEM); bf16* UBUF = (bf16*)(ws + WS_UBUF);
    bf16* MEMB = (bf16*)(ws + WS_MEMB);
    { const int ph = args.ph_lo;
        if (ph < PH_L0) {
            const int l = ph; const bf16* Wl = (const bf16*)(ws + WS_W) + (size_t)l * LW_END;
            pg8::Gemm g{MEMB, Wl + LW_MKV, MKV, 2 * D, D}; pg8::StaticOrder S; S.init(MKV, 2 * D, G, (int)blockIdx.x);
            pg8::EpiBf16<0> E{(bf16*)(ws + WS_KVMEM) + (size_t)l * MKV * 2 * D, 2 * D, nullptr, 0, 0, 1.f};
            pg8::gemm_phase<pg8::EpiBf16<0>, pg8::StaticOrder, true, true>(L + RING_OFF, g, S, E);
        } else {
            const int l = (ph - PH_L0) / PH_PER_LAYER, k = (ph - PH_L0) % PH_PER_LAYER; const bf16* Wl = (const bf16*)(ws + WS_W) + (size_t)l * LW_END;
            if (k == 0) {
                pg8::Gemm g{Hb, Wl + LW_IN, M, PINP, D}; pg8::StaticOrder S; S.init(M, PINP, G, (int)blockIdx.x);
                pg8::EpiBf16<0> E{PROJ, PINP, nullptr, 0, 0, 1.f};
                pg8::gemm_phase<pg8::EpiBf16<0>, pg8::StaticOrder, true, true>(L + RING_OFF, g, S, E);
            } else if (k == 1) {
                pg8::Gemm g{OBUF, Wl + LW_OUT, M, D, D}; pg8::StaticOrder S; S.init(M, D, G, (int)blockIdx.x);
                pg8::EpiY E{args.out, Hb, D, nullptr, ALPHA};
                pg8::gemm_phase<pg8::EpiY, pg8::StaticOrder, true, true>(L + RING_OFF, g, S, E);
            } else if (k == 2) {
                pg8::Gemm g{Hb, Wl + LW_MQ, M, D, D}; pg8::StaticOrder S; S.init(M, D, G, (int)blockIdx.x);
                pg8::EpiBf16<0> E{QMEM, D, nullptr, 0, 0, 1.f};
                pg8::gemm_phase<pg8::EpiBf16<0>, pg8::StaticOrder, true, true>(L + RING_OFF, g, S, E);
            } else if (k == 3) {
                pg8::Gemm g{OBUF, Wl + LW_MO, M, D, D}; pg8::StaticOrder S; S.init(M, D, G, (int)blockIdx.x);
                pg8::EpiY E{args.out, Hb, D, nullptr, ALPHA};
                pg8::gemm_phase<pg8::EpiY, pg8::StaticOrder, true, true>(L + RING_OFF, g, S, E);
            } else if (k == 4) {
                pg8::Gemm g{Hb, Wl + LW_UP, M, FF, D}; pg8::StaticOrder S; S.init(M, FF, G, (int)blockIdx.x);
                pg8::EpiBf16<2> E{UBUF, FF, args.in[18] + (size_t)l * FF, 0, 0, 1.f};
                pg8::gemm_phase<pg8::EpiBf16<2>, pg8::StaticOrder, true, true>(L + RING_OFF, g, S, E);
            } else {
                pg8::Gemm g{UBUF, Wl + LW_DN, M, D, FF}; pg8::StaticOrder S; S.init(M, D, G, (int)blockIdx.x);
                pg8::EpiY E{args.out, Hb, D, args.in[20] + (size_t)l * D, ALPHA};
                pg8::gemm_phase<pg8::EpiY, pg8::StaticOrder, true, true>(L + RING_OFF, g, S, E);
            }
        }
    }
}

static void launch_mk(const Args& a0, int lo, int hi, int grid, hipStream_t stream) {
    Args a = a0; a.ph_lo = lo; a.ph_hi = hi;
    hipLaunchKernelGGL(mk_fwd, dim3(grid), dim3(NWAVES * 64), LDS_BYTES, stream, a);
}
static void transpose_w(const float* W, int K, int N, int Npad, bf16* Wt, hipStream_t stream) {
    hipLaunchKernelGGL(k_transpose_w, dim3(Npad / 32, K / 32), dim3(32, 8), 0, stream, W, K, N, Wt);
}
extern "C" void kernel_launch(void* const* d_in, const int* in_sizes, int n_in, void* d_out, int out_size, void* d_ws, size_t ws_size, hipStream_t stream) {
    static int grid = 0;
    if (grid == 0) {
        if (n_in != 23 || in_sizes[0] != M * D || out_size != M * D || ws_size < WS_END) { fprintf(stderr, "kernel_launch: unexpected shapes (n_in %d, in0 %d, out %d, ws %zu)\n", n_in, n_in > 0 ? in_sizes[0] : -1, out_size, ws_size); grid = -1; return; }
        int dev = 0, cus = 0;
        if (hipGetDevice(&dev) != hipSuccess || hipDeviceGetAttribute(&cus, hipDeviceAttributeMultiprocessorCount, dev) != hipSuccess) { grid = -1; return; }
        if (hipFuncSetAttribute((const void*)mk_fwd, hipFuncAttributeMaxDynamicSharedMemorySize, LDS_BYTES) != hipSuccess) { fprintf(stderr, "kernel_launch: hipFuncSetAttribute failed\n"); grid = -1; return; }
        grid = cus;
    }
    if (grid < 0) return;
    const float* const* in = (const float* const*)d_in;
    unsigned char* ws = (unsigned char*)d_ws; float* out = (float*)d_out;
    bf16* Hb = (bf16*)(ws + WS_H); bf16* PROJ = (bf16*)(ws + WS_PROJ); bf16* OBUF = (bf16*)(ws + WS_OBUF); bf16* QMEM = (bf16*)(ws + WS_QMEM);
    float* GLOG = out; float* ORAW = out + (size_t)8 * 1024 * 1024;
    Args a{}; for (int i = 0; i < 23; ++i) a.in[i] = in[i]; a.out = out; a.ws = ws;
    hipMemsetAsync(ws + WS_CTL, 0, CTL_ZERO_BYTES, stream);
    for (int l = 0; l < DEPTH; ++l) {
        bf16* Wl = (bf16*)(ws + WS_W) + (size_t)l * LW_END;
        transpose_w(in[4] + (size_t)l * D * PIN, D, PIN, PINP, Wl + LW_IN, stream);
        transpose_w(in[9] + (size_t)l * D * D, D, D, D, Wl + LW_OUT, stream);
        transpose_w(in[12] + (size_t)l * D * D, D, D, D, Wl + LW_MQ, stream);
        transpose_w(in[13] + (size_t)l * D * 2 * D, D, 2 * D, 2 * D, Wl + LW_MKV, stream);
        transpose_w(in[14] + (size_t)l * D * D, D, D, D, Wl + LW_MO, stream);
        transpose_w(in[17] + (size_t)l * D * FF, D, FF, FF, Wl + LW_UP, stream);
        transpose_w(in[19] + (size_t)l * FF * D, FF, D, D, Wl + LW_DN, stream);
    }
    hipLaunchKernelGGL(k_cvt_bf16, dim3((MKV * D / 4 + 255) / 256), dim3(256), 0, stream, in[1], (bf16*)(ws + WS_MEMB), (size_t)MKV * D / 4);
    hipLaunchKernelGGL(k_ln_rows, dim3(M / 4), dim3(256), 0, stream, in[0], in[2], in[3], Hb, (float*)nullptr, M);
    launch_mk(a, PH_KV0, PH_KV0 + 1, grid, stream);
    launch_mk(a, PH_KV1, PH_KV1 + 1, grid, stream);
    for (int l = 0; l < DEPTH; ++l) {
        const int p0 = PH_L0 + l * PH_PER_LAYER;
        launch_mk(a, p0 + 0, p0 + 1, grid, stream);
        hipLaunchKernelGGL(k_gla_gate, dim3(M * 192 / 256), dim3(256), 0, stream, PROJ, in[5] + (size_t)l * 16 * 192, in[6] + (size_t)l * 192, GLOG);
        hipLaunchKernelGGL(k_gla_rec, dim3(BATCH * 4), dim3(128), 0, stream, PROJ, GLOG, ORAW);
        hipLaunchKernelGGL(k_gla_fin, dim3(M * 4 / 4), dim3(256), 0, stream, PROJ, ORAW, in[7] + (size_t)l * 96, OBUF);
        hipLaunchKernelGGL(k_dsa, dim3(M / 2), dim3(128), 0, stream, PROJ, in[8] + (size_t)l * 5 * 128 * 64, OBUF);
        hipLaunchKernelGGL(k_sb, dim3(M * 5 / 4), dim3(256), 0, stream, PROJ, OBUF);
        launch_mk(a, p0 + 1, p0 + 2, grid, stream);
        hipLaunchKernelGGL(k_ln_rows, dim3(M / 4), dim3(256), 0, stream, out, in[10] + (size_t)l * D, in[11] + (size_t)l * D, Hb, (float*)nullptr, M);
        launch_mk(a, p0 + 2, p0 + 3, grid, stream);
        hipLaunchKernelGGL(k_memattn, dim3(M), dim3(256), 0, stream, QMEM, (const bf16*)(ws + WS_KVMEM) + (size_t)l * MKV * 2 * D, OBUF);
        launch_mk(a, p0 + 3, p0 + 4, grid, stream);
        hipLaunchKernelGGL(k_ln_rows, dim3(M / 4), dim3(256), 0, stream, out, in[15] + (size_t)l * D, in[16] + (size_t)l * D, Hb, (float*)nullptr, M);
        launch_mk(a, p0 + 4, p0 + 5, grid, stream);
        launch_mk(a, p0 + 5, p0 + 6, grid, stream);
        hipLaunchKernelGGL(k_ln_rows, dim3(M / 4), dim3(256), 0, stream, out, in[21] + (size_t)l * D, in[22] + (size_t)l * D, Hb, (l == DEPTH - 1) ? out : (float*)nullptr, M);
    }
}
```

```cpp
#include <hip/hip_runtime.h>
#include <hip/hip_cooperative_groups.h>
#include <cstdio>
#include <cstdint>
namespace pg8 {
#define PG8_LAS __attribute__((address_space(3)))
typedef unsigned short bf16_t;
typedef short bf16x8 __attribute__((ext_vector_type(8)));
typedef float f32x4 __attribute__((ext_vector_type(4)));
typedef unsigned u32x4 __attribute__((ext_vector_type(4)));
constexpr int BM = 256, BK = 64, HALF = 128, HTB = HALF * BK * 2  , STAGE_BYTES = 8 * HTB, NXCD = 8, WGM = 8;

__host__ __device__ __forceinline__ int lds_byte(int r, int c) { const int st = (r >> 4) * 2 + (c >> 5), rr = r & 15, cc = c & 31, ob = rr * 64 + cc * 2; return st * 1024 + (ob ^ (((ob >> 9) & 1) << 5)); }
__host__ __device__ __forceinline__ void stage_rc(int b, int& R, int& C) { const int st = b / 1024, sb = b % 1024, swz = sb ^ (((sb >> 9) & 1) << 5); R = (st >> 1) * 16 + swz / 64; C = (st & 1) * 32 + (swz % 64) / 2; }
__host__ __device__ __forceinline__ int perm32(int rho) { const int n = rho >> 4, i = rho & 15; return 8 * (i >> 2) + 4 * n + (i & 3); }

struct Unit { int pm, pn; };
struct Gemm { const bf16_t* A; const bf16_t* Bt; int M, N, K; };

struct StaticOrder {
    int nM, nN, nwg, G, c;
    __host__ __device__ void init(int M, int N, int G_, int c_) { nM = M / BM; nN = N / BM; nwg = nM * nN; G = G_; c = c_; }
    __host__ __device__ bool next(int i, Unit& u) const {
        const long L = (long)i * G + c; if (L >= nwg) return false;
        int wgid = (int)L; { const int q = nwg / NXCD, r = nwg % NXCD, xcd = wgid % NXCD, off = wgid / NXCD; wgid = (xcd < r ? xcd * (q + 1) : r * (q + 1) + (xcd - r) * q) + off; }
        const int nig = WGM * nN, gid = wgid / nig, fm = gid * WGM, gsz = (nM - fm) < WGM ? (nM - fm) : WGM;
        u.pm = fm + ((wgid % nig) % gsz); u.pn = (wgid % nig) / gsz; return true;
    }
    __device__ __forceinline__ void a_ready(const Unit&) const {}
    __device__ __forceinline__ void done(const Unit&) const {}
};

__device__ __forceinline__ unsigned cvt_pk_bf16(float lo, float hi) { unsigned r; asm volatile("v_cvt_pk_bf16_f32 %0, %1, %2" : "=v"(r) : "v"(lo), "v"(hi)); return r; }
typedef float f32x2 __attribute__((ext_vector_type(2)));
template <int ACT  > struct EpiBf16 {
    static constexpr bool PERM = true, AFTER_DRAIN = false; static_assert(ACT == 0 || ACT == 2, "EpiBf16: ACT is 0 (none) or 2 (squared relu)");
    bf16_t* O; int ldc; const float* bias; int split_cols; size_t split_stride; float scale0;
    __device__ __forceinline__ void operator()(const f32x4 (&acc)[2][2][4][2], const Unit& u, int wr, int wc, int fr, int fq) const {
        const int row0 = u.pm * BM + wr * 64 + fr; int colt = u.pn * BM; bf16_t* base = O;
        float sc = 1.f; if (split_cols) { const int t = colt / split_cols; base += (size_t)t * split_stride; colt -= t * split_cols; if (t == 0) sc = scale0; }
        const int col0 = colt + wc * 32 + 8 * fq, bcol0 = u.pn * BM + wc * 32 + 8 * fq;
        f32x4 bv[2][2];
#pragma unroll
        for (int bj = 0; bj < 2; ++bj)
#pragma unroll
            for (int n = 0; n < 2; ++n) bv[bj][n] = bias ? *(const f32x4*)(bias + bcol0 + bj * HALF + 4 * n) : (f32x4){0.f, 0.f, 0.f, 0.f};
#pragma unroll
        for (int ai = 0; ai < 2; ++ai)
#pragma unroll
            for (int m = 0; m < 4; ++m) { bf16_t* rowp = base + (size_t)(row0 + ai * HALF + m * 16) * ldc + col0;
#pragma unroll
                for (int bj = 0; bj < 2; ++bj) { f32x4 v0 = acc[ai][bj][m][0] + bv[bj][0], v1 = acc[ai][bj][m][1] + bv[bj][1];
                    if (ACT == 2) { const f32x4 z4 = (f32x4){0.f, 0.f, 0.f, 0.f}; v0 = __builtin_elementwise_max(v0, z4); v1 = __builtin_elementwise_max(v1, z4); v0 = v0 * v0; v1 = v1 * v1; }
                    v0 = v0 * sc; v1 = v1 * sc; u32x4 w; w.x = cvt_pk_bf16(v0[0], v0[1]); w.y = cvt_pk_bf16(v0[2], v0[3]); w.z = cvt_pk_bf16(v1[0], v1[1]); w.w = cvt_pk_bf16(v1[2], v1[3]);
                    *(u32x4*)(rowp + bj * HALF) = w; } }
    }
};

struct EpiY {
    static constexpr bool PERM = false, AFTER_DRAIN = false;
    float* Y; const bf16_t* R; int ldc; const float* bias; float alpha;
    __device__ __forceinline__ void operator()(const f32x4 (&acc)[2][2][4][2], const Unit& u, int wr, int wc, int fr, int fq) const {
        const int row0 = u.pm * BM + wr * 64 + fr, col0 = u.pn * BM + wc * 32 + 4 * fq;
#pragma unroll
        for (int ai = 0; ai < 2; ++ai)
#pragma unroll
            for (int m = 0; m < 4; ++m) { const size_t roff = (size_t)(row0 + ai * HALF + m * 16) * ldc;
#pragma unroll
                for (int bj = 0; bj < 2; ++bj)
#pragma unroll
                    for (int n = 0; n < 2; ++n) { const int col = col0 + bj * HALF + n * 16;
                        const f32x4 bv = bias ? *(const f32x4*)(bias + col) : (f32x4){0.f, 0.f, 0.f, 0.f};
                        const uint2 rr = *(const uint2*)(R + roff + col);
                        f32x4 rv; rv[0] = __uint_as_float(rr.x << 16); rv[1] = __uint_as_float(rr.x & 0xffff0000u); rv[2] = __uint_as_float(rr.y << 16); rv[3] = __uint_as_float(rr.y & 0xffff0000u);
                        *(f32x4*)(Y + roff + col) = acc[ai][bj][m][n] + bv + rv * alpha; } }
    }
};

struct PanelStats {
    unsigned* xbuf;
    unsigned* cnt;
    unsigned* tmo;
    int ntn; float eps;
    unsigned code;
    __device__ __forceinline__ bool run(const f32x4 (&v)[2][2][4][2], const Unit& u, int wr, int wc, int fr, int fq, PG8_LAS unsigned char* lds, int wid, int lane) const {
        typedef float f32x2v __attribute__((ext_vector_type(2)));
        PG8_LAS f32x2v* P = (PG8_LAS f32x2v*)lds;
        PG8_LAS f32x2v* S = (PG8_LAS f32x2v*)(lds + 8192);
        PG8_LAS unsigned* flag = (PG8_LAS unsigned*)(lds + 8192 + 2048);
#pragma unroll
        for (int ai = 0; ai < 2; ++ai)
#pragma unroll
            for (int m = 0; m < 4; ++m) {
                float s = 0.f;
#pragma unroll
                for (int bj = 0; bj < 2; ++bj)
#pragma unroll
                    for (int n = 0; n < 2; ++n) { const f32x4 x = v[ai][bj][m][n]; s += (x[0] + x[1]) + (x[2] + x[3]); }
                s += __shfl_xor(s, 16); s += __shfl_xor(s, 32);
                const float mw = s * (1.0f / 64.0f); float q = 0.f;
#pragma unroll
                for (int bj = 0; bj < 2; ++bj)
#pragma unroll
                    for (int n = 0; n < 2; ++n) { const f32x4 d = v[ai][bj][m][n] - mw; q += (d[0] * d[0] + d[1] * d[1]) + (d[2] * d[2] + d[3] * d[3]); }
                q += __shfl_xor(q, 16); q += __shfl_xor(q, 32);
                if (fq == 0) P[(ai * HALF + wr * 64 + m * 16 + fr) * 4 + wc] = (f32x2v){mw, q};
            }
        asm volatile("s_waitcnt lgkmcnt(0)" ::: "memory"); __builtin_amdgcn_s_barrier(); asm volatile("" ::: "memory");
#if defined(BROKEN_EXCHANGE_NO_WAIT)
#warning BROKEN CONTROL BUILD: the row-statistics exchange does not wait; results are wrong by design
        if (blockIdx.x >= 64) { const long long t0_ = clock64(); while (clock64() - t0_ < 60000) __builtin_amdgcn_s_sleep(8); }
#endif
        const int row = wid * 32 + (lane & 31);
        if (lane < 32) {
            const f32x2v a = P[row * 4 + 0], b = P[row * 4 + 1], c = P[row * 4 + 2], d = P[row * 4 + 3];
            const float mt = (a.x + b.x + c.x + d.x) * 0.25f;
            const float da = a.x - mt, db = b.x - mt, dc = c.x - mt, dd = d.x - mt;
            const float m2 = (a.y + b.y) + (c.y + d.y) + 64.0f * ((da * da + db * db) + (dc * dc + dd * dd));
            unsigned long long* slot = (unsigned long long*)xbuf + ((size_t)(u.pm * BM + row) * 4 + u.pn);
            __hip_atomic_store(slot, ((unsigned long long)__float_as_uint(m2) << 32) | __float_as_uint(mt), __ATOMIC_RELAXED, __HIP_MEMORY_SCOPE_AGENT);
        }
        asm volatile("s_waitcnt vmcnt(0)" ::: "memory");
        if (lane == 0) __hip_atomic_fetch_add(cnt + 64 * u.pm, 1u, __ATOMIC_RELAXED, __HIP_MEMORY_SCOPE_AGENT);
        if (wid == 0) {
            bool dead = false; const unsigned long long t0 = __builtin_amdgcn_s_memrealtime(); const unsigned want = 8u * (unsigned)ntn;
            for (;;) {
#if defined(BROKEN_EXCHANGE_NO_WAIT)
                break;
#endif
                if ((unsigned)__builtin_amdgcn_readfirstlane(__hip_atomic_load(cnt + 64 * u.pm, __ATOMIC_RELAXED, __HIP_MEMORY_SCOPE_AGENT)) >= want) break;
                if (__builtin_amdgcn_s_memrealtime() - t0 > 2000000ull) {
                    if (lane == 0) { unsigned expect = 0u; __hip_atomic_compare_exchange_strong(tmo + 1, &expect, code | (unsigned)(u.pm & 0xff), __ATOMIC_RELAXED, __ATOMIC_RELAXED, __HIP_MEMORY_SCOPE_AGENT);
                                     __hip_atomic_store(tmo, 1u, __ATOMIC_RELAXED, __HIP_MEMORY_SCOPE_AGENT); }
                    dead = true; break; }
                __builtin_amdgcn_s_sleep(2);
            }
            __builtin_amdgcn_fence(__ATOMIC_ACQUIRE, "agent");
            if (lane == 0) flag[0] = dead ? 1u : 0u;
        }
        asm volatile("s_waitcnt vmcnt(0) lgkmcnt(0)" ::: "memory"); __builtin_amdgcn_s_barrier(); asm volatile("" ::: "memory");
        const bool bad = flag[0] != 0u;
        if (lane < 32) {
            const unsigned long long* slot = (const unsigned long long*)xbuf + (size_t)(u.pm * BM + row) * 4; float mt[4], m2[4]; float ms = 0.f;
#pragma unroll
            for (int t = 0; t < 4; ++t) { if (t < ntn) { const unsigned long long w = __hip_atomic_load(slot + t, __ATOMIC_RELAXED, __HIP_MEMORY_SCOPE_AGENT); mt[t] = __uint_as_float((unsigned)w); m2[t] = __uint_as_float((unsigned)(w >> 32)); } else { mt[t] = 0.f; m2[t] = 0.f; } ms += mt[t]; }
            const float mean = ms / (float)ntn; float q = 0.f;
#pragma unroll
            for (int t = 0; t < 4; ++t) if (t < ntn) { const float dm = mt[t] - mean; q += m2[t] + 256.0f * dm * dm; }
            S[row] = (f32x2v){mean, 1.0f / sqrtf(q / (256.0f * (float)ntn) + eps)};
        }
        asm volatile("s_waitcnt lgkmcnt(0)" ::: "memory"); __builtin_amdgcn_s_barrier(); asm volatile("" ::: "memory");
        return bad;
    }
};
struct EpiLnRes {
    static constexpr bool PERM = false, AFTER_DRAIN = true;
    const float* base; float* out; int ldc; const float* bias; PanelStats st; unsigned poison;
    __device__ __forceinline__ void fused(f32x4 (&acc)[2][2][4][2], const Unit& u, int wr, int wc, int fr, int fq, PG8_LAS unsigned char* lds, int wid, int lane) const {
        typedef float f32x2v __attribute__((ext_vector_type(2)));
        const PG8_LAS f32x2v* S = (const PG8_LAS f32x2v*)(lds + 8192);
        const int col0 = u.pn * BM + wc * 32 + 4 * fq;
#pragma unroll
        for (int bj = 0; bj < 2; ++bj)
#pragma unroll
            for (int n = 0; n < 2; ++n) { const f32x4 bv = bias ? *(const f32x4*)(bias + col0 + bj * HALF + n * 16) : (f32x4){0.f, 0.f, 0.f, 0.f};
#pragma unroll
                for (int ai = 0; ai < 2; ++ai)
#pragma unroll
                    for (int m = 0; m < 4; ++m) acc[ai][bj][m][n] += bv; }
        f32x4 pre[4][2][2];
#pragma unroll
        for (int m = 0; m < 4; ++m) { const size_t off = (size_t)(u.pm * BM + wr * 64 + m * 16 + fr) * ldc + col0;
#pragma unroll
            for (int bj = 0; bj < 2; ++bj)
#pragma unroll
                for (int n = 0; n < 2; ++n) pre[m][bj][n] = *(const f32x4*)(base + off + bj * HALF + n * 16); }
        const bool bad = st.run(acc, u, wr, wc, fr, fq, lds, wid, lane) || poison != 0u;
        const float qnan = __builtin_nanf("");
#pragma unroll
        for (int ai = 0; ai < 2; ++ai)
#pragma unroll
            for (int m = 0; m < 4; ++m) { const int r = ai * HALF + wr * 64 + m * 16 + fr; const f32x2v sr = S[r]; const size_t off = (size_t)(u.pm * BM + r) * ldc + col0;
#pragma unroll
                for (int bj = 0; bj < 2; ++bj)
#pragma unroll
                    for (int n = 0; n < 2; ++n) { const f32x4 bs = ai == 0 ? pre[m][bj][n] : *(const f32x4*)(base + off + bj * HALF + n * 16); f32x4 o = bs + (acc[ai][bj][m][n] - sr.x) * sr.y;
                        if (bad) o = (f32x4){qnan, qnan, qnan, qnan}; *(f32x4*)(out + off + bj * HALF + n * 16) = o; }
                if (m & 1) asm volatile("" ::: "memory"); }
    }
};
struct EpiLnResLn {
    static constexpr bool PERM = false, AFTER_DRAIN = true;
    const float* base; float* out; bf16_t* xn; int ldc; const float* bias; PanelStats st1, st2; unsigned poison;
    __device__ __forceinline__ void fused(f32x4 (&acc)[2][2][4][2], const Unit& u, int wr, int wc, int fr, int fq, PG8_LAS unsigned char* lds, int wid, int lane) const {
        typedef float f32x2v __attribute__((ext_vector_type(2))); typedef unsigned u32x2v __attribute__((ext_vector_type(2)));
        const PG8_LAS f32x2v* S = (const PG8_LAS f32x2v*)(lds + 8192);
        const int col0 = u.pn * BM + wc * 32 + 4 * fq;
#pragma unroll
        for (int bj = 0; bj < 2; ++bj)
#pragma unroll
            for (int n = 0; n < 2; ++n) { const f32x4 bv = bias ? *(const f32x4*)(bias + col0 + bj * HALF + n * 16) : (f32x4){0.f, 0.f, 0.f, 0.f};
#pragma unroll
                for (int ai = 0; ai < 2; ++ai)
#pragma unroll
                    for (int m = 0; m < 4; ++m) acc[ai][bj][m][n] += bv; }
        bool bad = st1.run(acc, u, wr, wc, fr, fq, lds, wid, lane) || poison != 0u;
        const float qnan = __builtin_nanf("");
#pragma unroll
        for (int ai = 0; ai < 2; ++ai)
#pragma unroll
            for (int m = 0; m < 4; ++m) { const int r = ai * HALF + wr * 64 + m * 16 + fr; const f32x2v sr = S[r]; const size_t off = (size_t)(u.pm * BM + r) * ldc + col0;
#pragma unroll
                for (int bj = 0; bj < 2; ++bj)
#pragma unroll
                    for (int n = 0; n < 2; ++n) { const f32x4 bs = *(const f32x4*)(base + off + bj * HALF + n * 16); acc[ai][bj][m][n] = bs + (acc[ai][bj][m][n] - sr.x) * sr.y; }
                asm volatile("" : "+v"(acc[ai][0][m][0]), "+v"(acc[ai][0][m][1]), "+v"(acc[ai][1][m][0]), "+v"(acc[ai][1][m][1]));
                if (m & 1) asm volatile("" ::: "memory"); }
        const bool bad1 = bad;
        bad = st2.run(acc, u, wr, wc, fr, fq, lds, wid, lane) || bad;
#pragma unroll
        for (int ai = 0; ai < 2; ++ai)
#pragma unroll
            for (int m = 0; m < 4; ++m) { const int r = ai * HALF + wr * 64 + m * 16 + fr; const f32x2v sr = S[r]; const size_t off = (size_t)(u.pm * BM + r) * ldc + col0;
#pragma unroll
                for (int bj = 0; bj < 2; ++bj)
#pragma unroll
                    for (int n = 0; n < 2; ++n) { const f32x4 x1 = acc[ai][bj][m][n]; *(f32x4*)(out + off + bj * HALF + n * 16) = bad1 ? (f32x4){qnan, qnan, qnan, qnan} : x1;
                        const f32x4 o = (x1 - sr.x) * sr.y; u32x2v w; w.x = cvt_pk_bf16(o[0], o[1]); w.y = cvt_pk_bf16(o[2], o[3]);
                        if (bad) { w.x = 0x7fc07fc0u; w.y = 0x7fc07fc0u; } *(u32x2v*)(xn + off + bj * HALF + n * 16) = w; }
                asm volatile("" ::: "memory"); }
    }
};

template <class Epi, class Sched, bool ALIGN_EPI = false, bool SP2 = false>
__device__ __forceinline__ void gemm_phase(PG8_LAS unsigned char* lds, const Gemm g, const Sched& S, const Epi& E) {
    int tid_ = threadIdx.x; asm volatile("" : "+v"(tid_));
    const int tid = tid_, wid = __builtin_amdgcn_readfirstlane(tid >> 6), lane = tid & 63, wr = wid >> 2, wc = wid & 3, fr = lane & 15, fq = lane >> 4;
    const int K = g.K, nt = K / BK;
    unsigned voffA[2], voffB[2];
#pragma unroll
    for (int i = 0; i < 2; ++i) { int R, C; stage_rc(tid * 16 + i * 8192, R, C); const int Rb = Epi::PERM ? ((R & ~31) + perm32(R & 31)) : R;
        voffA[i] = (unsigned)(R * K + C) * 2u; voffB[i] = (unsigned)(Rb * K + C) * 2u; }
    const size_t kstep = (size_t)(BK * 2);
    const size_t hstep = (size_t)HALF * K * 2;
    const size_t tstep = 2 * hstep;
    const unsigned ldsw = (unsigned)wid * 1024u;
    const int aoff = lds_byte(wr * 64 + fr, fq * 8), boff = lds_byte(wc * 32 + fr, fq * 8);
#define PG8_SA(b, h) (((b) * 2 + (h)) * HTB)
#define PG8_SB(b, h) ((4 + (b) * 2 + (h)) * HTB)
#define PG8_STAGE(bufoff, gbase, voff) do { _Pragma("unroll") for (int _i = 0; _i < 2; ++_i) \
        __builtin_amdgcn_global_load_lds((const unsigned*)((const char*)(gbase) + (voff)[_i]), (PG8_LAS unsigned*)(lds + (bufoff) + ldsw + _i * 8192), 16, 0, 0); } while (0)
#define PG8_LDA(dst, b, h) do { _Pragma("unroll") for (int m = 0; m < 4; ++m) _Pragma("unroll") for (int k = 0; k < 2; ++k) dst[m][k] = *(const PG8_LAS bf16x8*)(lds + PG8_SA(b, h) + aoff + m * 2048 + k * 1024); } while (0)
#define PG8_LDB(dst, b, h) do { _Pragma("unroll") for (int n = 0; n < 2; ++n) _Pragma("unroll") for (int k = 0; k < 2; ++k) dst[n][k] = *(const PG8_LAS bf16x8*)(lds + PG8_SB(b, h) + boff + n * 2048 + k * 1024); } while (0)
#define PG8_MMA(ai, bj, At, Bt) do { __builtin_amdgcn_s_setprio(1); _Pragma("unroll") for (int m = 0; m < 4; ++m) _Pragma("unroll") for (int n = 0; n < 2; ++n) _Pragma("unroll") for (int k = 0; k < 2; ++k) \
        acc[ai][bj][m][n] = __builtin_amdgcn_mfma_f32_16x16x32_bf16(Bt[n][k], At[m][k], acc[ai][bj][m][n], 0, 0, 0); __builtin_amdgcn_s_setprio(0); } while (0)
#define PG8_WAIT_V(n) asm volatile("s_waitcnt vmcnt(" #n ")" ::: "memory")
#define PG8_WAIT_L(n) asm volatile("s_waitcnt lgkmcnt(" #n ")" ::: "memory")
#define PG8_BAR __builtin_amdgcn_s_barrier()
#define PG8_SCHED __builtin_amdgcn_sched_barrier(0)
    Unit cur, nxt; int ui = 0;
    if (!S.next(0, cur)) return;
    f32x4 acc[2][2][4][2];
#pragma unroll
    for (int a = 0; a < 2; ++a)
#pragma unroll
        for (int b = 0; b < 2; ++b)
#pragma unroll
            for (int m = 0; m < 4; ++m)
#pragma unroll
                for (int n = 0; n < 2; ++n) acc[a][b][m][n] = (f32x4){0.f, 0.f, 0.f, 0.f};
    bf16x8 At[4][2], B0[2][2], B1[2][2];
    const char* cA = (const char*)g.A + (size_t)cur.pm * tstep; const char* cB = (const char*)g.Bt + (size_t)cur.pn * tstep;
    S.a_ready(cur);
    if constexpr (SP2) {
        PG8_STAGE(PG8_SB(0, 0), cB, voffB); PG8_STAGE(PG8_SB(0, 1), cB + hstep, voffB); PG8_STAGE(PG8_SA(0, 0), cA, voffA); PG8_STAGE(PG8_SA(0, 1), cA + hstep, voffA);
        if (wr == 1) PG8_BAR;
        PG8_WAIT_V(2); PG8_BAR;
        PG8_STAGE(PG8_SB(1, 0), cB + kstep, voffB); PG8_STAGE(PG8_SA(1, 0), cA + kstep, voffA); PG8_STAGE(PG8_SB(1, 1), cB + hstep + kstep, voffB);
        PG8_WAIT_V(6); PG8_BAR;
    } else {
        PG8_STAGE(PG8_SB(0, 0), cB, voffB); PG8_STAGE(PG8_SA(0, 0), cA, voffA); PG8_STAGE(PG8_SB(0, 1), cB + hstep, voffB); PG8_STAGE(PG8_SA(0, 1), cA + hstep, voffA);
        if (wr == 1) PG8_BAR;
        PG8_WAIT_V(4); PG8_BAR;
        PG8_STAGE(PG8_SB(1, 0), cB + kstep, voffB); PG8_STAGE(PG8_SA(1, 0), cA + kstep, voffA); PG8_STAGE(PG8_SB(1, 1), cB + hstep + kstep, voffB);
        PG8_WAIT_V(6); PG8_BAR;
    }
    for (;;) {
        const bool has_next = S.next(ui + 1, nxt);
        const char* nA = has_next ? (const char*)g.A + (size_t)nxt.pm * tstep : cA; const char* nB = has_next ? (const char*)g.Bt + (size_t)nxt.pn * tstep : cB;
        for (int t = 0; t < nt; t += 2) {
            const bool last = (t == nt - 2);
            const char* a1 = cA + (size_t)(t + 1) * kstep;
            const char* a2 = last ? nA : cA + (size_t)(t + 2) * kstep; const char* b2 = last ? nB : cB + (size_t)(t + 2) * kstep;
            const char* a3 = a2 + kstep; const char* b3 = b2 + kstep;
            if (last && has_next) S.a_ready(nxt);
            if constexpr (SP2) {
            PG8_LDB(B0, 0, 0); PG8_LDB(B1, 0, 1); PG8_SCHED; PG8_LDA(At, 0, 0); PG8_STAGE(PG8_SA(1, 1), a1 + hstep, voffA);
            PG8_WAIT_V(8); PG8_WAIT_L(0); PG8_BAR; PG8_MMA(0, 0, At, B0); PG8_MMA(0, 1, At, B1); PG8_BAR; PG8_SCHED;
            PG8_LDA(At, 0, 1); PG8_STAGE(PG8_SB(0, 0), b2, voffB); PG8_STAGE(PG8_SB(0, 1), b2 + hstep, voffB); PG8_STAGE(PG8_SA(0, 0), a2, voffA);
            PG8_WAIT_V(8); PG8_WAIT_L(0); PG8_BAR; PG8_MMA(1, 0, At, B0); PG8_MMA(1, 1, At, B1); PG8_BAR; PG8_SCHED;
            PG8_LDB(B0, 1, 0); PG8_LDB(B1, 1, 1); PG8_SCHED; PG8_LDA(At, 1, 0); PG8_STAGE(PG8_SA(0, 1), a2 + hstep, voffA);
            PG8_WAIT_V(8); PG8_WAIT_L(0); PG8_BAR; PG8_MMA(0, 0, At, B0); PG8_MMA(0, 1, At, B1); PG8_BAR; PG8_SCHED;
            PG8_LDA(At, 1, 1); PG8_STAGE(PG8_SB(1, 0), b3, voffB); PG8_STAGE(PG8_SB(1, 1), b3 + hstep, voffB); PG8_STAGE(PG8_SA(1, 0), a3, voffA);
            PG8_WAIT_V(8); PG8_WAIT_L(0); PG8_BAR; PG8_MMA(1, 0, At, B0); PG8_MMA(1, 1, At, B1); PG8_BAR; PG8_SCHED;
            } else {
            PG8_LDB(B0, 0, 0); PG8_SCHED; PG8_LDA(At, 0, 0); PG8_STAGE(PG8_SA(1, 1), a1 + hstep, voffA);
            PG8_WAIT_L(8); PG8_BAR; PG8_WAIT_L(0); PG8_MMA(0, 0, At, B0); PG8_BAR; PG8_SCHED;
            PG8_LDB(B1, 0, 1); PG8_STAGE(PG8_SB(0, 0), b2, voffB);
            PG8_BAR; PG8_WAIT_L(0); PG8_MMA(0, 1, At, B1); PG8_BAR;
            PG8_LDA(At, 0, 1); PG8_STAGE(PG8_SA(0, 0), a2, voffA);
            PG8_BAR; PG8_WAIT_L(0); PG8_MMA(1, 0, At, B0); PG8_BAR; PG8_SCHED;
            PG8_STAGE(PG8_SB(0, 1), b2 + hstep, voffB);
            PG8_WAIT_V(6); PG8_BAR; PG8_MMA(1, 1, At, B1); PG8_BAR;
            PG8_LDB(B0, 1, 0); PG8_SCHED; PG8_LDA(At, 1, 0); PG8_STAGE(PG8_SA(0, 1), a2 + hstep, voffA);
            PG8_WAIT_L(8); PG8_BAR; PG8_WAIT_L(0); PG8_MMA(0, 0, At, B0); PG8_BAR; PG8_SCHED;
            PG8_LDB(B1, 1, 1); PG8_STAGE(PG8_SB(1, 0), b3, voffB);
            PG8_BAR; PG8_WAIT_L(0); PG8_MMA(0, 1, At, B1); PG8_BAR;
            PG8_LDA(At, 1, 1); PG8_STAGE(PG8_SA(1, 0), a3, voffA);
            PG8_BAR; PG8_WAIT_L(0); PG8_MMA(1, 0, At, B0); PG8_BAR; PG8_SCHED;
            PG8_STAGE(PG8_SB(1, 1), b3 + hstep, voffB);
            PG8_WAIT_V(6); PG8_BAR; PG8_MMA(1, 1, At, B1); PG8_BAR;
            }
        }
        if constexpr (ALIGN_EPI) { if (wr == 0) PG8_BAR; }
        if constexpr (!Epi::AFTER_DRAIN) { E(acc, cur, wr, wc, fr, fq); S.done(cur); }
        if (!has_next) break;
#pragma unroll
        for (int a = 0; a < 2; ++a)
#pragma unroll
            for (int b = 0; b < 2; ++b)
#pragma unroll
                for (int m = 0; m < 4; ++m)
#pragma unroll
                    for (int n = 0; n < 2; ++n) acc[a][b][m][n] = (f32x4){0.f, 0.f, 0.f, 0.f};
        cur = nxt; cA = nA; cB = nB; ++ui;
        if constexpr (ALIGN_EPI) { if (wr == 1) PG8_BAR; }
    }
    PG8_WAIT_V(0);
    if constexpr (!ALIGN_EPI) { if (wr == 0) PG8_BAR; }
    PG8_BAR;
    if constexpr (Epi::AFTER_DRAIN) { E.fused(acc, cur, wr, wc, fr, fq, lds, wid, lane); S.done(cur); }
#undef PG8_SA
#undef PG8_SB
#undef PG8_STAGE
#undef PG8_LDA
#undef PG8_LDB
#undef PG8_MMA
#undef PG8_WAIT_V
#undef PG8_WAIT_L
#undef PG8_BAR
#undef PG8_SCHED
}
}
#define GAS __attribute__((address_space(1)))
#define LAS __attribute__((address_space(3)))
typedef unsigned short bf16;
typedef unsigned v4u __attribute__((ext_vector_type(4)));
typedef float f32x4 __attribute__((ext_vector_type(4)));
typedef short bf16x8 __attribute__((ext_vector_type(8)));
typedef GAS unsigned gu32;
typedef GAS unsigned long long gu64;
#define RLX_AGENT __ATOMIC_RELAXED, __HIP_MEMORY_SCOPE_AGENT
#define LDS_WAIT() asm volatile("s_waitcnt lgkmcnt(0)" ::: "memory")
#define VM_WAIT() asm volatile("s_waitcnt vmcnt(0)" ::: "memory")
__device__ __forceinline__ unsigned long long rt() { return __builtin_amdgcn_s_memrealtime(); }
__device__ __forceinline__ unsigned f2bf(float f) { unsigned u = __builtin_bit_cast(unsigned, f); return (u + 0x7fffu + ((u >> 16) & 1u)) >> 16; }
__device__ __forceinline__ unsigned pk2(float lo, float hi) { return f2bf(lo) | (f2bf(hi) << 16); }

#define XB_TMO      128
#define XB_XCNT(j)  (256  + 64 * (j))
#define XB_XSUB(j)  (1280 + 64 * (j))
#define XB_XGEN(j)  (2304 + 64 * (j))
#define XB_TOP      3328
#define XB_TOPGEN   3392
#define XCD_BAR_WORDS 3456
#define XB_SPIN_CAP (1u << 18)

__device__ __forceinline__ unsigned xb_ld(unsigned* p)              { return __hip_atomic_load(p, __ATOMIC_RELAXED, __HIP_MEMORY_SCOPE_AGENT); }
__device__ __forceinline__ unsigned xb_add(unsigned* p, unsigned v) { return __hip_atomic_fetch_add(p, v, __ATOMIC_RELAXED, __HIP_MEMORY_SCOPE_AGENT); }
__device__ __forceinline__ unsigned xb_xcc_id() { return (unsigned)__builtin_amdgcn_s_getreg((3 << 11) | 20) & 0xFu; }
#define XB_SPIN(cond, bar) do { unsigned _sp = 0; while (cond) { __builtin_amdgcn_s_sleep(1); \
    if ((++_sp & 255u) == 0u) { if (xb_ld(&(bar)[XB_TMO])) break; if (_sp > XB_SPIN_CAP) { atomicAdd(&(bar)[XB_TMO], 1u); break; } } } } while (0)

struct XcdBarrier {
    unsigned* bar; unsigned x;
    volatile LAS unsigned* st;
};

__device__ __forceinline__ XcdBarrier xcd_barrier_post(unsigned* bar, volatile LAS unsigned* st) {
    XcdBarrier b; b.bar = bar; b.x = xb_xcc_id(); b.st = st;
    if (threadIdx.x == 0) (void)xb_add(&bar[XB_XCNT(b.x)], 1u);
    return b;
}
__device__ __forceinline__ void xcd_barrier_complete(unsigned* bar, unsigned x, unsigned& nloc, unsigned& nx) {
    const unsigned G = gridDim.x * gridDim.y * gridDim.z;
    unsigned sum, cnt, mine, sp = 0u;
    for (;;) {
        sum = 0u; cnt = 0u; mine = 0u;
#pragma unroll
        for (unsigned j = 0; j < 16; ++j) { const unsigned c = xb_ld(&bar[XB_XCNT(j)]); sum += c; cnt += (c > 0u) ? 1u : 0u; mine = (j == x) ? c : mine; }
        if (sum == G) break;
        __builtin_amdgcn_s_sleep(1);
        if ((++sp & 255u) == 0u) { if (xb_ld(&bar[XB_TMO])) break; if (sp > XB_SPIN_CAP) { atomicAdd(&bar[XB_TMO], 1u); break; } }
    }
    nloc = mine > 0u ? mine : 1u; nx = cnt > 0u ? cnt : 1u;
}

__device__ __forceinline__ void xcd_barrier(const XcdBarrier& b) {
    asm volatile("s_waitcnt vmcnt(0)" ::: "memory");
    __syncthreads();
    if (threadIdx.x == 0) {
        unsigned* bar = b.bar;
        __builtin_amdgcn_s_waitcnt(0);
        unsigned nloc = b.st[0], nx = b.st[1];
        if (nloc == 0u) { xcd_barrier_complete(bar, b.x, nloc, nx); b.st[0] = nloc; b.st[1] = nx; }
        const unsigned old = xb_add(&bar[XB_XSUB(b.x)], 1u);
        const unsigned gen = old / nloc;
        if (old + 1u == (gen + 1u) * nloc) {
            __builtin_amdgcn_fence(__ATOMIC_RELEASE, "agent");
            asm volatile("s_waitcnt vmcnt(0)" ::: "memory");
            const unsigned og = xb_add(&bar[XB_TOP], 1u);
            const unsigned tg = og / nx;
            if (og + 1u == (tg + 1u) * nx) xb_add(&bar[XB_TOPGEN], 1u);
            else XB_SPIN(xb_ld(&bar[XB_TOPGEN]) == tg, bar);
            __builtin_amdgcn_fence(__ATOMIC_ACQUIRE, "agent");
            xb_add(&bar[XB_XGEN(b.x)], 1u);
            asm volatile("s_waitcnt vmcnt(0)" ::: "memory");
        } else {
            XB_SPIN(xb_ld(&bar[XB_XGEN(b.x)]) == gen, bar);
            __builtin_amdgcn_fence(__ATOMIC_ACQUIRE, "agent");
            asm volatile("s_waitcnt vmcnt(0)" ::: "memory");
        }
    }
    __syncthreads();
}

constexpr int D = 1024, BATCH = 16, SEQ = 2048, DEPTH = 2, M = BATCH * SEQ;
constexpr int PIN = 3224, PINP = 3328;
constexpr int C_GQ = 0, C_GK = 192, C_GV = 384, C_GLR = 768, C_GG = 784, C_DQ = 1168, C_DK = 1488, C_DV = 1552, C_IQ = 1680, C_IK = 2192, C_IW = 2256, C_SQ = 2264, C_SK = 2584, C_SV = 2904;
constexpr int O_GLA = 0, O_DSA = 384, O_SB = 704;
constexpr int MEMT = 256, MKV = BATCH * MEMT, FF = 4096;
constexpr float LN_EPS = 1e-5f;
constexpr float ALPHA = 1.4142135623730951f;
constexpr float IDX_SCALE = 0.04419417382415922f;
constexpr float GLA_QSCALE = 0.14433756729740643f;
constexpr int NWAVES = 8;
constexpr int LDS_BYTES = 147456;
constexpr int RING_OFF = 0, RING_BYTES = 131072, LDSCTL_OFF = RING_BYTES, MISC_OFF = LDSCTL_OFF + 320;

constexpr size_t MiB = 1u << 20;
constexpr size_t WS_CTL = 0, CTL_ZERO_BYTES = 1 * MiB;
constexpr size_t LW_IN = 0, LW_OUT = (size_t)PINP * D, LW_MQ = LW_OUT + (size_t)D * D, LW_MKV = LW_MQ + (size_t)D * D, LW_MO = LW_MKV + 2 * (size_t)D * D,
                 LW_UP = LW_MO + (size_t)D * D, LW_DN = LW_UP + (size_t)FF * D, LW_END = LW_DN + (size_t)D * FF;
constexpr size_t WS_W = 2 * MiB;
constexpr size_t WS_MEMB = 68 * MiB;
constexpr size_t WS_KVMEM = 76 * MiB;
constexpr size_t WS_H = 108 * MiB;
constexpr size_t WS_PROJ = 172 * MiB;
constexpr size_t WS_OBUF = 380 * MiB;
constexpr size_t WS_QMEM = 444 * MiB;
constexpr size_t WS_UBUF = 172 * MiB;
constexpr size_t WS_END = 508 * MiB;
static_assert(WS_W + 2 * LW_END * 2 <= WS_MEMB && WS_UBUF + (size_t)M * FF * 2 <= WS_QMEM, "ws map");
constexpr int CW_BAR = 4096;


__device__ __forceinline__ float bf2f(bf16 v) { return __uint_as_float((unsigned)v << 16); }
__device__ __forceinline__ float wave_sum(float v) {
#pragma unroll
    for (int o = 1; o < 64; o <<= 1) v += __shfl_xor(v, o);
    return v;
}
__device__ __forceinline__ float wave_max(float v) {
#pragma unroll
    for (int o = 1; o < 64; o <<= 1) v = fmaxf(v, __shfl_xor(v, o));
    return v;
}
__device__ __forceinline__ int wave_sum_i(int v) {
#pragma unroll
    for (int o = 1; o < 64; o <<= 1) v += __shfl_xor(v, o);
    return v;
}
__device__ __forceinline__ void unpack8(const uint4 u, float (&f)[8]) {
    f[0] = __uint_as_float(u.x << 16); f[1] = __uint_as_float(u.x & 0xffff0000u); f[2] = __uint_as_float(u.y << 16); f[3] = __uint_as_float(u.y & 0xffff0000u);
    f[4] = __uint_as_float(u.z << 16); f[5] = __uint_as_float(u.z & 0xffff0000u); f[6] = __uint_as_float(u.w << 16); f[7] = __uint_as_float(u.w & 0xffff0000u);
}


struct Frame { LAS unsigned char* lds; int tid, lane, wave, gw, NGW, G; };
#define WAVE_SYNC() asm volatile("s_waitcnt lgkmcnt(0)" ::: "memory")

__device__ __forceinline__ void tr_item(const float* __restrict__ W, int K, int N, int Npad, bf16* __restrict__ WT, LAS float* scr, int item, int lane) {
    const int nblk = Npad / 32, kb = item / nblk, nb = item % nblk, k0 = 64 * kb, n0 = 32 * nb;
    const int n = n0 + (lane & 31);
#pragma unroll 8
    for (int i = 0; i < 32; ++i) { const int kk = 2 * i + (lane >> 5); scr[kk * 33 + (lane & 31)] = (n < N) ? W[(size_t)(k0 + kk) * N + n] : 0.f; }
    WAVE_SYNC();
    const int c = lane & 7;
#pragma unroll
    for (int j = 0; j < 4; ++j) { const int nn = (lane >> 3) + 8 * j; const LAS float* s = scr + (8 * c) * 33 + nn;
        v4u o; o.x = pk2(s[0 * 33], s[1 * 33]); o.y = pk2(s[2 * 33], s[3 * 33]); o.z = pk2(s[4 * 33], s[5 * 33]); o.w = pk2(s[6 * 33], s[7 * 33]);
        *(v4u*)(WT + (size_t)(n0 + nn) * K + k0 + 8 * c) = o; }
    WAVE_SYNC();
}
__device__ __forceinline__ void ln_row(const float* src, const float* __restrict__ g, const float* __restrict__ b, bf16* dstb, float* dstf, int lane) {
    const float4* xr = (const float4*)src + lane;
    float4 v[4]; float s = 0.f;
#pragma unroll
    for (int j = 0; j < 4; ++j) { v[j] = xr[64 * j]; s += (v[j].x + v[j].y) + (v[j].z + v[j].w); }
    const float mean = wave_sum(s) * (1.f / D); float s2 = 0.f;
#pragma unroll
    for (int j = 0; j < 4; ++j) { v[j].x -= mean; v[j].y -= mean; v[j].z -= mean; v[j].w -= mean; s2 += (v[j].x * v[j].x + v[j].y * v[j].y) + (v[j].z * v[j].z + v[j].w * v[j].w); }
    const float rstd = 1.f / sqrtf(wave_sum(s2) * (1.f / D) + LN_EPS);
#pragma unroll
    for (int j = 0; j < 4; ++j) {
        const float4 gg = ((const float4*)g)[lane + 64 * j], bb = ((const float4*)b)[lane + 64 * j];
        float4 y; y.x = v[j].x * rstd * gg.x + bb.x; y.y = v[j].y * rstd * gg.y + bb.y; y.z = v[j].z * rstd * gg.z + bb.z; y.w = v[j].w * rstd * gg.w + bb.w;
        uint2 o; o.x = pk2(y.x, y.y); o.y = pk2(y.z, y.w); ((uint2*)dstb)[lane + 64 * j] = o;
        if (dstf) ((float4*)dstf)[lane + 64 * j] = y;
    }
}
__device__ __forceinline__ void ph_ln(const Frame& F, const float* src, const float* g, const float* b, bf16* dstb, float* dstf) {
    int lane = F.lane; asm volatile("" : "+v"(lane));
    for (int m = F.gw; m < M; m += F.NGW) ln_row(src + (size_t)m * D, g, b, dstb + (size_t)m * D, dstf ? dstf + (size_t)m * D : (float*)nullptr, lane);
}
__device__ __forceinline__ void ph_prologue(const Frame& F, const float* const* in, unsigned char* ws) {
    LAS float* scr = (LAS float*)(F.lds + F.wave * 16384);
    for (int l = 0; l < DEPTH; ++l) {
        bf16* Wl = (bf16*)(ws + WS_W) + (size_t)l * LW_END;
        for (int it = F.gw; it < (D / 64) * (PINP / 32); it += F.NGW) tr_item(in[4] + (size_t)l * D * PIN, D, PIN, PINP, Wl + LW_IN, scr, it, F.lane);
        for (int it = F.gw; it < (D / 64) * (D / 32); it += F.NGW) tr_item(in[9] + (size_t)l * D * D, D, D, D, Wl + LW_OUT, scr, it, F.lane);
        for (int it = F.gw; it < (D / 64) * (D / 32); it += F.NGW) tr_item(in[12] + (size_t)l * D * D, D, D, D, Wl + LW_MQ, scr, it, F.lane);
        for (int it = F.gw; it < (D / 64) * (2 * D / 32); it += F.NGW) tr_item(in[13] + (size_t)l * D * 2 * D, D, 2 * D, 2 * D, Wl + LW_MKV, scr, it, F.lane);
        for (int it = F.gw; it < (D / 64) * (D / 32); it += F.NGW) tr_item(in[14] + (size_t)l * D * D, D, D, D, Wl + LW_MO, scr, it, F.lane);
        for (int it = F.gw; it < (D / 64) * (FF / 32); it += F.NGW) tr_item(in[17] + (size_t)l * D * FF, D, FF, FF, Wl + LW_UP, scr, it, F.lane);
        for (int it = F.gw; it < (FF / 64) * (D / 32); it += F.NGW) tr_item(in[19] + (size_t)l * FF * D, FF, D, D, Wl + LW_DN, scr, it, F.lane);
    }
    { const float4* src = (const float4*)in[1]; uint2* dst = (uint2*)(ws + WS_MEMB);
      for (size_t i = (size_t)F.gw * 64 + F.lane; i < (size_t)MKV * D / 4; i += (size_t)F.NGW * 64) { const float4 v = src[i]; uint2 o; o.x = pk2(v.x, v.y); o.y = pk2(v.z, v.w); dst[i] = o; } }
    ph_ln(F, in[0], in[2], in[3], (bf16*)(ws + WS_H), (float*)nullptr);
}
__device__ __forceinline__ void ph_gla_gate(const Frame& F, const bf16* __restrict__ proj, const float* __restrict__ w2, const float* __restrict__ gb, float* __restrict__ gl) {
    int lane = F.lane; asm volatile("" : "+v"(lane));
    for (size_t idx = (size_t)F.gw * 64 + lane; idx < (size_t)M * 192; idx += (size_t)F.NGW * 64) {
        const int t = (int)(idx / 192), j = (int)(idx % 192);
        float acc = 0.f;
#pragma unroll
        for (int r = 0; r < 16; ++r) acc += bf2f(proj[(size_t)t * PINP + C_GLR + r]) * w2[r * 192 + j];
        acc += gb[j];
        const float ls = fminf(acc, 0.f) - log1pf(expf(-fabsf(acc)));
        gl[idx] = ls * (1.f / 16.f);
    }
}
__device__ __forceinline__ void ph_gla_rec(const Frame& F, const bf16* __restrict__ proj, const float* __restrict__ gl, float* __restrict__ oraw) {
    if ((int)blockIdx.x >= BATCH * 4) return;
    int tid = F.tid; asm volatile("" : "+v"(tid)); const int b = blockIdx.x >> 2, h = blockIdx.x & 3;
    LAS float* sq = (LAS float*)F.lds; LAS float* sk = sq + 32 * 48; LAS float* sa = sk + 32 * 48;
    float S[48];
#pragma unroll
    for (int d = 0; d < 48; ++d) S[d] = 0.f;
    for (int t0 = 0; t0 < SEQ; t0 += 32) {
        __syncthreads();
        for (int i = tid; i < 32 * 48; i += NWAVES * 64) { const int tt = i / 48, d = i % 48; const size_t row = (size_t)b * SEQ + t0 + tt;
            sq[i] = bf2f(proj[row * PINP + C_GQ + h * 48 + d]) * GLA_QSCALE; sk[i] = bf2f(proj[row * PINP + C_GK + h * 48 + d]); sa[i] = expf(gl[row * 192 + h * 48 + d]); }
        __syncthreads();
        if (tid < 96) {
            for (int tt = 0; tt < 32; ++tt) { const size_t row = (size_t)b * SEQ + t0 + tt; const float v = bf2f(proj[row * PINP + C_GV + h * 96 + tid]); float o = 0.f;
#pragma unroll
                for (int d = 0; d < 48; ++d) { S[d] = sa[tt * 48 + d] * S[d] + sk[tt * 48 + d] * v; o += sq[tt * 48 + d] * S[d]; }
                oraw[row * 384 + h * 96 + tid] = o; }
        }
    }
    __syncthreads();
}
__device__ __forceinline__ void ph_gla_fin(const Frame& F, const bf16* __restrict__ proj, const float* __restrict__ oraw, const float* __restrict__ ng, bf16* __restrict__ obuf) {
    int lane = F.lane; asm volatile("" : "+v"(lane));
    for (int gw = F.gw; gw < M * 4; gw += F.NGW) {
        const int t = gw >> 2, h = gw & 3;
        const float o0 = oraw[(size_t)t * 384 + h * 96 + lane], o1 = lane < 32 ? oraw[(size_t)t * 384 + h * 96 + 64 + lane] : 0.f;
        const float ss = wave_sum(o0 * o0 + o1 * o1);
        const float r = 1.f / sqrtf(ss * (1.f / 96.f) + LN_EPS);
        { const float g = bf2f(proj[(size_t)t * PINP + C_GG + h * 96 + lane]); const float y = o0 * r * ng[lane] * (g / (1.f + expf(-g))); obuf[(size_t)t * D + O_GLA + h * 96 + lane] = (bf16)f2bf(y); }
        if (lane < 32) { const float g = bf2f(proj[(size_t)t * PINP + C_GG + h * 96 + 64 + lane]); const float y = o1 * r * ng[64 + lane] * (g / (1.f + expf(-g))); obuf[(size_t)t * D + O_GLA + h * 96 + 64 + lane] = (bf16)f2bf(y); }
    }
}
__device__ __forceinline__ void ph_sb(const Frame& F, const bf16* __restrict__ proj, bf16* __restrict__ obuf) {
    int lane = F.lane; asm volatile("" : "+v"(lane));
    for (int gw = F.gw; gw < M * 5; gw += F.NGW) {
        const int tok = gw / 5, hd = gw % 5, b = tok / SEQ, t = tok % SEQ;
        float q[64];
        { const uint4* qr = (const uint4*)(proj + (size_t)tok * PINP + C_SQ + hd * 64);
#pragma unroll
          for (int i = 0; i < 8; ++i) { float f[8]; unpack8(qr[i], f);
#pragma unroll
              for (int e = 0; e < 8; ++e) q[8 * i + e] = f[e] * 0.125f; } }
        float o = 0.f, carry = 0.f;
        for (int base = t - 1; base >= 0; base -= 64) {
            const int s = base - lane; const bool valid = s >= 0;
            float z = 0.f;
            if (valid) { const uint4* kr = (const uint4*)(proj + ((size_t)b * SEQ + s) * PINP + C_SK + hd * 64);
#pragma unroll
                for (int i = 0; i < 8; ++i) { float f[8]; unpack8(kr[i], f);
#pragma unroll
                    for (int e = 0; e < 8; ++e) z += q[8 * i + e] * f[e]; } }
            const float sp = fmaxf(z, 0.f) + log1pf(expf(-fabsf(z)));
            const float l = valid ? -sp : 0.f;
            float inc = l;
#pragma unroll
            for (int off = 1; off < 64; off <<= 1) { const float y = __shfl_up(inc, off); if (lane >= off) inc += y; }
            const float w = valid ? expf((z - sp) + (inc - l) + carry) : 0.f;
            const float tot = __shfl(inc, 63);
            const int nv = (base + 1 < 64) ? base + 1 : 64;
            for (int i = 0; i < nv; ++i) { const float wi = __shfl(w, i); o += wi * bf2f(proj[((size_t)b * SEQ + (base - i)) * PINP + C_SV + hd * 64 + lane]); }
            carry += tot;
            if (carry < -104.f) break;
        }
        obuf[(size_t)tok * D + O_SB + hd * 64 + lane] = (bf16)f2bf(o);
    }
}
__device__ __forceinline__ void ph_dsa(const Frame& F, const bf16* __restrict__ proj, const float* __restrict__ wuv, bf16* __restrict__ obuf) {
    int lane = F.lane; asm volatile("" : "+v"(lane));
    LAS unsigned char* wl = F.lds + F.wave * 12544;
    LAS unsigned* s_key = (LAS unsigned*)wl;
    LAS float* s_p = (LAS float*)wl;
    LAS float* s_ol = (LAS float*)(wl + 5120);
    LAS float* s_iq = (LAS float*)(wl + 8192);
    LAS float* s_q = (LAS float*)(wl + 10240);
    LAS int* s_idx = (LAS int*)(wl + 11520);
    const unsigned long long lt_mask = (lane == 0) ? 0ull : (~0ull >> (64 - lane));
    for (int tok = F.gw; tok < M; tok += F.NGW) {
        const int b = tok / SEQ, t = tok % SEQ;
        const bf16* prow = proj + (size_t)tok * PINP;
        WAVE_SYNC();
        for (int i = lane; i < 512; i += 64) s_iq[i] = bf2f(prow[C_IQ + i]);
        for (int i = lane; i < 320; i += 64) s_q[i] = bf2f(prow[C_DQ + i]);
        float iw[8];
#pragma unroll
        for (int h = 0; h < 8; ++h) iw[h] = bf2f(prow[C_IW + h]);
        WAVE_SYNC();
        for (int j = 0; j < 32; ++j) {
            const int s = lane + 64 * j; unsigned kk = 0u;
            if (s <= t) {
                const uint4* kr = (const uint4*)(proj + ((size_t)b * SEQ + s) * PINP + C_IK);
                float dot[8];
#pragma unroll
                for (int h = 0; h < 8; ++h) dot[h] = 0.f;
#pragma unroll 1
                for (int i = 0; i < 8; ++i) { float f[8]; unpack8(kr[i], f);
#pragma unroll
                    for (int h = 0; h < 8; ++h)
#pragma unroll
                        for (int e = 0; e < 8; ++e) dot[h] += s_iq[h * 64 + 8 * i + e] * f[e]; }
                float isc = 0.f;
#pragma unroll
                for (int h = 0; h < 8; ++h) isc += fmaxf(dot[h], 0.f) * iw[h];
                isc *= IDX_SCALE;
                const unsigned u = __float_as_uint(isc); kk = (u & 0x80000000u) ? ~u : (u | 0x80000000u);
            }
            s_key[s] = kk;
        }
        WAVE_SYNC();
        int nsel;
        if (t + 1 <= 256) {
            nsel = t + 1;
            for (int i = lane; i < nsel; i += 64) s_idx[i] = i;
        } else {
            unsigned prefix = 0u;
            for (int bit = 31; bit >= 0; --bit) {
                const unsigned cand = prefix | (1u << bit); int c = 0;
                for (int j = 0; j < 32; ++j) c += (s_key[lane + 64 * j] >= cand) ? 1 : 0;
                c = wave_sum_i(c);
                if (c >= 256) prefix = cand;
            }
            int cg = 0;
            for (int j = 0; j < 32; ++j) cg += (s_key[lane + 64 * j] > prefix) ? 1 : 0;
            cg = wave_sum_i(cg);
            const int need = 256 - cg;
            int base_sel = 0, base_tie = 0;
            for (int j = 0; j < 32; ++j) {
                const unsigned k = s_key[lane + 64 * j]; const bool gt = k > prefix, eq = (k == prefix);
                const unsigned long long beq = __ballot(eq); const int tie_rank = base_tie + __popcll(beq & lt_mask);
                const bool sel = gt || (eq && tie_rank < need);
                const unsigned long long bs = __ballot(sel); const int pos = base_sel + __popcll(bs & lt_mask);
                if (sel) s_idx[pos] = lane + 64 * j;
                base_sel += __popcll(bs); base_tie += __popcll(beq);
            }
            nsel = 256;
        }
        WAVE_SYNC();
        const float slope[5] = {0.32987697769322355f, 0.1088188204120155f, 0.03589682359365735f, 0.011841535675862483f, 0.00390625f};
#pragma unroll 1
        for (int m = 0; m < 4; ++m) {
            const int kidx = lane + 64 * m;
            float dot[5];
#pragma unroll
            for (int h = 0; h < 5; ++h) dot[h] = -INFINITY;
            if (kidx < nsel) {
                const int si = s_idx[kidx];
                const uint4* kr = (const uint4*)(proj + ((size_t)b * SEQ + si) * PINP + C_DK);
#pragma unroll
                for (int h = 0; h < 5; ++h) dot[h] = 0.f;
#pragma unroll 1
                for (int i = 0; i < 8; ++i) { float f[8]; unpack8(kr[i], f);
#pragma unroll
                    for (int h = 0; h < 5; ++h)
#pragma unroll
                        for (int e = 0; e < 8; ++e) dot[h] += s_q[h * 64 + 8 * i + e] * f[e]; }
#pragma unroll
                for (int h = 0; h < 5; ++h) dot[h] = dot[h] * 0.125f - slope[h] * (float)(t - si);
            }
#pragma unroll
            for (int h = 0; h < 5; ++h) s_p[h * 256 + kidx] = dot[h];
        }
        WAVE_SYNC();
#pragma unroll 1
        for (int h = 0; h < 5; ++h) {
            float sc[4];
#pragma unroll
            for (int m = 0; m < 4; ++m) sc[m] = s_p[h * 256 + lane + 64 * m];
            const float mx = wave_max(fmaxf(fmaxf(sc[0], sc[1]), fmaxf(sc[2], sc[3])));
            float e[4], se = 0.f;
#pragma unroll
            for (int m = 0; m < 4; ++m) { e[m] = (lane + 64 * m < nsel) ? expf(sc[m] - mx) : 0.f; se += e[m]; }
            const float inv = 1.f / wave_sum(se);
#pragma unroll
            for (int m = 0; m < 4; ++m) s_p[h * 256 + lane + 64 * m] = e[m] * inv;
        }
        WAVE_SYNC();
        float a0[5], a1[5];
#pragma unroll
        for (int h = 0; h < 5; ++h) { a0[h] = 0.f; a1[h] = 0.f; }
        for (int k = 0; k < nsel; ++k) {
            const int si = s_idx[k]; const bf16* vr = proj + ((size_t)b * SEQ + si) * PINP + C_DV;
            const float v0 = bf2f(vr[lane]), v1 = bf2f(vr[lane + 64]);
#pragma unroll
            for (int h = 0; h < 5; ++h) { const float p = s_p[h * 256 + k]; a0[h] += p * v0; a1[h] += p * v1; }
        }
        WAVE_SYNC();
#pragma unroll
        for (int h = 0; h < 5; ++h) { s_ol[h * 128 + lane] = a0[h]; s_ol[h * 128 + lane + 64] = a1[h]; }
        WAVE_SYNC();
#pragma unroll
        for (int h = 0; h < 5; ++h) { float o = 0.f;
            for (int c = 0; c < 128; ++c) o += s_ol[h * 128 + c] * wuv[(h * 128 + c) * 64 + lane];
            obuf[(size_t)tok * D + O_DSA + h * 64 + lane] = (bf16)f2bf(o); }
    }
}
__device__ __forceinline__ void ph_memattn(const Frame& F, const bf16* __restrict__ qmem, const bf16* __restrict__ kv, bf16* __restrict__ obuf) {
    int lane = F.lane; asm volatile("" : "+v"(lane));
    LAS float* s_q = (LAS float*)(F.lds + F.wave * 2048); LAS float* s_p = s_q + 256;
    for (int gw = F.gw; gw < M * 4; gw += F.NGW) {
        const int tok = gw >> 2, hd = gw & 3, b = tok / SEQ;
        WAVE_SYNC();
#pragma unroll
        for (int i = 0; i < 4; ++i) s_q[lane + 64 * i] = bf2f(qmem[(size_t)tok * D + hd * 256 + lane + 64 * i]);
        WAVE_SYNC();
        float sc[4];
#pragma unroll
        for (int j = 0; j < 4; ++j) { const int m = lane + 64 * j; const uint4* kr = (const uint4*)(kv + ((size_t)b * MEMT + m) * 2048 + hd * 256); float dot = 0.f;
            for (int i = 0; i < 32; ++i) { float f[8]; unpack8(kr[i], f);
#pragma unroll
                for (int e = 0; e < 8; ++e) dot += s_q[8 * i + e] * f[e]; }
            sc[j] = dot * 0.0625f; }
        const float mx = wave_max(fmaxf(fmaxf(sc[0], sc[1]), fmaxf(sc[2], sc[3])));
        float e[4], se = 0.f;
#pragma unroll
        for (int j = 0; j < 4; ++j) { e[j] = expf(sc[j] - mx); se += e[j]; }
        const float inv = 1.f / wave_sum(se);
#pragma unroll
        for (int j = 0; j < 4; ++j) s_p[lane + 64 * j] = e[j] * inv;
        WAVE_SYNC();
        float o[4] = {0.f, 0.f, 0.f, 0.f};
        for (int m = 0; m < MEMT; ++m) { const float p = s_p[m]; const bf16* vr = kv + ((size_t)b * MEMT + m) * 2048 + 1024 + hd * 256;
#pragma unroll
            for (int i = 0; i < 4; ++i) o[i] += p * bf2f(vr[lane + 64 * i]); }
#pragma unroll
        for (int i = 0; i < 4; ++i) obuf[(size_t)tok * D + hd * 256 + lane + 64 * i] = (bf16)f2bf(o[i]);
    }
}

struct Args { const float* in[23]; float* out; unsigned char* ws; int ph_lo, ph_hi; };
static_assert(sizeof(Args) == 23 * 8 + 8 + 8 + 8, "Args has no padding");
namespace cg = cooperative_groups;

constexpr int PH_PRO = 0, PH_KV = 1, PH_L0 = 2, PH_PER_LAYER = 13, PH_END = PH_L0 + DEPTH * PH_PER_LAYER;

#define GEMM_PHASE(EPI, Aptr, Bptr, MM, NN, KK, ...) do { pg8::Gemm g{Aptr, Bptr, MM, NN, KK}; pg8::StaticOrder S; S.init(MM, NN, G, (int)blockIdx.x); \
    EPI E{__VA_ARGS__}; pg8::gemm_phase<EPI, pg8::StaticOrder, true, true>(L + RING_OFF, g, S, E); } while (0)

__global__ void __launch_bounds__(NWAVES * 64, 2) mk_fwd(Args args) {
    extern __shared__ __attribute__((aligned(16))) unsigned char lds[];
    LAS unsigned char* L = (LAS unsigned char*)lds;
    cg::grid_group grid = cg::this_grid();
    unsigned char* ws = args.ws;
    const int G = gridDim.x;
    Frame F; F.lds = L; F.tid = threadIdx.x; F.lane = F.tid & 63; F.wave = __builtin_amdgcn_readfirstlane(F.tid >> 6); F.G = G; F.gw = (int)blockIdx.x * NWAVES + F.wave; F.NGW = G * NWAVES;
    bf16* Hb = (bf16*)(ws + WS_H); bf16* PROJ = (bf16*)(ws + WS_PROJ); bf16* OBUF = (bf16*)(ws + WS_OBUF); bf16* QMEM = (bf16*)(ws + WS_QMEM); bf16* UBUF = (bf16*)(ws + WS_UBUF);
    bf16* MEMB = (bf16*)(ws + WS_MEMB); bf16* KVM = (bf16*)(ws + WS_KVMEM);
    float* GLOG = args.out; float* ORAW = args.out + (size_t)8 * 1024 * 1024;
    const int lo = args.ph_lo, hi = args.ph_hi;
#define IN(k) (lo <= (k) && (k) < hi)
#define SEAM(k) do { if (IN(k) && IN((k) + 1)) grid.sync(); } while (0)
    if (IN(PH_PRO)) { ph_prologue(F, args.in, ws); __syncthreads(); }
    SEAM(PH_PRO);
    if (IN(PH_KV)) {
#pragma unroll 1
        for (int l = 0; l < DEPTH; ++l) { const bf16* Wl = (const bf16*)(ws + WS_W) + (size_t)l * LW_END;
            GEMM_PHASE(pg8::EpiBf16<0>, MEMB, Wl + LW_MKV, MKV, 2 * D, D, KVM + (size_t)l * MKV * 2 * D, 2 * D, nullptr, 0, 0, 1.f); }
    }
    SEAM(PH_KV);
#pragma unroll 1
    for (int l = 0; l < DEPTH; ++l) {
        const int p0 = PH_L0 + l * PH_PER_LAYER; const bf16* Wl = (const bf16*)(ws + WS_W) + (size_t)l * LW_END;
        if (IN(p0 + 0)) GEMM_PHASE(pg8::EpiBf16<0>, Hb, Wl + LW_IN, M, PINP, D, PROJ, PINP, nullptr, 0, 0, 1.f);
        SEAM(p0 + 0);
        if (IN(p0 + 1)) { ph_gla_gate(F, PROJ, args.in[5] + (size_t)l * 16 * 192, args.in[6] + (size_t)l * 192, GLOG);
                          ph_sb(F, PROJ, OBUF); ph_dsa(F, PROJ, args.in[8] + (size_t)l * 5 * 128 * 64, OBUF); __syncthreads(); }
        SEAM(p0 + 1);
        if (IN(p0 + 2)) ph_gla_rec(F, PROJ, GLOG, ORAW);
        SEAM(p0 + 2);
        if (IN(p0 + 3)) ph_gla_fin(F, PROJ, ORAW, args.in[7] + (size_t)l * 96, OBUF);
        SEAM(p0 + 3);
        if (IN(p0 + 4)) GEMM_PHASE(pg8::EpiY, OBUF, Wl + LW_OUT, M, D, D, args.out, Hb, D, nullptr, ALPHA);
        SEAM(p0 + 4);
        if (IN(p0 + 5)) ph_ln(F, args.out, args.in[10] + (size_t)l * D, args.in[11] + (size_t)l * D, Hb, (float*)nullptr);
        SEAM(p0 + 5);
        if (IN(p0 + 6)) GEMM_PHASE(pg8::EpiBf16<0>, Hb, Wl + LW_MQ, M, D, D, QMEM, D, nullptr, 0, 0, 1.f);
        SEAM(p0 + 6);
        if (IN(p0 + 7)) { ph_memattn(F, QMEM, KVM + (size_t)l * MKV * 2 * D, OBUF); __syncthreads(); }
        SEAM(p0 + 7);
        if (IN(p0 + 8)) GEMM_PHASE(pg8::EpiY, OBUF, Wl + LW_MO, M, D, D, args.out, Hb, D, nullptr, ALPHA);
        SEAM(p0 + 8);
        if (IN(p0 + 9)) ph_ln(F, args.out, args.in[15] + (size_t)l * D, args.in[16] + (size_t)l * D, Hb, (float*)nullptr);
        SEAM(p0 + 9);
        if (IN(p0 + 10)) GEMM_PHASE(pg8::EpiBf16<2>, Hb, Wl + LW_UP, M, FF, D, UBUF, FF, args.in[18] + (size_t)l * FF, 0, 0, 1.f);
        SEAM(p0 + 10);
        if (IN(p0 + 11)) GEMM_PHASE(pg8::EpiY, UBUF, Wl + LW_DN, M, D, FF, args.out, Hb, D, args.in[20] + (size_t)l * D, ALPHA);
        SEAM(p0 + 11);
        if (IN(p0 + 12)) ph_ln(F, args.out, args.in[21] + (size_t)l * D, args.in[22] + (size_t)l * D, Hb, (l == DEPTH - 1) ? args.out : (float*)nullptr);
        SEAM(p0 + 12);
    }
#undef IN
#undef SEAM
}

#ifndef MK_SPLIT
#define MK_SPLIT 0
#endif
extern "C" void kernel_launch(void* const* d_in, const int* in_sizes, int n_in, void* d_out, int out_size, void* d_ws, size_t ws_size, hipStream_t stream) {
    static int grid = 0;
    if (grid == 0) {
        if (n_in != 23 || in_sizes[0] != M * D || out_size != M * D || ws_size < WS_END) { fprintf(stderr, "kernel_launch: unexpected shapes (n_in %d, in0 %d, out %d, ws %zu)\n", n_in, n_in > 0 ? in_sizes[0] : -1, out_size, ws_size); grid = -1; return; }
        int dev = 0, cus = 0, per_cu = 0;
        if (hipGetDevice(&dev) != hipSuccess || hipDeviceGetAttribute(&cus, hipDeviceAttributeMultiprocessorCount, dev) != hipSuccess) { grid = -1; return; }
        if (hipFuncSetAttribute((const void*)mk_fwd, hipFuncAttributeMaxDynamicSharedMemorySize, LDS_BYTES) != hipSuccess) { fprintf(stderr, "kernel_launch: hipFuncSetAttribute failed\n"); grid = -1; return; }
        if (hipOccupancyMaxActiveBlocksPerMultiprocessor(&per_cu, (const void*)mk_fwd, NWAVES * 64, LDS_BYTES) != hipSuccess || per_cu < 1) { fprintf(stderr, "kernel_launch: occupancy query says %d blocks per CU\n", per_cu); grid = -1; return; }
        grid = cus;
    }
    if (grid < 0) return;
    Args a{}; for (int i = 0; i < 23; ++i) a.in[i] = (const float*)d_in[i]; a.out = (float*)d_out; a.ws = (unsigned char*)d_ws;
    if (hipMemsetAsync((unsigned char*)d_ws + WS_CTL, 0, CTL_ZERO_BYTES, stream) != hipSuccess) return;
#if MK_SPLIT
    for (int p = 0; p < PH_END; ++p) { a.ph_lo = p; a.ph_hi = p + 1; hipLaunchKernelGGL(mk_fwd, dim3(grid), dim3(NWAVES * 64), LDS_BYTES, stream, a); }
#else
    a.ph_lo = 0; a.ph_hi = PH_END;
    void* kargs[] = {&a};
    const hipError_t e = hipLaunchCooperativeKernel((const void*)mk_fwd, dim3(grid), dim3(NWAVES * 64), kargs, LDS_BYTES, stream);
    if (e != hipSuccess) fprintf(stderr, "kernel_launch: cooperative launch failed: %s (grid %d)\n", hipGetErrorString(e), grid);
#endif
}
```

```cpp
#include <hip/hip_runtime.h>
#include <hip/hip_cooperative_groups.h>
#include <cstdio>
#include <cstdint>
namespace pg8 {
#define PG8_LAS __attribute__((address_space(3)))
typedef unsigned short bf16_t;
typedef short bf16x8 __attribute__((ext_vector_type(8)));
typedef float f32x4 __attribute__((ext_vector_type(4)));
typedef unsigned u32x4 __attribute__((ext_vector_type(4)));
constexpr int BM = 256, BK = 64, HALF = 128, HTB = HALF * BK * 2  , STAGE_BYTES = 8 * HTB, NXCD = 8, WGM = 8;

__host__ __device__ __forceinline__ int lds_byte(int r, int c) { const int st = (r >> 4) * 2 + (c >> 5), rr = r & 15, cc = c & 31, ob = rr * 64 + cc * 2; return st * 1024 + (ob ^ (((ob >> 9) & 1) << 5)); }
__host__ __device__ __forceinline__ void stage_rc(int b, int& R, int& C) { const int st = b / 1024, sb = b % 1024, swz = sb ^ (((sb >> 9) & 1) << 5); R = (st >> 1) * 16 + swz / 64; C = (st & 1) * 32 + (swz % 64) / 2; }
__host__ __device__ __forceinline__ int perm32(int rho) { const int n = rho >> 4, i = rho & 15; return 8 * (i >> 2) + 4 * n + (i & 3); }

struct Unit { int pm, pn; };
struct Gemm { const bf16_t* A; const bf16_t* Bt; int M, N, K; };

struct StaticOrder {
    int nM, nN, nwg, G, c;
    __host__ __device__ void init(int M, int N, int G_, int c_) { nM = M / BM; nN = N / BM; nwg = nM * nN; G = G_; c = c_; }
    __host__ __device__ bool next(int i, Unit& u) const {
        const long L = (long)i * G + c; if (L >= nwg) return false;
        int wgid = (int)L; { const int q = nwg / NXCD, r = nwg % NXCD, xcd = wgid % NXCD, off = wgid / NXCD; wgid = (xcd < r ? xcd * (q + 1) : r * (q + 1) + (xcd - r) * q) + off; }
        const int nig = WGM * nN, gid = wgid / nig, fm = gid * WGM, gsz = (nM - fm) < WGM ? (nM - fm) : WGM;
        u.pm = fm + ((wgid % nig) % gsz); u.pn = (wgid % nig) / gsz; return true;
    }
    __device__ __forceinline__ void a_ready(const Unit&) const {}
    __device__ __forceinline__ void done(const Unit&) const {}
};

__device__ __forceinline__ unsigned cvt_pk_bf16(float lo, float hi) { unsigned r; asm volatile("v_cvt_pk_bf16_f32 %0, %1, %2" : "=v"(r) : "v"(lo), "v"(hi)); return r; }
typedef float f32x2 __attribute__((ext_vector_type(2)));
template <int ACT  > struct EpiBf16 {
    static constexpr bool PERM = true, AFTER_DRAIN = false; static_assert(ACT == 0 || ACT == 2, "EpiBf16: ACT is 0 (none) or 2 (squared relu)");
    bf16_t* O; int ldc; const float* bias; int split_cols; size_t split_stride; float scale0;
    __device__ __forceinline__ void operator()(const f32x4 (&acc)[2][2][4][2], const Unit& u, int wr, int wc, int fr, int fq) const {
        const int row0 = u.pm * BM + wr * 64 + fr; int colt = u.pn * BM; bf16_t* base = O;
        float sc = 1.f; if (split_cols) { const int t = colt / split_cols; base += (size_t)t * split_stride; colt -= t * split_cols; if (t == 0) sc = scale0; }
        const int col0 = colt + wc * 32 + 8 * fq, bcol0 = u.pn * BM + wc * 32 + 8 * fq;
        f32x4 bv[2][2];
#pragma unroll
        for (int bj = 0; bj < 2; ++bj)
#pragma unroll
            for (int n = 0; n < 2; ++n) bv[bj][n] = bias ? *(const f32x4*)(bias + bcol0 + bj * HALF + 4 * n) : (f32x4){0.f, 0.f, 0.f, 0.f};
#pragma unroll
        for (int ai = 0; ai < 2; ++ai)
#pragma unroll
            for (int m = 0; m < 4; ++m) { bf16_t* rowp = base + (size_t)(row0 + ai * HALF + m * 16) * ldc + col0;
#pragma unroll
                for (int bj = 0; bj < 2; ++bj) { f32x4 v0 = acc[ai][bj][m][0] + bv[bj][0], v1 = acc[ai][bj][m][1] + bv[bj][1];
                    if (ACT == 2) { const f32x4 z4 = (f32x4){0.f, 0.f, 0.f, 0.f}; v0 = __builtin_elementwise_max(v0, z4); v1 = __builtin_elementwise_max(v1, z4); v0 = v0 * v0; v1 = v1 * v1; }
                    v0 = v0 * sc; v1 = v1 * sc; u32x4 w; w.x = cvt_pk_bf16(v0[0], v0[1]); w.y = cvt_pk_bf16(v0[2], v0[3]); w.z = cvt_pk_bf16(v1[0], v1[1]); w.w = cvt_pk_bf16(v1[2], v1[3]);
                    *(u32x4*)(rowp + bj * HALF) = w; } }
    }
};

struct EpiY {
    static constexpr bool PERM = false, AFTER_DRAIN = false;
    float* Y; const bf16_t* R; int ldc; const float* bias; float alpha;
    __device__ __forceinline__ void operator()(const f32x4 (&acc)[2][2][4][2], const Unit& u, int wr, int wc, int fr, int fq) const {
        const int row0 = u.pm * BM + wr * 64 + fr, col0 = u.pn * BM + wc * 32 + 4 * fq;
#pragma unroll
        for (int ai = 0; ai < 2; ++ai)
#pragma unroll
            for (int m = 0; m < 4; ++m) { const size_t roff = (size_t)(row0 + ai * HALF + m * 16) * ldc;
#pragma unroll
                for (int bj = 0; bj < 2; ++bj)
#pragma unroll
                    for (int n = 0; n < 2; ++n) { const int col = col0 + bj * HALF + n * 16;
                        const f32x4 bv = bias ? *(const f32x4*)(bias + col) : (f32x4){0.f, 0.f, 0.f, 0.f};
                        const uint2 rr = *(const uint2*)(R + roff + col);
                        f32x4 rv; rv[0] = __uint_as_float(rr.x << 16); rv[1] = __uint_as_float(rr.x & 0xffff0000u); rv[2] = __uint_as_float(rr.y << 16); rv[3] = __uint_as_float(rr.y & 0xffff0000u);
                        *(f32x4*)(Y + roff + col) = acc[ai][bj][m][n] + bv + rv * alpha; } }
    }
};

struct PanelStats {
    unsigned* xbuf;
    unsigned* cnt;
    unsigned* tmo;
    int ntn; float eps;
    unsigned code;
    __device__ __forceinline__ bool run(const f32x4 (&v)[2][2][4][2], const Unit& u, int wr, int wc, int fr, int fq, PG8_LAS unsigned char* lds, int wid, int lane) const {
        typedef float f32x2v __attribute__((ext_vector_type(2)));
        PG8_LAS f32x2v* P = (PG8_LAS f32x2v*)lds;
        PG8_LAS f32x2v* S = (PG8_LAS f32x2v*)(lds + 8192);
        PG8_LAS unsigned* flag = (PG8_LAS unsigned*)(lds + 8192 + 2048);
#pragma unroll
        for (int ai = 0; ai < 2; ++ai)
#pragma unroll
            for (int m = 0; m < 4; ++m) {
                float s = 0.f;
#pragma unroll
                for (int bj = 0; bj < 2; ++bj)
#pragma unroll
                    for (int n = 0; n < 2; ++n) { const f32x4 x = v[ai][bj][m][n]; s += (x[0] + x[1]) + (x[2] + x[3]); }
                s += __shfl_xor(s, 16); s += __shfl_xor(s, 32);
                const float mw = s * (1.0f / 64.0f); float q = 0.f;
#pragma unroll
                for (int bj = 0; bj < 2; ++bj)
#pragma unroll
                    for (int n = 0; n < 2; ++n) { const f32x4 d = v[ai][bj][m][n] - mw; q += (d[0] * d[0] + d[1] * d[1]) + (d[2] * d[2] + d[3] * d[3]); }
                q += __shfl_xor(q, 16); q += __shfl_xor(q, 32);
                if (fq == 0) P[(ai * HALF + wr * 64 + m * 16 + fr) * 4 + wc] = (f32x2v){mw, q};
            }
        asm volatile("s_waitcnt lgkmcnt(0)" ::: "memory"); __builtin_amdgcn_s_barrier(); asm volatile("" ::: "memory");
#if defined(BROKEN_EXCHANGE_NO_WAIT)
#warning BROKEN CONTROL BUILD: the row-statistics exchange does not wait; results are wrong by design
        if (blockIdx.x >= 64) { const long long t0_ = clock64(); while (clock64() - t0_ < 60000) __builtin_amdgcn_s_sleep(8); }
#endif
        const int row = wid * 32 + (lane & 31);
        if (lane < 32) {
            const f32x2v a = P[row * 4 + 0], b = P[row * 4 + 1], c = P[row * 4 + 2], d = P[row * 4 + 3];
            const float mt = (a.x + b.x + c.x + d.x) * 0.25f;
            const float da = a.x - mt, db = b.x - mt, dc = c.x - mt, dd = d.x - mt;
            const float m2 = (a.y + b.y) + (c.y + d.y) + 64.0f * ((da * da + db * db) + (dc * dc + dd * dd));
            unsigned long long* slot = (unsigned long long*)xbuf + ((size_t)(u.pm * BM + row) * 4 + u.pn);
            __hip_atomic_store(slot, ((unsigned long long)__float_as_uint(m2) << 32) | __float_as_uint(mt), __ATOMIC_RELAXED, __HIP_MEMORY_SCOPE_AGENT);
        }
        asm volatile("s_waitcnt vmcnt(0)" ::: "memory");
        if (lane == 0) __hip_atomic_fetch_add(cnt + 64 * u.pm, 1u, __ATOMIC_RELAXED, __HIP_MEMORY_SCOPE_AGENT);
        if (wid == 0) {
            bool dead = false; const unsigned long long t0 = __builtin_amdgcn_s_memrealtime(); const unsigned want = 8u * (unsigned)ntn;
            for (;;) {
#if defined(BROKEN_EXCHANGE_NO_WAIT)
                break;
#endif
                if ((unsigned)__builtin_amdgcn_readfirstlane(__hip_atomic_load(cnt + 64 * u.pm, __ATOMIC_RELAXED, __HIP_MEMORY_SCOPE_AGENT)) >= want) break;
                if (__builtin_amdgcn_s_memrealtime() - t0 > 2000000ull) {
                    if (lane == 0) { unsigned expect = 0u; __hip_atomic_compare_exchange_strong(tmo + 1, &expect, code | (unsigned)(u.pm & 0xff), __ATOMIC_RELAXED, __ATOMIC_RELAXED, __HIP_MEMORY_SCOPE_AGENT);
                                     __hip_atomic_store(tmo, 1u, __ATOMIC_RELAXED, __HIP_MEMORY_SCOPE_AGENT); }
                    dead = true; break; }
                __builtin_amdgcn_s_sleep(2);
            }
            __builtin_amdgcn_fence(__ATOMIC_ACQUIRE, "agent");
            if (lane == 0) flag[0] = dead ? 1u : 0u;
        }
        asm volatile("s_waitcnt vmcnt(0) lgkmcnt(0)" ::: "memory"); __builtin_amdgcn_s_barrier(); asm volatile("" ::: "memory");
        const bool bad = flag[0] != 0u;
        if (lane < 32) {
            const unsigned long long* slot = (const unsigned long long*)xbuf + (size_t)(u.pm * BM + row) * 4; float mt[4], m2[4]; float ms = 0.f;
#pragma unroll
            for (int t = 0; t < 4; ++t) { if (t < ntn) { const unsigned long long w = __hip_atomic_load(slot + t, __ATOMIC_RELAXED, __HIP_MEMORY_SCOPE_AGENT); mt[t] = __uint_as_float((unsigned)w); m2[t] = __uint_as_float((unsigned)(w >> 32)); } else { mt[t] = 0.f; m2[t] = 0.f; } ms += mt[t]; }
            const float mean = ms / (float)ntn; float q = 0.f;
#pragma unroll
            for (int t = 0; t < 4; ++t) if (t < ntn) { const float dm = mt[t] - mean; q += m2[t] + 256.0f * dm * dm; }
            S[row] = (f32x2v){mean, 1.0f / sqrtf(q / (256.0f * (float)ntn) + eps)};
        }
        asm volatile("s_waitcnt lgkmcnt(0)" ::: "memory"); __builtin_amdgcn_s_barrier(); asm volatile("" ::: "memory");
        return bad;
    }
};
struct EpiLnRes {
    static constexpr bool PERM = false, AFTER_DRAIN = true;
    const float* base; float* out; int ldc; const float* bias; PanelStats st; unsigned poison;
    __device__ __forceinline__ void fused(f32x4 (&acc)[2][2][4][2], const Unit& u, int wr, int wc, int fr, int fq, PG8_LAS unsigned char* lds, int wid, int lane) const {
        typedef float f32x2v __attribute__((ext_vector_type(2)));
        const PG8_LAS f32x2v* S = (const PG8_LAS f32x2v*)(lds + 8192);
        const int col0 = u.pn * BM + wc * 32 + 4 * fq;
#pragma unroll
        for (int bj = 0; bj < 2; ++bj)
#pragma unroll
            for (int n = 0; n < 2; ++n) { const f32x4 bv = bias ? *(const f32x4*)(bias + col0 + bj * HALF + n * 16) : (f32x4){0.f, 0.f, 0.f, 0.f};
#pragma unroll
                for (int ai = 0; ai < 2; ++ai)
#pragma unroll
                    for (int m = 0; m < 4; ++m) acc[ai][bj][m][n] += bv; }
        f32x4 pre[4][2][2];
#pragma unroll
        for (int m = 0; m < 4; ++m) { const size_t off = (size_t)(u.pm * BM + wr * 64 + m * 16 + fr) * ldc + col0;
#pragma unroll
            for (int bj = 0; bj < 2; ++bj)
#pragma unroll
                for (int n = 0; n < 2; ++n) pre[m][bj][n] = *(const f32x4*)(base + off + bj * HALF + n * 16); }
        const bool bad = st.run(acc, u, wr, wc, fr, fq, lds, wid, lane) || poison != 0u;
        const float qnan = __builtin_nanf("");
#pragma unroll
        for (int ai = 0; ai < 2; ++ai)
#pragma unroll
            for (int m = 0; m < 4; ++m) { const int r = ai * HALF + wr * 64 + m * 16 + fr; const f32x2v sr = S[r]; const size_t off = (size_t)(u.pm * BM + r) * ldc + col0;
#pragma unroll
                for (int bj = 0; bj < 2; ++bj)
#pragma unroll
                    for (int n = 0; n < 2; ++n) { const f32x4 bs = ai == 0 ? pre[m][bj][n] : *(const f32x4*)(base + off + bj * HALF + n * 16); f32x4 o = bs + (acc[ai][bj][m][n] - sr.x) * sr.y;
                        if (bad) o = (f32x4){qnan, qnan, qnan, qnan}; *(f32x4*)(out + off + bj * HALF + n * 16) = o; }
                if (m & 1) asm volatile("" ::: "memory"); }
    }
};
struct EpiLnResLn {
    static constexpr bool PERM = false, AFTER_DRAIN = true;
    const float* base; float* out; bf16_t* xn; int ldc; const float* bias; PanelStats st1, st2; unsigned poison;
    __device__ __forceinline__ void fused(f32x4 (&acc)[2][2][4][2], const Unit& u, int wr, int wc, int fr, int fq, PG8_LAS unsigned char* lds, int wid, int lane) const {
        typedef float f32x2v __attribute__((ext_vector_type(2))); typedef unsigned u32x2v __attribute__((ext_vector_type(2)));
        const PG8_LAS f32x2v* S = (const PG8_LAS f32x2v*)(lds + 8192);
        const int col0 = u.pn * BM + wc * 32 + 4 * fq;
#pragma unroll
        for (int bj = 0; bj < 2; ++bj)
#pragma unroll
            for (int n = 0; n < 2; ++n) { const f32x4 bv = bias ? *(const f32x4*)(bias + col0 + bj * HALF + n * 16) : (f32x4){0.f, 0.f, 0.f, 0.f};
#pragma unroll
                for (int ai = 0; ai < 2; ++ai)
#pragma unroll
                    for (int m = 0; m < 4; ++m) acc[ai][bj][m][n] += bv; }
        bool bad = st1.run(acc, u, wr, wc, fr, fq, lds, wid, lane) || poison != 0u;
        const float qnan = __builtin_nanf("");
#pragma unroll
        for (int ai = 0; ai < 2; ++ai)
#pragma unroll
            for (int m = 0; m < 4; ++m) { const int r = ai * HALF + wr * 64 + m * 16 + fr; const f32x2v sr = S[r]; const size_t off = (size_t)(u.pm * BM + r) * ldc + col0;
#pragma unroll
                for (int bj = 0; bj < 2; ++bj)
#pragma unroll
                    for (int n = 0; n < 2; ++n) { const f32x4 bs = *(const f32x4*)(base + off + bj * HALF + n * 16); acc[ai][bj][m][n] = bs + (acc[ai][bj][m][n] - sr.x) * sr.y; }
                asm volatile("" : "+v"(acc[ai][0][m][0]), "+v"(acc[ai][0][m][1]), "+v"(acc[ai][1][m][0]), "+v"(acc[ai][1][m][1]));
                if (m & 1) asm volatile("" ::: "memory"); }
        const bool bad1 = bad;
        bad = st2.run(acc, u, wr, wc, fr, fq, lds, wid, lane) || bad;
#pragma unroll
        for (int ai = 0; ai < 2; ++ai)
#pragma unroll
            for (int m = 0; m < 4; ++m) { const int r = ai * HALF + wr * 64 + m * 16 + fr; const f32x2v sr = S[r]; const size_t off = (size_t)(u.pm * BM + r) * ldc + col0;
#pragma unroll
                for (int bj = 0; bj < 2; ++bj)
#pragma unroll
                    for (int n = 0; n < 2; ++n) { const f32x4 x1 = acc[ai][bj][m][n]; *(f32x4*)(out + off + bj * HALF + n * 16) = bad1 ? (f32x4){qnan, qnan, qnan, qnan} : x1;
                        const f32x4 o = (x1 - sr.x) * sr.y; u32x2v w; w.x = cvt_pk_bf16(o[0], o[1]); w.y = cvt_pk_bf16(o[2], o[3]);
                        if (bad) { w.x = 0x7fc07fc0u; w.y = 0x7fc07fc0u; } *(u32x2v*)(xn + off + bj * HALF + n * 16) = w; }
                asm volatile("" ::: "memory"); }
    }
};

template <class Epi, class Sched, bool ALIGN_EPI = false, bool SP2 = false>
__device__ __forceinline__ void gemm_phase(PG8_LAS unsigned char* lds, const Gemm g, const Sched& S, const Epi& E, const int wave_id) {
    int tid_; asm volatile("v_mbcnt_lo_u32_b32 %0, -1, 0\n\tv_mbcnt_hi_u32_b32 %0, -1, %0" : "=v"(tid_)); tid_ += 64 * wave_id; asm volatile("" : "+v"(tid_));
    const int tid = tid_, wid = __builtin_amdgcn_readfirstlane(tid >> 6), lane = tid & 63, wr = wid >> 2, wc = wid & 3, fr = lane & 15, fq = lane >> 4;
    const int K = g.K, nt = K / BK;
    unsigned voffA[2], voffB[2];
#pragma unroll
    for (int i = 0; i < 2; ++i) { int R, C; stage_rc(tid * 16 + i * 8192, R, C); const int Rb = Epi::PERM ? ((R & ~31) + perm32(R & 31)) : R;
        voffA[i] = (unsigned)(R * K + C) * 2u; voffB[i] = (unsigned)(Rb * K + C) * 2u; }
    const size_t kstep = (size_t)(BK * 2);
    const size_t hstep = (size_t)HALF * K * 2;
    const size_t tstep = 2 * hstep;
    const unsigned ldsw = (unsigned)wid * 1024u;
    const int aoff = lds_byte(wr * 64 + fr, fq * 8), boff = lds_byte(wc * 32 + fr, fq * 8);
#define PG8_SA(b, h) (((b) * 2 + (h)) * HTB)
#define PG8_SB(b, h) ((4 + (b) * 2 + (h)) * HTB)
#define PG8_STAGE(bufoff, gbase, voff) do { _Pragma("unroll") for (int _i = 0; _i < 2; ++_i) \
        __builtin_amdgcn_global_load_lds((const unsigned*)((const char*)(gbase) + (voff)[_i]), (PG8_LAS unsigned*)(lds + (bufoff) + ldsw + _i * 8192), 16, 0, 0); } while (0)
#define PG8_LDA(dst, b, h) do { _Pragma("unroll") for (int m = 0; m < 4; ++m) _Pragma("unroll") for (int k = 0; k < 2; ++k) dst[m][k] = *(const PG8_LAS bf16x8*)(lds + PG8_SA(b, h) + aoff + m * 2048 + k * 1024); } while (0)
#define PG8_LDB(dst, b, h) do { _Pragma("unroll") for (int n = 0; n < 2; ++n) _Pragma("unroll") for (int k = 0; k < 2; ++k) dst[n][k] = *(const PG8_LAS bf16x8*)(lds + PG8_SB(b, h) + boff + n * 2048 + k * 1024); } while (0)
#define PG8_MMA(ai, bj, At, Bt) do { __builtin_amdgcn_s_setprio(1); _Pragma("unroll") for (int m = 0; m < 4; ++m) _Pragma("unroll") for (int n = 0; n < 2; ++n) _Pragma("unroll") for (int k = 0; k < 2; ++k) \
        acc[ai][bj][m][n] = __builtin_amdgcn_mfma_f32_16x16x32_bf16(Bt[n][k], At[m][k], acc[ai][bj][m][n], 0, 0, 0); __builtin_amdgcn_s_setprio(0); } while (0)
#define PG8_WAIT_V(n) asm volatile("s_waitcnt vmcnt(" #n ")" ::: "memory")
#define PG8_WAIT_L(n) asm volatile("s_waitcnt lgkmcnt(" #n ")" ::: "memory")
#define PG8_BAR __builtin_amdgcn_s_barrier()
#define PG8_SCHED __builtin_amdgcn_sched_barrier(0)
    Unit cur, nxt; int ui = 0;
    if (!S.next(0, cur)) return;
    f32x4 acc[2][2][4][2];
#pragma unroll
    for (int a = 0; a < 2; ++a)
#pragma unroll
        for (int b = 0; b < 2; ++b)
#pragma unroll
            for (int m = 0; m < 4; ++m)
#pragma unroll
                for (int n = 0; n < 2; ++n) acc[a][b][m][n] = (f32x4){0.f, 0.f, 0.f, 0.f};
    bf16x8 At[4][2], B0[2][2], B1[2][2];
    const char* cA = (const char*)g.A + (size_t)cur.pm * tstep; const char* cB = (const char*)g.Bt + (size_t)cur.pn * tstep;
    S.a_ready(cur);
    if constexpr (SP2) {
        PG8_STAGE(PG8_SB(0, 0), cB, voffB); PG8_STAGE(PG8_SB(0, 1), cB + hstep, voffB); PG8_STAGE(PG8_SA(0, 0), cA, voffA); PG8_STAGE(PG8_SA(0, 1), cA + hstep, voffA);
        if (wr == 1) PG8_BAR;
        PG8_WAIT_V(2); PG8_BAR;
        PG8_STAGE(PG8_SB(1, 0), cB + kstep, voffB); PG8_STAGE(PG8_SA(1, 0), cA + kstep, voffA); PG8_STAGE(PG8_SB(1, 1), cB + hstep + kstep, voffB);
        PG8_WAIT_V(6); PG8_BAR;
    } else {
        PG8_STAGE(PG8_SB(0, 0), cB, voffB); PG8_STAGE(PG8_SA(0, 0), cA, voffA); PG8_STAGE(PG8_SB(0, 1), cB + hstep, voffB); PG8_STAGE(PG8_SA(0, 1), cA + hstep, voffA);
        if (wr == 1) PG8_BAR;
        PG8_WAIT_V(4); PG8_BAR;
        PG8_STAGE(PG8_SB(1, 0), cB + kstep, voffB); PG8_STAGE(PG8_SA(1, 0), cA + kstep, voffA); PG8_STAGE(PG8_SB(1, 1), cB + hstep + kstep, voffB);
        PG8_WAIT_V(6); PG8_BAR;
    }
    for (;;) {
        const bool has_next = S.next(ui + 1, nxt);
        const char* nA = has_next ? (const char*)g.A + (size_t)nxt.pm * tstep : cA; const char* nB = has_next ? (const char*)g.Bt + (size_t)nxt.pn * tstep : cB;
        for (int t = 0; t < nt; t += 2) {
            const bool last = (t == nt - 2);
            const char* a1 = cA + (size_t)(t + 1) * kstep;
            const char* a2 = last ? nA : cA + (size_t)(t + 2) * kstep; const char* b2 = last ? nB : cB + (size_t)(t + 2) * kstep;
            const char* a3 = a2 + kstep; const char* b3 = b2 + kstep;
            if (last && has_next) S.a_ready(nxt);
            if constexpr (SP2) {
            PG8_LDB(B0, 0, 0); PG8_LDB(B1, 0, 1); PG8_SCHED; PG8_LDA(At, 0, 0); PG8_STAGE(PG8_SA(1, 1), a1 + hstep, voffA);
            PG8_WAIT_V(8); PG8_WAIT_L(0); PG8_BAR; PG8_MMA(0, 0, At, B0); PG8_MMA(0, 1, At, B1); PG8_BAR; PG8_SCHED;
            PG8_LDA(At, 0, 1); PG8_STAGE(PG8_SB(0, 0), b2, voffB); PG8_STAGE(PG8_SB(0, 1), b2 + hstep, voffB); PG8_STAGE(PG8_SA(0, 0), a2, voffA);
            PG8_WAIT_V(8); PG8_WAIT_L(0); PG8_BAR; PG8_MMA(1, 0, At, B0); PG8_MMA(1, 1, At, B1); PG8_BAR; PG8_SCHED;
            PG8_LDB(B0, 1, 0); PG8_LDB(B1, 1, 1); PG8_SCHED; PG8_LDA(At, 1, 0); PG8_STAGE(PG8_SA(0, 1), a2 + hstep, voffA);
            PG8_WAIT_V(8); PG8_WAIT_L(0); PG8_BAR; PG8_MMA(0, 0, At, B0); PG8_MMA(0, 1, At, B1); PG8_BAR; PG8_SCHED;
            PG8_LDA(At, 1, 1); PG8_STAGE(PG8_SB(1, 0), b3, voffB); PG8_STAGE(PG8_SB(1, 1), b3 + hstep, voffB); PG8_STAGE(PG8_SA(1, 0), a3, voffA);
            PG8_WAIT_V(8); PG8_WAIT_L(0); PG8_BAR; PG8_MMA(1, 0, At, B0); PG8_MMA(1, 1, At, B1); PG8_BAR; PG8_SCHED;
            } else {
            PG8_LDB(B0, 0, 0); PG8_SCHED; PG8_LDA(At, 0, 0); PG8_STAGE(PG8_SA(1, 1), a1 + hstep, voffA);
            PG8_WAIT_L(8); PG8_BAR; PG8_WAIT_L(0); PG8_MMA(0, 0, At, B0); PG8_BAR; PG8_SCHED;
            PG8_LDB(B1, 0, 1); PG8_STAGE(PG8_SB(0, 0), b2, voffB);
            PG8_BAR; PG8_WAIT_L(0); PG8_MMA(0, 1, At, B1); PG8_BAR;
            PG8_LDA(At, 0, 1); PG8_STAGE(PG8_SA(0, 0), a2, voffA);
            PG8_BAR; PG8_WAIT_L(0); PG8_MMA(1, 0, At, B0); PG8_BAR; PG8_SCHED;
            PG8_STAGE(PG8_SB(0, 1), b2 + hstep, voffB);
            PG8_WAIT_V(6); PG8_BAR; PG8_MMA(1, 1, At, B1); PG8_BAR;
            PG8_LDB(B0, 1, 0); PG8_SCHED; PG8_LDA(At, 1, 0); PG8_STAGE(PG8_SA(0, 1), a2 + hstep, voffA);
            PG8_WAIT_L(8); PG8_BAR; PG8_WAIT_L(0); PG8_MMA(0, 0, At, B0); PG8_BAR; PG8_SCHED;
            PG8_LDB(B1, 1, 1); PG8_STAGE(PG8_SB(1, 0), b3, voffB);
            PG8_BAR; PG8_WAIT_L(0); PG8_MMA(0, 1, At, B1); PG8_BAR;
            PG8_LDA(At, 1, 1); PG8_STAGE(PG8_SA(1, 0), a3, voffA);
            PG8_BAR; PG8_WAIT_L(0); PG8_MMA(1, 0, At, B0); PG8_BAR; PG8_SCHED;
            PG8_STAGE(PG8_SB(1, 1), b3 + hstep, voffB);
            PG8_WAIT_V(6); PG8_BAR; PG8_MMA(1, 1, At, B1); PG8_BAR;
            }
        }
        if constexpr (ALIGN_EPI) { if (wr == 0) PG8_BAR; }
        if constexpr (!Epi::AFTER_DRAIN) { E(acc, cur, wr, wc, fr, fq); S.done(cur); }
        if (!has_next) break;
#pragma unroll
        for (int a = 0; a < 2; ++a)
#pragma unroll
            for (int b = 0; b < 2; ++b)
#pragma unroll
                for (int m = 0; m < 4; ++m)
#pragma unroll
                    for (int n = 0; n < 2; ++n) acc[a][b][m][n] = (f32x4){0.f, 0.f, 0.f, 0.f};
        cur = nxt; cA = nA; cB = nB; ++ui;
        if constexpr (ALIGN_EPI) { if (wr == 1) PG8_BAR; }
    }
    PG8_WAIT_V(0);
    if constexpr (!ALIGN_EPI) { if (wr == 0) PG8_BAR; }
    PG8_BAR;
    if constexpr (Epi::AFTER_DRAIN) { E.fused(acc, cur, wr, wc, fr, fq, lds, wid, lane); S.done(cur); }
#undef PG8_SA
#undef PG8_SB
#undef PG8_STAGE
#undef PG8_LDA
#undef PG8_LDB
#undef PG8_MMA
#undef PG8_WAIT_V
#undef PG8_WAIT_L
#undef PG8_BAR
#undef PG8_SCHED
}
}
#define GAS __attribute__((address_space(1)))
#define LAS __attribute__((address_space(3)))
typedef unsigned short bf16;
typedef unsigned v4u __attribute__((ext_vector_type(4)));
typedef float f32x4 __attribute__((ext_vector_type(4)));
typedef short bf16x8 __attribute__((ext_vector_type(8)));
typedef GAS unsigned gu32;
typedef GAS unsigned long long gu64;
#define RLX_AGENT __ATOMIC_RELAXED, __HIP_MEMORY_SCOPE_AGENT
#define LDS_WAIT() asm volatile("s_waitcnt lgkmcnt(0)" ::: "memory")
#define VM_WAIT() asm volatile("s_waitcnt vmcnt(0)" ::: "memory")
__device__ __forceinline__ unsigned long long rt() { return __builtin_amdgcn_s_memrealtime(); }
__device__ __forceinline__ unsigned f2bf(float f) { unsigned u = __builtin_bit_cast(unsigned, f); return (u + 0x7fffu + ((u >> 16) & 1u)) >> 16; }
__device__ __forceinline__ unsigned pk2(float lo, float hi) { return f2bf(lo) | (f2bf(hi) << 16); }

#define XB_TMO      128
#define XB_XCNT(j)  (256  + 64 * (j))
#define XB_XSUB(j)  (1280 + 64 * (j))
#define XB_XGEN(j)  (2304 + 64 * (j))
#define XB_TOP      3328
#define XB_TOPGEN   3392
#define XCD_BAR_WORDS 3456
#define XB_SPIN_CAP (1u << 18)

__device__ __forceinline__ unsigned xb_ld(unsigned* p)              { return __hip_atomic_load(p, __ATOMIC_RELAXED, __HIP_MEMORY_SCOPE_AGENT); }
__device__ __forceinline__ unsigned xb_add(unsigned* p, unsigned v) { return __hip_atomic_fetch_add(p, v, __ATOMIC_RELAXED, __HIP_MEMORY_SCOPE_AGENT); }
__device__ __forceinline__ unsigned xb_xcc_id() { return (unsigned)__builtin_amdgcn_s_getreg((3 << 11) | 20) & 0xFu; }
#define XB_SPIN(cond, bar) do { unsigned _sp = 0; while (cond) { __builtin_amdgcn_s_sleep(1); \
    if ((++_sp & 255u) == 0u) { if (xb_ld(&(bar)[XB_TMO])) break; if (_sp > XB_SPIN_CAP) { atomicAdd(&(bar)[XB_TMO], 1u); break; } } } } while (0)

struct XcdBarrier {
    unsigned* bar; unsigned x;
    volatile LAS unsigned* st;
};

__device__ __forceinline__ XcdBarrier xcd_barrier_post(unsigned* bar, volatile LAS unsigned* st) {
    XcdBarrier b; b.bar = bar; b.x = xb_xcc_id(); b.st = st;
    if (threadIdx.x == 0) (void)xb_add(&bar[XB_XCNT(b.x)], 1u);
    return b;
}
__device__ __forceinline__ void xcd_barrier_complete(unsigned* bar, unsigned x, unsigned& nloc, unsigned& nx) {
    const unsigned G = gridDim.x * gridDim.y * gridDim.z;
    unsigned sum, cnt, mine, sp = 0u;
    for (;;) {
        sum = 0u; cnt = 0u; mine = 0u;
#pragma unroll
        for (unsigned j = 0; j < 16; ++j) { const unsigned c = xb_ld(&bar[XB_XCNT(j)]); sum += c; cnt += (c > 0u) ? 1u : 0u; mine = (j == x) ? c : mine; }
        if (sum == G) break;
        __builtin_amdgcn_s_sleep(1);
        if ((++sp & 255u) == 0u) { if (xb_ld(&bar[XB_TMO])) break; if (sp > XB_SPIN_CAP) { atomicAdd(&bar[XB_TMO], 1u); break; } }
    }
    nloc = mine > 0u ? mine : 1u; nx = cnt > 0u ? cnt : 1u;
}

__device__ __forceinline__ void xcd_barrier(const XcdBarrier& b) {
    asm volatile("s_waitcnt vmcnt(0)" ::: "memory");
    __syncthreads();
    if (threadIdx.x == 0) {
        unsigned* bar = b.bar;
        __builtin_amdgcn_s_waitcnt(0);
        unsigned nloc = b.st[0], nx = b.st[1];
        if (nloc == 0u) { xcd_barrier_complete(bar, b.x, nloc, nx); b.st[0] = nloc; b.st[1] = nx; }
        const unsigned old = xb_add(&bar[XB_XSUB(b.x)], 1u);
        const unsigned gen = old / nloc;
        if (old + 1u == (gen + 1u) * nloc) {
            __builtin_amdgcn_fence(__ATOMIC_RELEASE, "agent");
            asm volatile("s_waitcnt vmcnt(0)" ::: "memory");
            const unsigned og = xb_add(&bar[XB_TOP], 1u);
            const unsigned tg = og / nx;
            if (og + 1u == (tg + 1u) * nx) xb_add(&bar[XB_TOPGEN], 1u);
            else XB_SPIN(xb_ld(&bar[XB_TOPGEN]) == tg, bar);
            __builtin_amdgcn_fence(__ATOMIC_ACQUIRE, "agent");
            xb_add(&bar[XB_XGEN(b.x)], 1u);
            asm volatile("s_waitcnt vmcnt(0)" ::: "memory");
        } else {
            XB_SPIN(xb_ld(&bar[XB_XGEN(b.x)]) == gen, bar);
            __builtin_amdgcn_fence(__ATOMIC_ACQUIRE, "agent");
            asm volatile("s_waitcnt vmcnt(0)" ::: "memory");
        }
    }
    __syncthreads();
}

constexpr int D = 1024, BATCH = 16, SEQ = 2048, DEPTH = 2, M = BATCH * SEQ;
constexpr int PIN = 3224, PINP = 3584;
constexpr int C_VH = 3232;
constexpr int C_GQ = 0, C_GK = 192, C_GV = 384, C_GLR = 768, C_GG = 784, C_DQ = 1168, C_DK = 1488, C_DV = 1552, C_IQ = 1680, C_IK = 2192, C_IW = 2256, C_SQ = 2264, C_SK = 2584, C_SV = 2904;
constexpr int O_GLA = 0, O_DSA = 384, O_SB = 704;
constexpr int MEMT = 256, MKV = BATCH * MEMT, FF = 4096;
constexpr float LN_EPS = 1e-5f;
constexpr float ALPHA = 1.4142135623730951f;
constexpr float IDX_SCALE = 0.04419417382415922f;
constexpr float GLA_QSCALE = 0.14433756729740643f;
constexpr int NWAVES = 8;
constexpr int LDS_BYTES = 147456;
constexpr int RING_OFF = 0, RING_BYTES = 131072, LDSCTL_OFF = RING_BYTES, MISC_OFF = LDSCTL_OFF + 320;

constexpr size_t MiB = 1u << 20;
constexpr size_t WS_CTL = 0, CTL_ZERO_BYTES = 1 * MiB;
constexpr size_t LW_IN = 0, LW_OUT = (size_t)PINP * D, LW_MQ = LW_OUT + (size_t)D * D, LW_MKV = LW_MQ + (size_t)D * D, LW_MO = LW_MKV + 2 * (size_t)D * D,
                 LW_UP = LW_MO + (size_t)D * D, LW_DN = LW_UP + (size_t)FF * D, LW_END = LW_DN + (size_t)D * FF;
constexpr size_t WS_W = 2 * MiB;
constexpr size_t WS_MEMB = 68 * MiB;
constexpr size_t WS_KVMEM = 76 * MiB;
constexpr size_t WS_H = 108 * MiB;
constexpr size_t WS_PROJ = 172 * MiB;
constexpr size_t WS_OBUF = 396 * MiB;
constexpr size_t WS_QMEM = 172 * MiB;
constexpr size_t WS_MASK = 460 * MiB;
constexpr size_t WS_UBUF = 172 * MiB;
constexpr size_t WS_END = 468 * MiB;
static_assert(WS_W + 2 * LW_END * 2 <= WS_MEMB && WS_UBUF + (size_t)M * FF * 2 <= WS_OBUF + 64 * MiB && WS_PROJ + (size_t)M * PINP * 2 <= WS_OBUF, "ws map");
constexpr int CW_BAR = 4096;


__device__ __forceinline__ float bf2f(bf16 v) { return __uint_as_float((unsigned)v << 16); }
__device__ __forceinline__ float wave_sum(float v) {
#pragma unroll
    for (int o = 1; o < 64; o <<= 1) v += __shfl_xor(v, o);
    return v;
}
__device__ __forceinline__ float wave_max(float v) {
#pragma unroll
    for (int o = 1; o < 64; o <<= 1) v = fmaxf(v, __shfl_xor(v, o));
    return v;
}
__device__ __forceinline__ int wave_sum_i(int v) {
#pragma unroll
    for (int o = 1; o < 64; o <<= 1) v += __shfl_xor(v, o);
    return v;
}
__device__ __forceinline__ void unpack8(const uint4 u, float (&f)[8]) {
    f[0] = __uint_as_float(u.x << 16); f[1] = __uint_as_float(u.x & 0xffff0000u); f[2] = __uint_as_float(u.y << 16); f[3] = __uint_as_float(u.y & 0xffff0000u);
    f[4] = __uint_as_float(u.z << 16); f[5] = __uint_as_float(u.z & 0xffff0000u); f[6] = __uint_as_float(u.w << 16); f[7] = __uint_as_float(u.w & 0xffff0000u);
}


struct Frame { LAS unsigned char* lds; int wave, gw, NGW, G; };
__device__ __forceinline__ int lane_id_asm() { int l; asm volatile("v_mbcnt_lo_u32_b32 %0, -1, 0\n\tv_mbcnt_hi_u32_b32 %0, -1, %0" : "=v"(l)); return l; }
#define LANE_ID() lane_id_asm()
#define WAVE_SYNC() asm volatile("s_waitcnt lgkmcnt(0)" ::: "memory")
constexpr int CW_Q = 1024;

typedef float f32x16 __attribute__((ext_vector_type(16)));
typedef short s16x4 __attribute__((ext_vector_type(4)));
typedef float f32x2_t __attribute__((ext_vector_type(2)));
typedef __bf16 bf16x2_t __attribute__((ext_vector_type(2)));
__device__ __forceinline__ unsigned cvtpk(float lo, float hi) { f32x2_t v = {lo, hi}; bf16x2_t b = __builtin_convertvector(v, bf16x2_t); return __builtin_bit_cast(unsigned, b); }
__device__ __forceinline__ bf16x8 pack8(const f32x16& p, int s8) {
    v4u w; w.x = cvtpk(p[s8 + 0], p[s8 + 1]); w.y = cvtpk(p[s8 + 2], p[s8 + 3]); w.z = cvtpk(p[s8 + 4], p[s8 + 5]); w.w = cvtpk(p[s8 + 6], p[s8 + 7]);
    return __builtin_bit_cast(bf16x8, w);
}
typedef short v4i16_t __attribute__((ext_vector_type(4)));
__device__ __forceinline__ s16x4 tr_read(LAS const unsigned char* p) { return __builtin_bit_cast(s16x4, __builtin_amdgcn_ds_read_tr16_b64_v4i16((LAS v4i16_t*)p)); }
__device__ __forceinline__ float xhalf(float v) { return __shfl_xor(v, 32); }
#define CROW(reg) (((reg) & 3) + 8 * ((reg) >> 2))
constexpr float LOG2E = 1.4426950408889634f;

constexpr int ISC_RS = 2056;
__device__ __forceinline__ void ph_idx(const Frame& F, const bf16* __restrict__ proj, unsigned* __restrict__ maskbuf) {
    int lane = LANE_ID(); asm volatile("" : "+v"(lane));
    const int r = lane & 31, h = lane >> 5, wave = F.wave;
    LAS unsigned short* isc_lds = (LAS unsigned short*)F.lds;
    for (int it = (int)blockIdx.x; it < BATCH * 64; it += F.G) {
        const int rnd = it >> 8, w = it & 255, b = w >> 4, s = w & 15;
        const int qb = (rnd == 0) ? s : (rnd == 1) ? 31 - s : (rnd == 2) ? 32 + s : 63 - s;
        const int q0 = qb * 32; const size_t tok0 = (size_t)b * SEQ + q0;
        if (qb < 8) {
#pragma unroll
            for (int qq = 0; qq < 4; ++qq) { const int t = q0 + 4 * wave + qq; int nv = t + 1 - 32 * lane; nv = nv < 0 ? 0 : (nv > 32 ? 32 : nv);
                maskbuf[(tok0 + 4 * wave + qq) * 64 + lane] = (nv == 32) ? 0xffffffffu : ((1u << nv) - 1u); }
            continue;
        }
        {
            const bf16* qrow = proj + (tok0 + r) * PINP;
            typedef unsigned u32x2v __attribute__((ext_vector_type(2)));
            for (int kb = wave; kb <= qb; kb += 2 * NWAVES) {
                const bool v2 = (kb + NWAVES) <= qb; const int kb2 = v2 ? kb + NWAVES : kb;
                const bf16* krowA = proj + ((size_t)b * SEQ + kb * 32 + r) * PINP + C_IK + h * 8;
                const bf16* krowB = proj + ((size_t)b * SEQ + kb2 * 32 + r) * PINP + C_IK + h * 8;
                bf16x8 kfA[4], kfB[4];
#pragma unroll
                for (int ks = 0; ks < 4; ++ks) { kfA[ks] = *(const bf16x8*)(krowA + ks * 16); kfB[ks] = *(const bf16x8*)(krowB + ks * 16); }
                f32x16 iscA, iscB;
#pragma unroll
                for (int i = 0; i < 16; ++i) { iscA[i] = 0.f; iscB[i] = 0.f; }
                bf16x8 qn[4]; float iwn;
#pragma unroll
                for (int ks = 0; ks < 4; ++ks) qn[ks] = *(const bf16x8*)(qrow + C_IQ + ks * 16 + h * 8);
                iwn = bf2f(qrow[C_IW]) * IDX_SCALE;
#pragma unroll 1
                for (int hd = 0; hd < 8; ++hd) {
                    bf16x8 qc[4]; const float iwc = iwn;
#pragma unroll
                    for (int ks = 0; ks < 4; ++ks) qc[ks] = qn[ks];
                    const int hn = (hd + 1) & 7;
#pragma unroll
                    for (int ks = 0; ks < 4; ++ks) qn[ks] = *(const bf16x8*)(qrow + C_IQ + hn * 64 + ks * 16 + h * 8);
                    iwn = bf2f(qrow[C_IW + hn]) * IDX_SCALE;
                    f32x16 accA, accB;
#pragma unroll
                    for (int i = 0; i < 16; ++i) { accA[i] = 0.f; accB[i] = 0.f; }
#pragma unroll
                    for (int ks = 0; ks < 4; ++ks) { accA = __builtin_amdgcn_mfma_f32_32x32x16_bf16(kfA[ks], qc[ks], accA, 0, 0, 0); accB = __builtin_amdgcn_mfma_f32_32x32x16_bf16(kfB[ks], qc[ks], accB, 0, 0, 0); }
#pragma unroll
                    for (int i = 0; i < 16; ++i) { iscA[i] += fmaxf(accA[i], 0.f) * iwc; iscB[i] += fmaxf(accB[i], 0.f) * iwc; }
                }
#pragma unroll
                for (int g = 0; g < 4; ++g) { unsigned kk[4];
#pragma unroll
                    for (int i = 0; i < 4; ++i) { const unsigned u = (unsigned)__builtin_bit_cast(unsigned short, (_Float16)iscA[4 * g + i]); kk[i] = (u & 0x8000u) ? (~u & 0xffffu) : (u | 0x8000u); }
                    u32x2v o; o.x = kk[0] | (kk[1] << 16); o.y = kk[2] | (kk[3] << 16);
                    *(LAS u32x2v*)(isc_lds + r * ISC_RS + kb * 32 + 8 * g + 4 * h) = o; }
                if (v2) {
#pragma unroll
                    for (int g = 0; g < 4; ++g) { unsigned kk[4];
#pragma unroll
                        for (int i = 0; i < 4; ++i) { const unsigned u = (unsigned)__builtin_bit_cast(unsigned short, (_Float16)iscB[4 * g + i]); kk[i] = (u & 0x8000u) ? (~u & 0xffffu) : (u | 0x8000u); }
                        u32x2v o; o.x = kk[0] | (kk[1] << 16); o.y = kk[2] | (kk[3] << 16);
                        *(LAS u32x2v*)(isc_lds + r * ISC_RS + kb2 * 32 + 8 * g + 4 * h) = o; }
                }
            }
        }
        __syncthreads();
#pragma unroll 1
        for (int qq = 0; qq < 4; ++qq) {
            const int rq = 4 * wave + qq, t = q0 + rq;
            int nv = t + 1 - 32 * lane; nv = nv < 0 ? 0 : (nv > 32 ? 32 : nv);
            unsigned key[32];
            { const LAS v4u* src = (const LAS v4u*)(isc_lds + rq * ISC_RS + 32 * lane);
#pragma unroll
              for (int c = 0; c < 4; ++c) { const v4u v = src[c];
                  key[8 * c + 0] = v.x & 0xffffu; key[8 * c + 1] = v.x >> 16; key[8 * c + 2] = v.y & 0xffffu; key[8 * c + 3] = v.y >> 16;
                  key[8 * c + 4] = v.z & 0xffffu; key[8 * c + 5] = v.z >> 16; key[8 * c + 6] = v.w & 0xffffu; key[8 * c + 7] = v.w >> 16; } }
#pragma unroll
            for (int j = 0; j < 32; ++j) key[j] = (j < nv) ? key[j] : 0u;
            unsigned prefix = 0u;
#pragma unroll 1
            for (int bit = 15; bit >= 0; --bit) {
                const unsigned cand = prefix | (1u << bit); int c = 0;
#pragma unroll
                for (int j = 0; j < 32; ++j) c += (key[j] >= cand) ? 1 : 0;
                c = wave_sum_i(c);
                if (c >= 256) prefix = cand;
            }
            int cg = 0, ce = 0;
#pragma unroll
            for (int j = 0; j < 32; ++j) { cg += (key[j] > prefix) ? 1 : 0; ce += (key[j] == prefix) ? 1 : 0; }
            const int need = 256 - wave_sum_i(cg);
            int excl = ce;
#pragma unroll
            for (int off = 1; off < 64; off <<= 1) { const int y = __shfl_up(excl, off); if (lane >= off) excl += y; }
            excl -= ce;
            unsigned word = 0u; int run = excl;
#pragma unroll
            for (int j = 0; j < 32; ++j) { const bool gt = key[j] > prefix, eq = key[j] == prefix; const bool sel = gt || (eq && run < need); run += eq ? 1 : 0; word |= sel ? (1u << j) : 0u; }
            maskbuf[(tok0 + rq) * 64 + lane] = word;
        }
        __syncthreads();
    }
}

constexpr int VT_RS = 144;
__device__ __forceinline__ void pv_block(f32x16& o0, f32x16& o1, LAS const unsigned char* vt, const bf16x8 pb0, const bf16x8 pb1, int lane) {
    const int h = lane >> 5;
    LAS const unsigned char* base = vt + (4 * h + ((lane & 15) >> 2)) * VT_RS + (16 * ((lane >> 4) & 1) + 4 * (lane & 3)) * 2;
#pragma unroll
    for (int db = 0; db < 2; ++db) {
#pragma unroll
        for (int s = 0; s < 2; ++s) {
            const s16x4 lo = tr_read(base + (16 * s) * VT_RS + db * 64), hi = tr_read(base + (16 * s + 8) * VT_RS + db * 64);
            const bf16x8 vf = (bf16x8){lo[0], lo[1], lo[2], lo[3], hi[0], hi[1], hi[2], hi[3]};
            if (db == 0) o0 = __builtin_amdgcn_mfma_f32_32x32x16_bf16(vf, s == 0 ? pb0 : pb1, o0, 0, 0, 0);
            else         o1 = __builtin_amdgcn_mfma_f32_32x32x16_bf16(vf, s == 0 ? pb0 : pb1, o1, 0, 0, 0);
        }
    }
}
__device__ __forceinline__ void store_ot(bf16* dst, const f32x16& o0, const f32x16& o1, float sc, int h) {
#pragma unroll
    for (int g = 0; g < 4; ++g) {
        uint2 a; a.x = cvtpk(o0[4 * g] * sc, o0[4 * g + 1] * sc); a.y = cvtpk(o0[4 * g + 2] * sc, o0[4 * g + 3] * sc); *(uint2*)(dst + 8 * g + 4 * h) = a;
        uint2 c; c.x = cvtpk(o1[4 * g] * sc, o1[4 * g + 1] * sc); c.y = cvtpk(o1[4 * g + 2] * sc, o1[4 * g + 3] * sc); *(uint2*)(dst + 32 + 8 * g + 4 * h) = c;
    }
}
__device__ __forceinline__ void dsa_att_item(const bf16* __restrict__ proj, const unsigned* __restrict__ maskbuf, bf16* __restrict__ obuf, int b, int qb, int hd, LAS unsigned char* wl, int lane) {
    const int r = lane & 31, h = lane >> 5;
    const size_t tok0 = (size_t)b * SEQ + qb * 32; const int t = qb * 32 + r;
    const float slope[5] = {0.32987697769322355f, 0.1088188204120155f, 0.03589682359365735f, 0.011841535675862483f, 0.00390625f};
    const float c1 = 0.125f * LOG2E, c2 = slope[hd] * LOG2E;
    bf16x8 qf[4];
#pragma unroll
    for (int ks = 0; ks < 4; ++ks) qf[ks] = *(const bf16x8*)(proj + (tok0 + r) * PINP + C_DQ + hd * 64 + ks * 16 + h * 8);
    f32x16 o0, o1;
#pragma unroll
    for (int i = 0; i < 16; ++i) { o0[i] = 0.f; o1[i] = 0.f; }
    float m = -1e30f, l = 0.f;
    const unsigned* mrow = maskbuf + (tok0 + r) * 64;
    for (int kb = 0; kb <= qb; ++kb) {
        const int key0 = kb * 32;
        const bf16* kbase = proj + ((size_t)b * SEQ + key0) * PINP;
        v4u vst[4];
#pragma unroll
        for (int i = 0; i < 4; ++i) vst[i] = *(const v4u*)(kbase + (size_t)((lane >> 3) + 8 * i) * PINP + C_VH + hd * 64 + (lane & 7) * 8);
        bf16x8 kf[4];
#pragma unroll
        for (int ks = 0; ks < 4; ++ks) kf[ks] = *(const bf16x8*)(kbase + (size_t)r * PINP + C_DK + ks * 16 + h * 8);
        const unsigned word = mrow[kb] >> (4 * h);
        f32x16 S;
#pragma unroll
        for (int i = 0; i < 16; ++i) S[i] = 0.f;
#pragma unroll
        for (int ks = 0; ks < 4; ++ks) S = __builtin_amdgcn_mfma_f32_32x32x16_bf16(kf[ks], qf[ks], S, 0, 0, 0);
        asm volatile("" ::: "memory");
#pragma unroll
        for (int i = 0; i < 4; ++i) *(LAS v4u*)(wl + ((lane >> 3) + 8 * i) * VT_RS + (lane & 7) * 16) = vst[i];
        asm volatile("" ::: "memory");
        const float dist0 = (float)(t - key0 - 4 * h);
        float mx = -INFINITY;
#pragma unroll
        for (int i = 0; i < 16; ++i) { const bool sel = (word >> CROW(i)) & 1u; S[i] = sel ? (S[i] * c1 - c2 * (dist0 - (float)CROW(i))) : -INFINITY; mx = fmaxf(mx, S[i]); }
        mx = fmaxf(mx, xhalf(mx));
        const float mn = fmaxf(m, mx), alpha = __builtin_amdgcn_exp2f(m - mn);
        float ls = 0.f;
#pragma unroll
        for (int i = 0; i < 16; ++i) { S[i] = __builtin_amdgcn_exp2f(S[i] - mn); ls += S[i]; }
        ls += xhalf(ls);
        l = l * alpha + ls; m = mn;
#pragma unroll
        for (int i = 0; i < 16; ++i) { o0[i] *= alpha; o1[i] *= alpha; }
        const bf16x8 pb0 = pack8(S, 0), pb1 = pack8(S, 8);
        pv_block(o0, o1, wl, pb0, pb1, lane);
        asm volatile("" ::: "memory");
    }
    store_ot(obuf + (tok0 + r) * D + O_DSA + hd * 64, o0, o1, 1.f / l, h);
}
__device__ __forceinline__ void ph_dsa_att(const Frame& F, const bf16* __restrict__ proj, const unsigned* __restrict__ maskbuf, bf16* __restrict__ obuf, unsigned* counter) {
    int lane = LANE_ID(); asm volatile("" : "+v"(lane));
    LAS unsigned char* wl = F.lds + F.wave * 16384;
    for (;;) {
        unsigned it = 0; if (lane == 0) it = atomicAdd(counter, 1u);
        it = (unsigned)__builtin_amdgcn_readfirstlane((int)it);
        if (it >= (unsigned)(BATCH * 64 * 5)) break;
        const int qb = 63 - (int)(it / 80u), rem = (int)(it % 80u);
        dsa_att_item(proj, maskbuf, obuf, rem / 5, qb, rem % 5, wl, lane);
    }
}
__device__ __forceinline__ void fold_vh_item(const float* __restrict__ w_in, const float* __restrict__ wuv, bf16* __restrict__ Wt, int item, int lane) {
    const int hd = item / (D / 8), k0 = (item % (D / 8)) * 8;
    float acc[8];
#pragma unroll
    for (int i = 0; i < 8; ++i) acc[i] = 0.f;
    for (int c = 0; c < 128; ++c) { const float u = wuv[((size_t)hd * 128 + c) * 64 + lane];
#pragma unroll
        for (int i = 0; i < 8; ++i) acc[i] += u * w_in[(size_t)(k0 + i) * PIN + C_DV + c]; }
    v4u o; o.x = pk2(acc[0], acc[1]); o.y = pk2(acc[2], acc[3]); o.z = pk2(acc[4], acc[5]); o.w = pk2(acc[6], acc[7]);
    *(v4u*)(Wt + (size_t)(C_VH + hd * 64 + lane) * D + k0) = o;
}


__device__ __forceinline__ void tr_item(const float* __restrict__ W, int K, int N, int Npad, bf16* __restrict__ WT, LAS float* scr, int item, int lane) {
    const int nblk = Npad / 32, kb = item / nblk, nb = item % nblk, k0 = 64 * kb, n0 = 32 * nb;
    const int n = n0 + (lane & 31);
#pragma unroll 8
    for (int i = 0; i < 32; ++i) { const int kk = 2 * i + (lane >> 5); scr[kk * 33 + (lane & 31)] = (n < N) ? W[(size_t)(k0 + kk) * N + n] : 0.f; }
    WAVE_SYNC();
    const int c = lane & 7;
#pragma unroll
    for (int j = 0; j < 4; ++j) { const int nn = (lane >> 3) + 8 * j; const LAS float* s = scr + (8 * c) * 33 + nn;
        v4u o; o.x = pk2(s[0 * 33], s[1 * 33]); o.y = pk2(s[2 * 33], s[3 * 33]); o.z = pk2(s[4 * 33], s[5 * 33]); o.w = pk2(s[6 * 33], s[7 * 33]);
        *(v4u*)(WT + (size_t)(n0 + nn) * K + k0 + 8 * c) = o; }
    WAVE_SYNC();
}
__device__ __forceinline__ void ln_row(const float* src, const float* __restrict__ g, const float* __restrict__ b, bf16* dstb, float* dstf, int lane) {
    const float4* xr = (const float4*)src + lane;
    float4 v[4]; float s = 0.f;
#pragma unroll
    for (int j = 0; j < 4; ++j) { v[j] = xr[64 * j]; s += (v[j].x + v[j].y) + (v[j].z + v[j].w); }
    const float mean = wave_sum(s) * (1.f / D); float s2 = 0.f;
#pragma unroll
    for (int j = 0; j < 4; ++j) { v[j].x -= mean; v[j].y -= mean; v[j].z -= mean; v[j].w -= mean; s2 += (v[j].x * v[j].x + v[j].y * v[j].y) + (v[j].z * v[j].z + v[j].w * v[j].w); }
    const float rstd = 1.f / sqrtf(wave_sum(s2) * (1.f / D) + LN_EPS);
#pragma unroll
    for (int j = 0; j < 4; ++j) {
        const float4 gg = ((const float4*)g)[lane + 64 * j], bb = ((const float4*)b)[lane + 64 * j];
        float4 y; y.x = v[j].x * rstd * gg.x + bb.x; y.y = v[j].y * rstd * gg.y + bb.y; y.z = v[j].z * rstd * gg.z + bb.z; y.w = v[j].w * rstd * gg.w + bb.w;
        uint2 o; o.x = pk2(y.x, y.y); o.y = pk2(y.z, y.w); ((uint2*)dstb)[lane + 64 * j] = o;
        if (dstf) ((float4*)dstf)[lane + 64 * j] = y;
    }
}
__device__ __forceinline__ void ph_ln(const Frame& F, const float* src, const float* g, const float* b, bf16* dstb, float* dstf) {
    int lane = LANE_ID(); asm volatile("" : "+v"(lane));
    for (int m = F.gw; m < M; m += F.NGW) ln_row(src + (size_t)m * D, g, b, dstb + (size_t)m * D, dstf ? dstf + (size_t)m * D : (float*)nullptr, lane);
}
__device__ __forceinline__ void ph_prologue(const Frame& F, const float* const* in, unsigned char* ws) {
    int lane_ = LANE_ID(); asm volatile("" : "+v"(lane_));
    LAS float* scr = (LAS float*)(F.lds + F.wave * 16384);
    for (int l = 0; l < DEPTH; ++l) {
        bf16* Wl = (bf16*)(ws + WS_W) + (size_t)l * LW_END;
        for (int it = F.gw; it < (D / 64) * (C_VH / 32); it += F.NGW) tr_item(in[4] + (size_t)l * D * PIN, D, PIN, C_VH, Wl + LW_IN, scr, it, lane_);
        for (int it = F.gw; it < 5 * (D / 8); it += F.NGW) fold_vh_item(in[4] + (size_t)l * D * PIN, in[8] + (size_t)l * 5 * 128 * 64, Wl + LW_IN, it, lane_);
        for (int i = F.gw * 64 + lane_; i < (PINP - C_VH - 320) * D / 8; i += F.NGW * 64) ((v4u*)(Wl + LW_IN + (size_t)(C_VH + 320) * D))[i] = (v4u){0u, 0u, 0u, 0u};
        for (int it = F.gw; it < (D / 64) * (D / 32); it += F.NGW) tr_item(in[9] + (size_t)l * D * D, D, D, D, Wl + LW_OUT, scr, it, lane_);
        for (int it = F.gw; it < (D / 64) * (D / 32); it += F.NGW) tr_item(in[12] + (size_t)l * D * D, D, D, D, Wl + LW_MQ, scr, it, lane_);
        for (int it = F.gw; it < (D / 64) * (2 * D / 32); it += F.NGW) tr_item(in[13] + (size_t)l * D * 2 * D, D, 2 * D, 2 * D, Wl + LW_MKV, scr, it, lane_);
        for (int it = F.gw; it < (D / 64) * (D / 32); it += F.NGW) tr_item(in[14] + (size_t)l * D * D, D, D, D, Wl + LW_MO, scr, it, lane_);
        for (int it = F.gw; it < (D / 64) * (FF / 32); it += F.NGW) tr_item(in[17] + (size_t)l * D * FF, D, FF, FF, Wl + LW_UP, scr, it, lane_);
        for (int it = F.gw; it < (FF / 64) * (D / 32); it += F.NGW) tr_item(in[19] + (size_t)l * FF * D, FF, D, D, Wl + LW_DN, scr, it, lane_);
    }
    { const float4* src = (const float4*)in[1]; uint2* dst = (uint2*)(ws + WS_MEMB);
      for (size_t i = (size_t)F.gw * 64 + lane_; i < (size_t)MKV * D / 4; i += (size_t)F.NGW * 64) { const float4 v = src[i]; uint2 o; o.x = pk2(v.x, v.y); o.y = pk2(v.z, v.w); dst[i] = o; } }
    ph_ln(F, in[0], in[2], in[3], (bf16*)(ws + WS_H), (float*)nullptr);
}
__device__ __forceinline__ void ph_gla_gate(const Frame& F, const bf16* __restrict__ proj, const float* __restrict__ w2, const float* __restrict__ gb, float* __restrict__ gl) {
    int lane = LANE_ID(); asm volatile("" : "+v"(lane));
    for (size_t idx = (size_t)F.gw * 64 + lane; idx < (size_t)M * 192; idx += (size_t)F.NGW * 64) {
        const int t = (int)(idx / 192), j = (int)(idx % 192);
        float acc = 0.f;
#pragma unroll
        for (int r = 0; r < 16; ++r) acc += bf2f(proj[(size_t)t * PINP + C_GLR + r]) * w2[r * 192 + j];
        acc += gb[j];
        const float ls = fminf(acc, 0.f) - log1pf(expf(-fabsf(acc)));
        gl[idx] = ls * (1.f / 16.f);
    }
}
__device__ __forceinline__ void ph_gla_rec(const Frame& F, const bf16* __restrict__ proj, const float* __restrict__ gl, float* __restrict__ oraw) {
    if ((int)blockIdx.x >= BATCH * 4) return;
    int tid = LANE_ID() + 64 * F.wave; asm volatile("" : "+v"(tid)); const int b = blockIdx.x >> 2, h = blockIdx.x & 3;
    LAS float* sq = (LAS float*)F.lds; LAS float* sk = sq + 32 * 48; LAS float* sa = sk + 32 * 48;
    float S[48];
#pragma unroll
    for (int d = 0; d < 48; ++d) S[d] = 0.f;
    for (int t0 = 0; t0 < SEQ; t0 += 32) {
        __syncthreads();
        for (int i = tid; i < 32 * 48; i += NWAVES * 64) { const int tt = i / 48, d = i % 48; const size_t row = (size_t)b * SEQ + t0 + tt;
            sq[i] = bf2f(proj[row * PINP + C_GQ + h * 48 + d]) * GLA_QSCALE; sk[i] = bf2f(proj[row * PINP + C_GK + h * 48 + d]); sa[i] = expf(gl[row * 192 + h * 48 + d]); }
        __syncthreads();
        if (tid < 96) {
            for (int tt = 0; tt < 32; ++tt) { const size_t row = (size_t)b * SEQ + t0 + tt; const float v = bf2f(proj[row * PINP + C_GV + h * 96 + tid]); float o = 0.f;
#pragma unroll
                for (int d = 0; d < 48; ++d) { S[d] = sa[tt * 48 + d] * S[d] + sk[tt * 48 + d] * v; o += sq[tt * 48 + d] * S[d]; }
                oraw[row * 384 + h * 96 + tid] = o; }
        }
    }
    __syncthreads();
}
__device__ __forceinline__ void ph_gla_fin(const Frame& F, const bf16* __restrict__ proj, const float* __restrict__ oraw, const float* __restrict__ ng, bf16* __restrict__ obuf) {
    int lane = LANE_ID(); asm volatile("" : "+v"(lane));
    for (int gw = F.gw; gw < M * 4; gw += F.NGW) {
        const int t = gw >> 2, h = gw & 3;
        const float o0 = oraw[(size_t)t * 384 + h * 96 + lane], o1 = lane < 32 ? oraw[(size_t)t * 384 + h * 96 + 64 + lane] : 0.f;
        const float ss = wave_sum(o0 * o0 + o1 * o1);
        const float r = 1.f / sqrtf(ss * (1.f / 96.f) + LN_EPS);
        { const float g = bf2f(proj[(size_t)t * PINP + C_GG + h * 96 + lane]); const float y = o0 * r * ng[lane] * (g / (1.f + expf(-g))); obuf[(size_t)t * D + O_GLA + h * 96 + lane] = (bf16)f2bf(y); }
        if (lane < 32) { const float g = bf2f(proj[(size_t)t * PINP + C_GG + h * 96 + 64 + lane]); const float y = o1 * r * ng[64 + lane] * (g / (1.f + expf(-g))); obuf[(size_t)t * D + O_GLA + h * 96 + 64 + lane] = (bf16)f2bf(y); }
    }
}
__device__ __forceinline__ void ph_sb(const Frame& F, const bf16* __restrict__ proj, bf16* __restrict__ obuf) {
    int lane = LANE_ID(); asm volatile("" : "+v"(lane));
    for (int gw = F.gw; gw < M * 5; gw += F.NGW) {
        const int tok = gw / 5, hd = gw % 5, b = tok / SEQ, t = tok % SEQ;
        float q[64];
        { const uint4* qr = (const uint4*)(proj + (size_t)tok * PINP + C_SQ + hd * 64);
#pragma unroll
          for (int i = 0; i < 8; ++i) { float f[8]; unpack8(qr[i], f);
#pragma unroll
              for (int e = 0; e < 8; ++e) q[8 * i + e] = f[e] * 0.125f; } }
        float o = 0.f, carry = 0.f;
        for (int base = t - 1; base >= 0; base -= 64) {
            const int s = base - lane; const bool valid = s >= 0;
            float z = 0.f;
            if (valid) { const uint4* kr = (const uint4*)(proj + ((size_t)b * SEQ + s) * PINP + C_SK + hd * 64);
#pragma unroll
                for (int i = 0; i < 8; ++i) { float f[8]; unpack8(kr[i], f);
#pragma unroll
                    for (int e = 0; e < 8; ++e) z += q[8 * i + e] * f[e]; } }
            const float sp = fmaxf(z, 0.f) + log1pf(expf(-fabsf(z)));
            const float l = valid ? -sp : 0.f;
            float inc = l;
#pragma unroll
            for (int off = 1; off < 64; off <<= 1) { const float y = __shfl_up(inc, off); if (lane >= off) inc += y; }
            const float w = valid ? expf((z - sp) + (inc - l) + carry) : 0.f;
            const float tot = __shfl(inc, 63);
            const int nv = (base + 1 < 64) ? base + 1 : 64;
            for (int i = 0; i < nv; ++i) { const float wi = __shfl(w, i); o += wi * bf2f(proj[((size_t)b * SEQ + (base - i)) * PINP + C_SV + hd * 64 + lane]); }
            carry += tot;
            if (carry < -104.f) break;
        }
        obuf[(size_t)tok * D + O_SB + hd * 64 + lane] = (bf16)f2bf(o);
    }
}
__device__ __forceinline__ void ph_dsa(const Frame& F, const bf16* __restrict__ proj, const float* __restrict__ wuv, bf16* __restrict__ obuf) {
    int lane = LANE_ID(); asm volatile("" : "+v"(lane));
    LAS unsigned char* wl = F.lds + F.wave * 12544;
    LAS unsigned* s_key = (LAS unsigned*)wl;
    LAS float* s_p = (LAS float*)wl;
    LAS float* s_ol = (LAS float*)(wl + 5120);
    LAS float* s_iq = (LAS float*)(wl + 8192);
    LAS float* s_q = (LAS float*)(wl + 10240);
    LAS int* s_idx = (LAS int*)(wl + 11520);
    const unsigned long long lt_mask = (lane == 0) ? 0ull : (~0ull >> (64 - lane));
    for (int tok = F.gw; tok < M; tok += F.NGW) {
        const int b = tok / SEQ, t = tok % SEQ;
        const bf16* prow = proj + (size_t)tok * PINP;
        WAVE_SYNC();
        for (int i = lane; i < 512; i += 64) s_iq[i] = bf2f(prow[C_IQ + i]);
        for (int i = lane; i < 320; i += 64) s_q[i] = bf2f(prow[C_DQ + i]);
        float iw[8];
#pragma unroll
        for (int h = 0; h < 8; ++h) iw[h] = bf2f(prow[C_IW + h]);
        WAVE_SYNC();
        for (int j = 0; j < 32; ++j) {
            const int s = lane + 64 * j; unsigned kk = 0u;
            if (s <= t) {
                const uint4* kr = (const uint4*)(proj + ((size_t)b * SEQ + s) * PINP + C_IK);
                float dot[8];
#pragma unroll
                for (int h = 0; h < 8; ++h) dot[h] = 0.f;
#pragma unroll 1
                for (int i = 0; i < 8; ++i) { float f[8]; unpack8(kr[i], f);
#pragma unroll
                    for (int h = 0; h < 8; ++h)
#pragma unroll
                        for (int e = 0; e < 8; ++e) dot[h] += s_iq[h * 64 + 8 * i + e] * f[e]; }
                float isc = 0.f;
#pragma unroll
                for (int h = 0; h < 8; ++h) isc += fmaxf(dot[h], 0.f) * iw[h];
                isc *= IDX_SCALE;
                const unsigned u = __float_as_uint(isc); kk = (u & 0x80000000u) ? ~u : (u | 0x80000000u);
            }
            s_key[s] = kk;
        }
        WAVE_SYNC();
        int nsel;
        if (t + 1 <= 256) {
            nsel = t + 1;
            for (int i = lane; i < nsel; i += 64) s_idx[i] = i;
        } else {
            unsigned prefix = 0u;
            for (int bit = 31; bit >= 0; --bit) {
                const unsigned cand = prefix | (1u << bit); int c = 0;
                for (int j = 0; j < 32; ++j) c += (s_key[lane + 64 * j] >= cand) ? 1 : 0;
                c = wave_sum_i(c);
                if (c >= 256) prefix = cand;
            }
            int cg = 0;
            for (int j = 0; j < 32; ++j) cg += (s_key[lane + 64 * j] > prefix) ? 1 : 0;
            cg = wave_sum_i(cg);
            const int need = 256 - cg;
            int base_sel = 0, base_tie = 0;
            for (int j = 0; j < 32; ++j) {
                const unsigned k = s_key[lane + 64 * j]; const bool gt = k > prefix, eq = (k == prefix);
                const unsigned long long beq = __ballot(eq); const int tie_rank = base_tie + __popcll(beq & lt_mask);
                const bool sel = gt || (eq && tie_rank < need);
                const unsigned long long bs = __ballot(sel); const int pos = base_sel + __popcll(bs & lt_mask);
                if (sel) s_idx[pos] = lane + 64 * j;
                base_sel += __popcll(bs); base_tie += __popcll(beq);
            }
            nsel = 256;
        }
        WAVE_SYNC();
        const float slope[5] = {0.32987697769322355f, 0.1088188204120155f, 0.03589682359365735f, 0.011841535675862483f, 0.00390625f};
#pragma unroll 1
        for (int m = 0; m < 4; ++m) {
            const int kidx = lane + 64 * m;
            float dot[5];
#pragma unroll
            for (int h = 0; h < 5; ++h) dot[h] = -INFINITY;
            if (kidx < nsel) {
                const int si = s_idx[kidx];
                const uint4* kr = (const uint4*)(proj + ((size_t)b * SEQ + si) * PINP + C_DK);
#pragma unroll
                for (int h = 0; h < 5; ++h) dot[h] = 0.f;
#pragma unroll 1
                for (int i = 0; i < 8; ++i) { float f[8]; unpack8(kr[i], f);
#pragma unroll
                    for (int h = 0; h < 5; ++h)
#pragma unroll
                        for (int e = 0; e < 8; ++e) dot[h] += s_q[h * 64 + 8 * i + e] * f[e]; }
#pragma unroll
                for (int h = 0; h < 5; ++h) dot[h] = dot[h] * 0.125f - slope[h] * (float)(t - si);
            }
#pragma unroll
            for (int h = 0; h < 5; ++h) s_p[h * 256 + kidx] = dot[h];
        }
        WAVE_SYNC();
#pragma unroll 1
        for (int h = 0; h < 5; ++h) {
            float sc[4];
#pragma unroll
            for (int m = 0; m < 4; ++m) sc[m] = s_p[h * 256 + lane + 64 * m];
            const float mx = wave_max(fmaxf(fmaxf(sc[0], sc[1]), fmaxf(sc[2], sc[3])));
            float e[4], se = 0.f;
#pragma unroll
            for (int m = 0; m < 4; ++m) { e[m] = (lane + 64 * m < nsel) ? expf(sc[m] - mx) : 0.f; se += e[m]; }
            const float inv = 1.f / wave_sum(se);
#pragma unroll
            for (int m = 0; m < 4; ++m) s_p[h * 256 + lane + 64 * m] = e[m] * inv;
        }
        WAVE_SYNC();
        float a0[5], a1[5];
#pragma unroll
        for (int h = 0; h < 5; ++h) { a0[h] = 0.f; a1[h] = 0.f; }
        for (int k = 0; k < nsel; ++k) {
            const int si = s_idx[k]; const bf16* vr = proj + ((size_t)b * SEQ + si) * PINP + C_DV;
            const float v0 = bf2f(vr[lane]), v1 = bf2f(vr[lane + 64]);
#pragma unroll
            for (int h = 0; h < 5; ++h) { const float p = s_p[h * 256 + k]; a0[h] += p * v0; a1[h] += p * v1; }
        }
        WAVE_SYNC();
#pragma unroll
        for (int h = 0; h < 5; ++h) { s_ol[h * 128 + lane] = a0[h]; s_ol[h * 128 + lane + 64] = a1[h]; }
        WAVE_SYNC();
#pragma unroll
        for (int h = 0; h < 5; ++h) { float o = 0.f;
            for (int c = 0; c < 128; ++c) o += s_ol[h * 128 + c] * wuv[(h * 128 + c) * 64 + lane];
            obuf[(size_t)tok * D + O_DSA + h * 64 + lane] = (bf16)f2bf(o); }
    }
}
__device__ __forceinline__ void ph_memattn(const Frame& F, const bf16* __restrict__ qmem, const bf16* __restrict__ kv, bf16* __restrict__ obuf) {
    int lane = LANE_ID(); asm volatile("" : "+v"(lane));
    LAS float* s_q = (LAS float*)(F.lds + F.wave * 2048); LAS float* s_p = s_q + 256;
    for (int gw = F.gw; gw < M * 4; gw += F.NGW) {
        const int tok = gw >> 2, hd = gw & 3, b = tok / SEQ;
        WAVE_SYNC();
#pragma unroll
        for (int i = 0; i < 4; ++i) s_q[lane + 64 * i] = bf2f(qmem[(size_t)tok * D + hd * 256 + lane + 64 * i]);
        WAVE_SYNC();
        float sc[4];
#pragma unroll
        for (int j = 0; j < 4; ++j) { const int m = lane + 64 * j; const uint4* kr = (const uint4*)(kv + ((size_t)b * MEMT + m) * 2048 + hd * 256); float dot = 0.f;
            for (int i = 0; i < 32; ++i) { float f[8]; unpack8(kr[i], f);
#pragma unroll
                for (int e = 0; e < 8; ++e) dot += s_q[8 * i + e] * f[e]; }
            sc[j] = dot * 0.0625f; }
        const float mx = wave_max(fmaxf(fmaxf(sc[0], sc[1]), fmaxf(sc[2], sc[3])));
        float e[4], se = 0.f;
#pragma unroll
        for (int j = 0; j < 4; ++j) { e[j] = expf(sc[j] - mx); se += e[j]; }
        const float inv = 1.f / wave_sum(se);
#pragma unroll
        for (int j = 0; j < 4; ++j) s_p[lane + 64 * j] = e[j] * inv;
        WAVE_SYNC();
        float o[4] = {0.f, 0.f, 0.f, 0.f};
        for (int m = 0; m < MEMT; ++m) { const float p = s_p[m]; const bf16* vr = kv + ((size_t)b * MEMT + m) * 2048 + 1024 + hd * 256;
#pragma unroll
            for (int i = 0; i < 4; ++i) o[i] += p * bf2f(vr[lane + 64 * i]); }
#pragma unroll
        for (int i = 0; i < 4; ++i) obuf[(size_t)tok * D + hd * 256 + lane + 64 * i] = (bf16)f2bf(o[i]);
    }
}

struct Args { const float* in[23]; float* out; unsigned char* ws; int ph_lo, ph_hi; };
static_assert(sizeof(Args) == 23 * 8 + 8 + 8 + 8, "Args has no padding");
namespace cg = cooperative_groups;

constexpr int PH_PRO = 0, PH_KV = 1, PH_L0 = 2, PH_PER_LAYER = 13, PH_END = PH_L0 + DEPTH * PH_PER_LAYER;

#define GEMM_PHASE(EPI, Aptr, Bptr, MM, NN, KK, ...) do { pg8::Gemm g{Aptr, Bptr, MM, NN, KK}; pg8::StaticOrder S; S.init(MM, NN, G, (int)blockIdx.x); \
    EPI E{__VA_ARGS__}; pg8::gemm_phase<EPI, pg8::StaticOrder, true, true>(L + RING_OFF, g, S, E, F.wave); } while (0)

__global__ void __launch_bounds__(NWAVES * 64, 2) mk_fwd(Args args) {
    extern __shared__ __attribute__((aligned(16))) unsigned char lds[];
    LAS unsigned char* L = (LAS unsigned char*)lds;
    cg::grid_group grid = cg::this_grid();
    unsigned char* ws = args.ws;
    const int G = gridDim.x;
    Frame F; F.lds = L; F.wave = __builtin_amdgcn_readfirstlane((int)threadIdx.x >> 6); F.G = G; F.gw = (int)blockIdx.x * NWAVES + F.wave; F.NGW = G * NWAVES;
    bf16* Hb = (bf16*)(ws + WS_H); bf16* PROJ = (bf16*)(ws + WS_PROJ); bf16* OBUF = (bf16*)(ws + WS_OBUF); bf16* QMEM = (bf16*)(ws + WS_QMEM); bf16* UBUF = (bf16*)(ws + WS_UBUF);
    unsigned* MASK = (unsigned*)(ws + WS_MASK); bf16* MEMB = (bf16*)(ws + WS_MEMB); bf16* KVM = (bf16*)(ws + WS_KVMEM);
    float* GLOG = args.out; float* ORAW = args.out + (size_t)8 * 1024 * 1024;
    const int lo = args.ph_lo, hi = args.ph_hi;
#define IN(k) (lo <= (k) && (k) < hi)
#define SEAM(k) do { if (IN(k) && IN((k) + 1)) grid.sync(); } while (0)
    if (IN(PH_PRO)) { ph_prologue(F, args.in, ws); __syncthreads(); }
    SEAM(PH_PRO);
    if (IN(PH_KV)) {
#pragma unroll 1
        for (int l = 0; l < DEPTH; ++l) { const bf16* Wl = (const bf16*)(ws + WS_W) + (size_t)l * LW_END;
            GEMM_PHASE(pg8::EpiBf16<0>, MEMB, Wl + LW_MKV, MKV, 2 * D, D, KVM + (size_t)l * MKV * 2 * D, 2 * D, nullptr, 0, 0, 1.f); }
    }
    SEAM(PH_KV);
#pragma unroll 1
    for (int l = 0; l < DEPTH; ++l) {
        const int p0 = PH_L0 + l * PH_PER_LAYER; const bf16* Wl = (const bf16*)(ws + WS_W) + (size_t)l * LW_END;
        if (IN(p0 + 0)) GEMM_PHASE(pg8::EpiBf16<0>, Hb, Wl + LW_IN, M, PINP, D, PROJ, PINP, nullptr, 0, 0, 1.f);
        SEAM(p0 + 0);
        if (IN(p0 + 1)) { ph_gla_gate(F, PROJ, args.in[5] + (size_t)l * 16 * 192, args.in[6] + (size_t)l * 192, GLOG);
                          ph_idx(F, PROJ, MASK); ph_sb(F, PROJ, OBUF); __syncthreads(); }
        SEAM(p0 + 1);
        if (IN(p0 + 2)) { ph_gla_rec(F, PROJ, GLOG, ORAW); ph_dsa_att(F, PROJ, MASK, OBUF, (unsigned*)(ws + WS_CTL) + CW_Q + 64 * (l * 4 + 0)); __syncthreads(); }
        SEAM(p0 + 2);
        if (IN(p0 + 3)) ph_gla_fin(F, PROJ, ORAW, args.in[7] + (size_t)l * 96, OBUF);
        SEAM(p0 + 3);
        if (IN(p0 + 4)) GEMM_PHASE(pg8::EpiY, OBUF, Wl + LW_OUT, M, D, D, args.out, Hb, D, nullptr, ALPHA);
        SEAM(p0 + 4);
        if (IN(p0 + 5)) ph_ln(F, args.out, args.in[10] + (size_t)l * D, args.in[11] + (size_t)l * D, Hb, (float*)nullptr);
        SEAM(p0 + 5);
        if (IN(p0 + 6)) GEMM_PHASE(pg8::EpiBf16<0>, Hb, Wl + LW_MQ, M, D, D, QMEM, D, nullptr, 0, 0, 1.f);
        SEAM(p0 + 6);
        if (IN(p0 + 7)) { ph_memattn(F, QMEM, KVM + (size_t)l * MKV * 2 * D, OBUF); __syncthreads(); }
        SEAM(p0 + 7);
        if (IN(p0 + 8)) GEMM_PHASE(pg8::EpiY, OBUF, Wl + LW_MO, M, D, D, args.out, Hb, D, nullptr, ALPHA);
        SEAM(p0 + 8);
        if (IN(p0 + 9)) ph_ln(F, args.out, args.in[15] + (size_t)l * D, args.in[16] + (size_t)l * D, Hb, (float*)nullptr);
        SEAM(p0 + 9);
        if (IN(p0 + 10)) GEMM_PHASE(pg8::EpiBf16<2>, Hb, Wl + LW_UP, M, FF, D, UBUF, FF, args.in[18] + (size_t)l * FF, 0, 0, 1.f);
        SEAM(p0 + 10);
        if (IN(p0 + 11)) GEMM_PHASE(pg8::EpiY, UBUF, Wl + LW_DN, M, D, FF, args.out, Hb, D, args.in[20] + (size_t)l * D, ALPHA);
        SEAM(p0 + 11);
        if (IN(p0 + 12)) ph_ln(F, args.out, args.in[21] + (size_t)l * D, args.in[22] + (size_t)l * D, Hb, (l == DEPTH - 1) ? args.out : (float*)nullptr);
        SEAM(p0 + 12);
    }
#undef IN
#undef SEAM
}

#ifndef MK_SPLIT
#define MK_SPLIT 0
#endif
extern "C" void kernel_launch(void* const* d_in, const int* in_sizes, int n_in, void* d_out, int out_size, void* d_ws, size_t ws_size, hipStream_t stream) {
    static int grid = 0;
    if (grid == 0) {
        if (n_in != 23 || in_sizes[0] != M * D || out_size != M * D || ws_size < WS_END) { fprintf(stderr, "kernel_launch: unexpected shapes (n_in %d, in0 %d, out %d, ws %zu)\n", n_in, n_in > 0 ? in_sizes[0] : -1, out_size, ws_size); grid = -1; return; }
        int dev = 0, cus = 0, per_cu = 0;
        if (hipGetDevice(&dev) != hipSuccess || hipDeviceGetAttribute(&cus, hipDeviceAttributeMultiprocessorCount, dev) != hipSuccess) { grid = -1; return; }
        if (hipFuncSetAttribute((const void*)mk_fwd, hipFuncAttributeMaxDynamicSharedMemorySize, LDS_BYTES) != hipSuccess) { fprintf(stderr, "kernel_launch: hipFuncSetAttribute failed\n"); grid = -1; return; }
        if (hipOccupancyMaxActiveBlocksPerMultiprocessor(&per_cu, (const void*)mk_fwd, NWAVES * 64, LDS_BYTES) != hipSuccess || per_cu < 1) { fprintf(stderr, "kernel_launch: occupancy query says %d blocks per CU\n", per_cu); grid = -1; return; }
        grid = cus;
    }
    if (grid < 0) return;
    Args a{}; for (int i = 0; i < 23; ++i) a.in[i] = (const float*)d_in[i]; a.out = (float*)d_out; a.ws = (unsigned char*)d_ws;
    if (hipMemsetAsync((unsigned char*)d_ws + WS_CTL, 0, CTL_ZERO_BYTES, stream) != hipSuccess) return;
#if MK_SPLIT
    for (int p = 0; p < PH_END; ++p) { a.ph_lo = p; a.ph_hi = p + 1; hipLaunchKernelGGL(mk_fwd, dim3(grid), dim3(NWAVES * 64), LDS_BYTES, stream, a); }
#else
    a.ph_lo = 0; a.ph_hi = PH_END;
    void* kargs[] = {&a};
    const hipError_t e = hipLaunchCooperativeKernel((const void*)mk_fwd, dim3(grid), dim3(NWAVES * 64), kargs, LDS_BYTES, stream);
    if (e != hipSuccess) fprintf(stderr, "kernel_launch: cooperative launch failed: %s (grid %d)\n", hipGetErrorString(e), grid);
#endif
}
```

```cpp
#include <hip/hip_runtime.h>
#include <hip/hip_cooperative_groups.h>
#include <cstdio>
#include <cstdint>
namespace pg8 {
#define PG8_LAS __attribute__((address_space(3)))
typedef unsigned short bf16_t;
typedef short bf16x8 __attribute__((ext_vector_type(8)));
typedef float f32x4 __attribute__((ext_vector_type(4)));
typedef unsigned u32x4 __attribute__((ext_vector_type(4)));
constexpr int BM = 256, BK = 64, HALF = 128, HTB = HALF * BK * 2  , STAGE_BYTES = 8 * HTB, NXCD = 8, WGM = 8;

__host__ __device__ __forceinline__ int lds_byte(int r, int c) { const int st = (r >> 4) * 2 + (c >> 5), rr = r & 15, cc = c & 31, ob = rr * 64 + cc * 2; return st * 1024 + (ob ^ (((ob >> 9) & 1) << 5)); }
__host__ __device__ __forceinline__ void stage_rc(int b, int& R, int& C) { const int st = b / 1024, sb = b % 1024, swz = sb ^ (((sb >> 9) & 1) << 5); R = (st >> 1) * 16 + swz / 64; C = (st & 1) * 32 + (swz % 64) / 2; }
__host__ __device__ __forceinline__ int perm32(int rho) { const int n = rho >> 4, i = rho & 15; return 8 * (i >> 2) + 4 * n + (i & 3); }

struct Unit { int pm, pn; };
struct Gemm { const bf16_t* A; const bf16_t* Bt; int M, N, K; };

struct StaticOrder {
    int nM, nN, nwg, G, c;
    __host__ __device__ void init(int M, int N, int G_, int c_) { nM = M / BM; nN = N / BM; nwg = nM * nN; G = G_; c = c_; }
    __host__ __device__ bool next(int i, Unit& u) const {
        const long L = (long)i * G + c; if (L >= nwg) return false;
        int wgid = (int)L; { const int q = nwg / NXCD, r = nwg % NXCD, xcd = wgid % NXCD, off = wgid / NXCD; wgid = (xcd < r ? xcd * (q + 1) : r * (q + 1) + (xcd - r) * q) + off; }
        const int nig = WGM * nN, gid = wgid / nig, fm = gid * WGM, gsz = (nM - fm) < WGM ? (nM - fm) : WGM;
        u.pm = fm + ((wgid % nig) % gsz); u.pn = (wgid % nig) / gsz; return true;
    }
    __device__ __forceinline__ void a_ready(const Unit&) const {}
    __device__ __forceinline__ void done(const Unit&) const {}
};

__device__ __forceinline__ unsigned cvt_pk_bf16(float lo, float hi) { unsigned r; asm volatile("v_cvt_pk_bf16_f32 %0, %1, %2" : "=v"(r) : "v"(lo), "v"(hi)); return r; }
typedef float f32x2 __attribute__((ext_vector_type(2)));
template <int ACT  > struct EpiBf16 {
    static constexpr bool PERM = true, AFTER_DRAIN = false; static_assert(ACT == 0 || ACT == 2, "EpiBf16: ACT is 0 (none) or 2 (squared relu)");
    bf16_t* O; int ldc; const float* bias; int split_cols; size_t split_stride; float scale0;
    __device__ __forceinline__ void operator()(const f32x4 (&acc)[2][2][4][2], const Unit& u, int wr, int wc, int fr, int fq) const {
        const int row0 = u.pm * BM + wr * 64 + fr; int colt = u.pn * BM; bf16_t* base = O;
        float sc = 1.f; if (split_cols) { const int t = colt / split_cols; base += (size_t)t * split_stride; colt -= t * split_cols; if (t == 0) sc = scale0; }
        const int col0 = colt + wc * 32 + 8 * fq, bcol0 = u.pn * BM + wc * 32 + 8 * fq;
        f32x4 bv[2][2];
#pragma unroll
        for (int bj = 0; bj < 2; ++bj)
#pragma unroll
            for (int n = 0; n < 2; ++n) bv[bj][n] = bias ? *(const f32x4*)(bias + bcol0 + bj * HALF + 4 * n) : (f32x4){0.f, 0.f, 0.f, 0.f};
#pragma unroll
        for (int ai = 0; ai < 2; ++ai)
#pragma unroll
            for (int m = 0; m < 4; ++m) { bf16_t* rowp = base + (size_t)(row0 + ai * HALF + m * 16) * ldc + col0;
#pragma unroll
                for (int bj = 0; bj < 2; ++bj) { f32x4 v0 = acc[ai][bj][m][0] + bv[bj][0], v1 = acc[ai][bj][m][1] + bv[bj][1];
                    if (ACT == 2) { const f32x4 z4 = (f32x4){0.f, 0.f, 0.f, 0.f}; v0 = __builtin_elementwise_max(v0, z4); v1 = __builtin_elementwise_max(v1, z4); v0 = v0 * v0; v1 = v1 * v1; }
                    v0 = v0 * sc; v1 = v1 * sc; u32x4 w; w.x = cvt_pk_bf16(v0[0], v0[1]); w.y = cvt_pk_bf16(v0[2], v0[3]); w.z = cvt_pk_bf16(v1[0], v1[1]); w.w = cvt_pk_bf16(v1[2], v1[3]);
                    *(u32x4*)(rowp + bj * HALF) = w; } }
    }
};

struct EpiY {
    static constexpr bool PERM = false, AFTER_DRAIN = false;
    float* Y; const bf16_t* R; int ldc; const float* bias; float alpha;
    __device__ __forceinline__ void operator()(const f32x4 (&acc)[2][2][4][2], const Unit& u, int wr, int wc, int fr, int fq) const {
        const int row0 = u.pm * BM + wr * 64 + fr, col0 = u.pn * BM + wc * 32 + 4 * fq;
#pragma unroll
        for (int ai = 0; ai < 2; ++ai)
#pragma unroll
            for (int m = 0; m < 4; ++m) { const size_t roff = (size_t)(row0 + ai * HALF + m * 16) * ldc;
#pragma unroll
                for (int bj = 0; bj < 2; ++bj)
#pragma unroll
                    for (int n = 0; n < 2; ++n) { const int col = col0 + bj * HALF + n * 16;
                        const f32x4 bv = bias ? *(const f32x4*)(bias + col) : (f32x4){0.f, 0.f, 0.f, 0.f};
                        const uint2 rr = *(const uint2*)(R + roff + col);
                        f32x4 rv; rv[0] = __uint_as_float(rr.x << 16); rv[1] = __uint_as_float(rr.x & 0xffff0000u); rv[2] = __uint_as_float(rr.y << 16); rv[3] = __uint_as_float(rr.y & 0xffff0000u);
                        *(f32x4*)(Y + roff + col) = acc[ai][bj][m][n] + bv + rv * alpha; } }
    }
};

struct PanelStats {
    unsigned* xbuf;
    unsigned* cnt;
    unsigned* tmo;
    int ntn; float eps;
    unsigned code;
    __device__ __forceinline__ bool run(const f32x4 (&v)[2][2][4][2], const Unit& u, int wr, int wc, int fr, int fq, PG8_LAS unsigned char* lds, int wid, int lane) const {
        typedef float f32x2v __attribute__((ext_vector_type(2)));
        PG8_LAS f32x2v* P = (PG8_LAS f32x2v*)lds;
        PG8_LAS f32x2v* S = (PG8_LAS f32x2v*)(lds + 8192);
        PG8_LAS unsigned* flag = (PG8_LAS unsigned*)(lds + 8192 + 2048);
#pragma unroll
        for (int ai = 0; ai < 2; ++ai)
#pragma unroll
            for (int m = 0; m < 4; ++m) {
                float s = 0.f;
#pragma unroll
                for (int bj = 0; bj < 2; ++bj)
#pragma unroll
                    for (int n = 0; n < 2; ++n) { const f32x4 x = v[ai][bj][m][n]; s += (x[0] + x[1]) + (x[2] + x[3]); }
                s += __shfl_xor(s, 16); s += __shfl_xor(s, 32);
                const float mw = s * (1.0f / 64.0f); float q = 0.f;
#pragma unroll
                for (int bj = 0; bj < 2; ++bj)
#pragma unroll
                    for (int n = 0; n < 2; ++n) { const f32x4 d = v[ai][bj][m][n] - mw; q += (d[0] * d[0] + d[1] * d[1]) + (d[2] * d[2] + d[3] * d[3]); }
                q += __shfl_xor(q, 16); q += __shfl_xor(q, 32);
                if (fq == 0) P[(ai * HALF + wr * 64 + m * 16 + fr) * 4 + wc] = (f32x2v){mw, q};
            }
        asm volatile("s_waitcnt lgkmcnt(0)" ::: "memory"); __builtin_amdgcn_s_barrier(); asm volatile("" ::: "memory");
#if defined(BROKEN_EXCHANGE_NO_WAIT)
#warning BROKEN CONTROL BUILD: the row-statistics exchange does not wait; results are wrong by design
        if (blockIdx.x >= 64) { const long long t0_ = clock64(); while (clock64() - t0_ < 60000) __builtin_amdgcn_s_sleep(8); }
#endif
        const int row = wid * 32 + (lane & 31);
        if (lane < 32) {
            const f32x2v a = P[row * 4 + 0], b = P[row * 4 + 1], c = P[row * 4 + 2], d = P[row * 4 + 3];
            const float mt = (a.x + b.x + c.x + d.x) * 0.25f;
            const float da = a.x - mt, db = b.x - mt, dc = c.x - mt, dd = d.x - mt;
            const float m2 = (a.y + b.y) + (c.y + d.y) + 64.0f * ((da * da + db * db) + (dc * dc + dd * dd));
            unsigned long long* slot = (unsigned long long*)xbuf + ((size_t)(u.pm * BM + row) * 4 + u.pn);
            __hip_atomic_store(slot, ((unsigned long long)__float_as_uint(m2) << 32) | __float_as_uint(mt), __ATOMIC_RELAXED, __HIP_MEMORY_SCOPE_AGENT);
        }
        asm volatile("s_waitcnt vmcnt(0)" ::: "memory");
        if (lane == 0) __hip_atomic_fetch_add(cnt + 64 * u.pm, 1u, __ATOMIC_RELAXED, __HIP_MEMORY_SCOPE_AGENT);
        if (wid == 0) {
            bool dead = false; const unsigned long long t0 = __builtin_amdgcn_s_memrealtime(); const unsigned want = 8u * (unsigned)ntn;
            for (;;) {
#if defined(BROKEN_EXCHANGE_NO_WAIT)
                break;
#endif
                if ((unsigned)__builtin_amdgcn_readfirstlane(__hip_atomic_load(cnt + 64 * u.pm, __ATOMIC_RELAXED, __HIP_MEMORY_SCOPE_AGENT)) >= want) break;
                if (__builtin_amdgcn_s_memrealtime() - t0 > 2000000ull) {
                    if (lane == 0) { unsigned expect = 0u; __hip_atomic_compare_exchange_strong(tmo + 1, &expect, code | (unsigned)(u.pm & 0xff), __ATOMIC_RELAXED, __ATOMIC_RELAXED, __HIP_MEMORY_SCOPE_AGENT);
                                     __hip_atomic_store(tmo, 1u, __ATOMIC_RELAXED, __HIP_MEMORY_SCOPE_AGENT); }
                    dead = true; break; }
                __builtin_amdgcn_s_sleep(2);
            }
            __builtin_amdgcn_fence(__ATOMIC_ACQUIRE, "agent");
            if (lane == 0) flag[0] = dead ? 1u : 0u;
        }
        asm volatile("s_waitcnt vmcnt(0) lgkmcnt(0)" ::: "memory"); __builtin_amdgcn_s_barrier(); asm volatile("" ::: "memory");
        const bool bad = flag[0] != 0u;
        if (lane < 32) {
            const unsigned long long* slot = (const unsigned long long*)xbuf + (size_t)(u.pm * BM + row) * 4; float mt[4], m2[4]; float ms = 0.f;
#pragma unroll
            for (int t = 0; t < 4; ++t) { if (t < ntn) { const unsigned long long w = __hip_atomic_load(slot + t, __ATOMIC_RELAXED, __HIP_MEMORY_SCOPE_AGENT); mt[t] = __uint_as_float((unsigned)w); m2[t] = __uint_as_float((unsigned)(w >> 32)); } else { mt[t] = 0.f; m2[t] = 0.f; } ms += mt[t]; }
            const float mean = ms / (float)ntn; float q = 0.f;
#pragma unroll
            for (int t = 0; t < 4; ++t) if (t < ntn) { const float dm = mt[t] - mean; q += m2[t] + 256.0f * dm * dm; }
            S[row] = (f32x2v){mean, 1.0f / sqrtf(q / (256.0f * (float)ntn) + eps)};
        }
        asm volatile("s_waitcnt lgkmcnt(0)" ::: "memory"); __builtin_amdgcn_s_barrier(); asm volatile("" ::: "memory");
        return bad;
    }
};
struct EpiLnRes {
    static constexpr bool PERM = false, AFTER_DRAIN = true;
    const float* base; float* out; int ldc; const float* bias; PanelStats st; unsigned poison;
    __device__ __forceinline__ void fused(f32x4 (&acc)[2][2][4][2], const Unit& u, int wr, int wc, int fr, int fq, PG8_LAS unsigned char* lds, int wid, int lane) const {
        typedef float f32x2v __attribute__((ext_vector_type(2)));
        const PG8_LAS f32x2v* S = (const PG8_LAS f32x2v*)(lds + 8192);
        const int col0 = u.pn * BM + wc * 32 + 4 * fq;
#pragma unroll
        for (int bj = 0; bj < 2; ++bj)
#pragma unroll
            for (int n = 0; n < 2; ++n) { const f32x4 bv = bias ? *(const f32x4*)(bias + col0 + bj * HALF + n * 16) : (f32x4){0.f, 0.f, 0.f, 0.f};
#pragma unroll
                for (int ai = 0; ai < 2; ++ai)
#pragma unroll
                    for (int m = 0; m < 4; ++m) acc[ai][bj][m][n] += bv; }
        f32x4 pre[4][2][2];
#pragma unroll
        for (int m = 0; m < 4; ++m) { const size_t off = (size_t)(u.pm * BM + wr * 64 + m * 16 + fr) * ldc + col0;
#pragma unroll
            for (int bj = 0; bj < 2; ++bj)
#pragma unroll
                for (int n = 0; n < 2; ++n) pre[m][bj][n] = *(const f32x4*)(base + off + bj * HALF + n * 16); }
        const bool bad = st.run(acc, u, wr, wc, fr, fq, lds, wid, lane) || poison != 0u;
        const float qnan = __builtin_nanf("");
#pragma unroll
        for (int ai = 0; ai < 2; ++ai)
#pragma unroll
            for (int m = 0; m < 4; ++m) { const int r = ai * HALF + wr * 64 + m * 16 + fr; const f32x2v sr = S[r]; const size_t off = (size_t)(u.pm * BM + r) * ldc + col0;
#pragma unroll
                for (int bj = 0; bj < 2; ++bj)
#pragma unroll
                    for (int n = 0; n < 2; ++n) { const f32x4 bs = ai == 0 ? pre[m][bj][n] : *(const f32x4*)(base + off + bj * HALF + n * 16); f32x4 o = bs + (acc[ai][bj][m][n] - sr.x) * sr.y;
                        if (bad) o = (f32x4){qnan, qnan, qnan, qnan}; *(f32x4*)(out + off + bj * HALF + n * 16) = o; }
                if (m & 1) asm volatile("" ::: "memory"); }
    }
};
struct EpiLnResLn {
    static constexpr bool PERM = false, AFTER_DRAIN = true;
    const float* base; float* out; bf16_t* xn; int ldc; const float* bias; PanelStats st1, st2; unsigned poison;
    __device__ __forceinline__ void fused(f32x4 (&acc)[2][2][4][2], const Unit& u, int wr, int wc, int fr, int fq, PG8_LAS unsigned char* lds, int wid, int lane) const {
        typedef float f32x2v __attribute__((ext_vector_type(2))); typedef unsigned u32x2v __attribute__((ext_vector_type(2)));
        const PG8_LAS f32x2v* S = (const PG8_LAS f32x2v*)(lds + 8192);
        const int col0 = u.pn * BM + wc * 32 + 4 * fq;
#pragma unroll
        for (int bj = 0; bj < 2; ++bj)
#pragma unroll
            for (int n = 0; n < 2; ++n) { const f32x4 bv = bias ? *(const f32x4*)(bias + col0 + bj * HALF + n * 16) : (f32x4){0.f, 0.f, 0.f, 0.f};
#pragma unroll
                for (int ai = 0; ai < 2; ++ai)
#pragma unroll
                    for (int m = 0; m < 4; ++m) acc[ai][bj][m][n] += bv; }
        bool bad = st1.run(acc, u, wr, wc, fr, fq, lds, wid, lane) || poison != 0u;
        const float qnan = __builtin_nanf("");
#pragma unroll
        for (int ai = 0; ai < 2; ++ai)
#pragma unroll
            for (int m = 0; m < 4; ++m) { const int r = ai * HALF + wr * 64 + m * 16 + fr; const f32x2v sr = S[r]; const size_t off = (size_t)(u.pm * BM + r) * ldc + col0;
#pragma unroll
                for (int bj = 0; bj < 2; ++bj)
#pragma unroll
                    for (int n = 0; n < 2; ++n) { const f32x4 bs = *(const f32x4*)(base + off + bj * HALF + n * 16); acc[ai][bj][m][n] = bs + (acc[ai][bj][m][n] - sr.x) * sr.y; }
                asm volatile("" : "+v"(acc[ai][0][m][0]), "+v"(acc[ai][0][m][1]), "+v"(acc[ai][1][m][0]), "+v"(acc[ai][1][m][1]));
                if (m & 1) asm volatile("" ::: "memory"); }
        const bool bad1 = bad;
        bad = st2.run(acc, u, wr, wc, fr, fq, lds, wid, lane) || bad;
#pragma unroll
        for (int ai = 0; ai < 2; ++ai)
#pragma unroll
            for (int m = 0; m < 4; ++m) { const int r = ai * HALF + wr * 64 + m * 16 + fr; const f32x2v sr = S[r]; const size_t off = (size_t)(u.pm * BM + r) * ldc + col0;
#pragma unroll
                for (int bj = 0; bj < 2; ++bj)
#pragma unroll
                    for (int n = 0; n < 2; ++n) { const f32x4 x1 = acc[ai][bj][m][n]; *(f32x4*)(out + off + bj * HALF + n * 16) = bad1 ? (f32x4){qnan, qnan, qnan, qnan} : x1;
                        const f32x4 o = (x1 - sr.x) * sr.y; u32x2v w; w.x = cvt_pk_bf16(o[0], o[1]); w.y = cvt_pk_bf16(o[2], o[3]);
                        if (bad) { w.x = 0x7fc07fc0u; w.y = 0x7fc07fc0u; } *(u32x2v*)(xn + off + bj * HALF + n * 16) = w; }
                asm volatile("" ::: "memory"); }
    }
};

template <class Epi, class Sched, bool ALIGN_EPI = false, bool SP2 = false>
__device__ __forceinline__ void gemm_phase(PG8_LAS unsigned char* lds, const Gemm g, const Sched& S, const Epi& E, const int wave_id) {
    int tid_; asm volatile("v_mbcnt_lo_u32_b32 %0, -1, 0\n\tv_mbcnt_hi_u32_b32 %0, -1, %0" : "=v"(tid_)); tid_ += 64 * wave_id; asm volatile("" : "+v"(tid_));
    const int tid = tid_, wid = __builtin_amdgcn_readfirstlane(tid >> 6), lane = tid & 63, wr = wid >> 2, wc = wid & 3, fr = lane & 15, fq = lane >> 4;
    const int K = g.K, nt = K / BK;
    unsigned voffA[2], voffB[2];
#pragma unroll
    for (int i = 0; i < 2; ++i) { int R, C; stage_rc(tid * 16 + i * 8192, R, C); const int Rb = Epi::PERM ? ((R & ~31) + perm32(R & 31)) : R;
        voffA[i] = (unsigned)(R * K + C) * 2u; voffB[i] = (unsigned)(Rb * K + C) * 2u; }
    const size_t kstep = (size_t)(BK * 2);
    const size_t hstep = (size_t)HALF * K * 2;
    const size_t tstep = 2 * hstep;
    const unsigned ldsw = (unsigned)wid * 1024u;
    const int aoff = lds_byte(wr * 64 + fr, fq * 8), boff = lds_byte(wc * 32 + fr, fq * 8);
#define PG8_SA(b, h) (((b) * 2 + (h)) * HTB)
#define PG8_SB(b, h) ((4 + (b) * 2 + (h)) * HTB)
#define PG8_STAGE(bufoff, gbase, voff) do { _Pragma("unroll") for (int _i = 0; _i < 2; ++_i) \
        __builtin_amdgcn_global_load_lds((const unsigned*)((const char*)(gbase) + (voff)[_i]), (PG8_LAS unsigned*)(lds + (bufoff) + ldsw + _i * 8192), 16, 0, 0); } while (0)
#define PG8_LDA(dst, b, h) do { _Pragma("unroll") for (int m = 0; m < 4; ++m) _Pragma("unroll") for (int k = 0; k < 2; ++k) dst[m][k] = *(const PG8_LAS bf16x8*)(lds + PG8_SA(b, h) + aoff + m * 2048 + k * 1024); } while (0)
#define PG8_LDB(dst, b, h) do { _Pragma("unroll") for (int n = 0; n < 2; ++n) _Pragma("unroll") for (int k = 0; k < 2; ++k) dst[n][k] = *(const PG8_LAS bf16x8*)(lds + PG8_SB(b, h) + boff + n * 2048 + k * 1024); } while (0)
#define PG8_MMA(ai, bj, At, Bt) do { __builtin_amdgcn_s_setprio(1); _Pragma("unroll") for (int m = 0; m < 4; ++m) _Pragma("unroll") for (int n = 0; n < 2; ++n) _Pragma("unroll") for (int k = 0; k < 2; ++k) \
        acc[ai][bj][m][n] = __builtin_amdgcn_mfma_f32_16x16x32_bf16(Bt[n][k], At[m][k], acc[ai][bj][m][n], 0, 0, 0); __builtin_amdgcn_s_setprio(0); } while (0)
#define PG8_WAIT_V(n) asm volatile("s_waitcnt vmcnt(" #n ")" ::: "memory")
#define PG8_WAIT_L(n) asm volatile("s_waitcnt lgkmcnt(" #n ")" ::: "memory")
#define PG8_BAR __builtin_amdgcn_s_barrier()
#define PG8_SCHED __builtin_amdgcn_sched_barrier(0)
    Unit cur, nxt; int ui = 0;
    if (!S.next(0, cur)) return;
    f32x4 acc[2][2][4][2];
#pragma unroll
    for (int a = 0; a < 2; ++a)
#pragma unroll
        for (int b = 0; b < 2; ++b)
#pragma unroll
            for (int m = 0; m < 4; ++m)
#pragma unroll
                for (int n = 0; n < 2; ++n) acc[a][b][m][n] = (f32x4){0.f, 0.f, 0.f, 0.f};
    bf16x8 At[4][2], B0[2][2], B1[2][2];
    const char* cA = (const char*)g.A + (size_t)cur.pm * tstep; const char* cB = (const char*)g.Bt + (size_t)cur.pn * tstep;
    S.a_ready(cur);
    if constexpr (SP2) {
        PG8_STAGE(PG8_SB(0, 0), cB, voffB); PG8_STAGE(PG8_SB(0, 1), cB + hstep, voffB); PG8_STAGE(PG8_SA(0, 0), cA, voffA); PG8_STAGE(PG8_SA(0, 1), cA + hstep, voffA);
        if (wr == 1) PG8_BAR;
        PG8_WAIT_V(2); PG8_BAR;
        PG8_STAGE(PG8_SB(1, 0), cB + kstep, voffB); PG8_STAGE(PG8_SA(1, 0), cA + kstep, voffA); PG8_STAGE(PG8_SB(1, 1), cB + hstep + kstep, voffB);
        PG8_WAIT_V(6); PG8_BAR;
    } else {
        PG8_STAGE(PG8_SB(0, 0), cB, voffB); PG8_STAGE(PG8_SA(0, 0), cA, voffA); PG8_STAGE(PG8_SB(0, 1), cB + hstep, voffB); PG8_STAGE(PG8_SA(0, 1), cA + hstep, voffA);
        if (wr == 1) PG8_BAR;
        PG8_WAIT_V(4); PG8_BAR;
        PG8_STAGE(PG8_SB(1, 0), cB + kstep, voffB); PG8_STAGE(PG8_SA(1, 0), cA + kstep, voffA); PG8_STAGE(PG8_SB(1, 1), cB + hstep + kstep, voffB);
        PG8_WAIT_V(6); PG8_BAR;
    }
    for (;;) {
        const bool has_next = S.next(ui + 1, nxt);
        const char* nA = has_next ? (const char*)g.A + (size_t)nxt.pm * tstep : cA; const char* nB = has_next ? (const char*)g.Bt + (size_t)nxt.pn * tstep : cB;
        for (int t = 0; t < nt; t += 2) {
            const bool last = (t == nt - 2);
            const char* a1 = cA + (size_t)(t + 1) * kstep;
            const char* a2 = last ? nA : cA + (size_t)(t + 2) * kstep; const char* b2 = last ? nB : cB + (size_t)(t + 2) * kstep;
            const char* a3 = a2 + kstep; const char* b3 = b2 + kstep;
            if (last && has_next) S.a_ready(nxt);
            if constexpr (SP2) {
            PG8_LDB(B0, 0, 0); PG8_LDB(B1, 0, 1); PG8_SCHED; PG8_LDA(At, 0, 0); PG8_STAGE(PG8_SA(1, 1), a1 + hstep, voffA);
            PG8_WAIT_V(8); PG8_WAIT_L(0); PG8_BAR; PG8_MMA(0, 0, At, B0); PG8_MMA(0, 1, At, B1); PG8_BAR; PG8_SCHED;
            PG8_LDA(At, 0, 1); PG8_STAGE(PG8_SB(0, 0), b2, voffB); PG8_STAGE(PG8_SB(0, 1), b2 + hstep, voffB); PG8_STAGE(PG8_SA(0, 0), a2, voffA);
            PG8_WAIT_V(8); PG8_WAIT_L(0); PG8_BAR; PG8_MMA(1, 0, At, B0); PG8_MMA(1, 1, At, B1); PG8_BAR; PG8_SCHED;
            PG8_LDB(B0, 1, 0); PG8_LDB(B1, 1, 1); PG8_SCHED; PG8_LDA(At, 1, 0); PG8_STAGE(PG8_SA(0, 1), a2 + hstep, voffA);
            PG8_WAIT_V(8); PG8_WAIT_L(0); PG8_BAR; PG8_MMA(0, 0, At, B0); PG8_MMA(0, 1, At, B1); PG8_BAR; PG8_SCHED;
            PG8_LDA(At, 1, 1); PG8_STAGE(PG8_SB(1, 0), b3, voffB); PG8_STAGE(PG8_SB(1, 1), b3 + hstep, voffB); PG8_STAGE(PG8_SA(1, 0), a3, voffA);
            PG8_WAIT_V(8); PG8_WAIT_L(0); PG8_BAR; PG8_MMA(1, 0, At, B0); PG8_MMA(1, 1, At, B1); PG8_BAR; PG8_SCHED;
            } else {
            PG8_LDB(B0, 0, 0); PG8_SCHED; PG8_LDA(At, 0, 0); PG8_STAGE(PG8_SA(1, 1), a1 + hstep, voffA);
            PG8_WAIT_L(8); PG8_BAR; PG8_WAIT_L(0); PG8_MMA(0, 0, At, B0); PG8_BAR; PG8_SCHED;
            PG8_LDB(B1, 0, 1); PG8_STAGE(PG8_SB(0, 0), b2, voffB);
            PG8_BAR; PG8_WAIT_L(0); PG8_MMA(0, 1, At, B1); PG8_BAR;
            PG8_LDA(At, 0, 1); PG8_STAGE(PG8_SA(0, 0), a2, voffA);
            PG8_BAR; PG8_WAIT_L(0); PG8_MMA(1, 0, At, B0); PG8_BAR; PG8_SCHED;
            PG8_STAGE(PG8_SB(0, 1), b2 + hstep, voffB);
            PG8_WAIT_V(6); PG8_BAR; PG8_MMA(1, 1, At, B1); PG8_BAR;
            PG8_LDB(B0, 1, 0); PG8_SCHED; PG8_LDA(At, 1, 0); PG8_STAGE(PG8_SA(0, 1), a2 + hstep, voffA);
            PG8_WAIT_L(8); PG8_BAR; PG8_WAIT_L(0); PG8_MMA(0, 0, At, B0); PG8_BAR; PG8_SCHED;
            PG8_LDB(B1, 1, 1); PG8_STAGE(PG8_SB(1, 0), b3, voffB);
            PG8_BAR; PG8_WAIT_L(0); PG8_MMA(0, 1, At, B1); PG8_BAR;
            PG8_LDA(At, 1, 1); PG8_STAGE(PG8_SA(1, 0), a3, voffA);
            PG8_BAR; PG8_WAIT_L(0); PG8_MMA(1, 0, At, B0); PG8_BAR; PG8_SCHED;
            PG8_STAGE(PG8_SB(1, 1), b3 + hstep, voffB);
            PG8_WAIT_V(6); PG8_BAR; PG8_MMA(1, 1, At, B1); PG8_BAR;
            }
        }
        if constexpr (ALIGN_EPI) { if (wr == 0) PG8_BAR; }
        if constexpr (!Epi::AFTER_DRAIN) { E(acc, cur, wr, wc, fr, fq); S.done(cur); }
        if (!has_next) break;
#pragma unroll
        for (int a = 0; a < 2; ++a)
#pragma unroll
            for (int b = 0; b < 2; ++b)
#pragma unroll
                for (int m = 0; m < 4; ++m)
#pragma unroll
                    for (int n = 0; n < 2; ++n) acc[a][b][m][n] = (f32x4){0.f, 0.f, 0.f, 0.f};
        cur = nxt; cA = nA; cB = nB; ++ui;
        if constexpr (ALIGN_EPI) { if (wr == 1) PG8_BAR; }
    }
    PG8_WAIT_V(0);
    if constexpr (!ALIGN_EPI) { if (wr == 0) PG8_BAR; }
    PG8_BAR;
    if constexpr (Epi::AFTER_DRAIN) { E.fused(acc, cur, wr, wc, fr, fq, lds, wid, lane); S.done(cur); }
#undef PG8_SA
#undef PG8_SB
#undef PG8_STAGE
#undef PG8_LDA
#undef PG8_LDB
#undef PG8_MMA
#undef PG8_WAIT_V
#undef PG8_WAIT_L
#undef PG8_BAR
#undef PG8_SCHED
}
}
#define GAS __attribute__((address_space(1)))
#define LAS __attribute__((address_space(3)))
typedef unsigned short bf16;
typedef unsigned v4u __attribute__((ext_vector_type(4)));
typedef float f32x4 __attribute__((ext_vector_type(4)));
typedef short bf16x8 __attribute__((ext_vector_type(8)));
typedef GAS unsigned gu32;
typedef GAS unsigned long long gu64;
#define RLX_AGENT __ATOMIC_RELAXED, __HIP_MEMORY_SCOPE_AGENT
#define LDS_WAIT() asm volatile("s_waitcnt lgkmcnt(0)" ::: "memory")
#define VM_WAIT() asm volatile("s_waitcnt vmcnt(0)" ::: "memory")
__device__ __forceinline__ unsigned long long rt() { return __builtin_amdgcn_s_memrealtime(); }
__device__ __forceinline__ unsigned f2bf(float f) { unsigned u = __builtin_bit_cast(unsigned, f); return (u + 0x7fffu + ((u >> 16) & 1u)) >> 16; }
__device__ __forceinline__ unsigned pk2(float lo, float hi) { return f2bf(lo) | (f2bf(hi) << 16); }

#define XB_TMO      128
#define XB_XCNT(j)  (256  + 64 * (j))
#define XB_XSUB(j)  (1280 + 64 * (j))
#define XB_XGEN(j)  (2304 + 64 * (j))
#define XB_TOP      3328
#define XB_TOPGEN   3392
#define XCD_BAR_WORDS 3456
#define XB_SPIN_CAP (1u << 18)

__device__ __forceinline__ unsigned xb_ld(unsigned* p)              { return __hip_atomic_load(p, __ATOMIC_RELAXED, __HIP_MEMORY_SCOPE_AGENT); }
__device__ __forceinline__ unsigned xb_add(unsigned* p, unsigned v) { return __hip_atomic_fetch_add(p, v, __ATOMIC_RELAXED, __HIP_MEMORY_SCOPE_AGENT); }
__device__ __forceinline__ unsigned xb_xcc_id() { return (unsigned)__builtin_amdgcn_s_getreg((3 << 11) | 20) & 0xFu; }
#define XB_SPIN(cond, bar) do { unsigned _sp = 0; while (cond) { __builtin_amdgcn_s_sleep(1); \
    if ((++_sp & 255u) == 0u) { if (xb_ld(&(bar)[XB_TMO])) break; if (_sp > XB_SPIN_CAP) { atomicAdd(&(bar)[XB_TMO], 1u); break; } } } } while (0)

struct XcdBarrier {
    unsigned* bar; unsigned x;
    volatile LAS unsigned* st;
};

__device__ __forceinline__ XcdBarrier xcd_barrier_post(unsigned* bar, volatile LAS unsigned* st) {
    XcdBarrier b; b.bar = bar; b.x = xb_xcc_id(); b.st = st;
    if (threadIdx.x == 0) (void)xb_add(&bar[XB_XCNT(b.x)], 1u);
    return b;
}
__device__ __forceinline__ void xcd_barrier_complete(unsigned* bar, unsigned x, unsigned& nloc, unsigned& nx) {
    const unsigned G = gridDim.x * gridDim.y * gridDim.z;
    unsigned sum, cnt, mine, sp = 0u;
    for (;;) {
        sum = 0u; cnt = 0u; mine = 0u;
#pragma unroll
        for (unsigned j = 0; j < 16; ++j) { const unsigned c = xb_ld(&bar[XB_XCNT(j)]); sum += c; cnt += (c > 0u) ? 1u : 0u; mine = (j == x) ? c : mine; }
        if (sum == G) break;
        __builtin_amdgcn_s_sleep(1);
        if ((++sp & 255u) == 0u) { if (xb_ld(&bar[XB_TMO])) break; if (sp > XB_SPIN_CAP) { atomicAdd(&bar[XB_TMO], 1u); break; } }
    }
    nloc = mine > 0u ? mine : 1u; nx = cnt > 0u ? cnt : 1u;
}

__device__ __forceinline__ void xcd_barrier(const XcdBarrier& b) {
    asm volatile("s_waitcnt vmcnt(0)" ::: "memory");
    __syncthreads();
    if (threadIdx.x == 0) {
        unsigned* bar = b.bar;
        __builtin_amdgcn_s_waitcnt(0);
        unsigned nloc = b.st[0], nx = b.st[1];
        if (nloc == 0u) { xcd_barrier_complete(bar, b.x, nloc, nx); b.st[0] = nloc; b.st[1] = nx; }
        const unsigned old = xb_add(&bar[XB_XSUB(b.x)], 1u);
        const unsigned gen = old / nloc;
        if (old + 1u == (gen + 1u) * nloc) {
            __builtin_amdgcn_fence(__ATOMIC_RELEASE, "agent");
            asm volatile("s_waitcnt vmcnt(0)" ::: "memory");
            const unsigned og = xb_add(&bar[XB_TOP], 1u);
            const unsigned tg = og / nx;
            if (og + 1u == (tg + 1u) * nx) xb_add(&bar[XB_TOPGEN], 1u);
            else XB_SPIN(xb_ld(&bar[XB_TOPGEN]) == tg, bar);
            __builtin_amdgcn_fence(__ATOMIC_ACQUIRE, "agent");
            xb_add(&bar[XB_XGEN(b.x)], 1u);
            asm volatile("s_waitcnt vmcnt(0)" ::: "memory");
        } else {
            XB_SPIN(xb_ld(&bar[XB_XGEN(b.x)]) == gen, bar);
            __builtin_amdgcn_fence(__ATOMIC_ACQUIRE, "agent");
            asm volatile("s_waitcnt vmcnt(0)" ::: "memory");
        }
    }
    __syncthreads();
}

constexpr int D = 1024, BATCH = 16, SEQ = 2048, DEPTH = 2, M = BATCH * SEQ;
constexpr int PIN = 3224, PINP = 3584;
constexpr int C_VH = 3232;
constexpr int C_GQ = 0, C_GK = 192, C_GV = 384, C_GLR = 768, C_GG = 784, C_DQ = 1168, C_DK = 1488, C_DV = 1552, C_IQ = 1680, C_IK = 2192, C_IW = 2256, C_SQ = 2264, C_SK = 2584, C_SV = 2904;
constexpr int O_GLA = 0, O_DSA = 384, O_SB = 704;
constexpr int MEMT = 256, MKV = BATCH * MEMT, FF = 4096;
constexpr float LN_EPS = 1e-5f;
constexpr float ALPHA = 1.4142135623730951f;
constexpr float IDX_SCALE = 0.04419417382415922f;
constexpr float GLA_QSCALE = 0.14433756729740643f;
constexpr int NWAVES = 8;
constexpr int LDS_BYTES = 147456;
constexpr int RING_OFF = 0, RING_BYTES = 131072, LDSCTL_OFF = RING_BYTES, MISC_OFF = LDSCTL_OFF + 320;

constexpr size_t MiB = 1u << 20;
constexpr size_t WS_CTL = 0, CTL_ZERO_BYTES = 1 * MiB;
constexpr size_t LW_IN = 0, LW_OUT = (size_t)PINP * D, LW_MQ = LW_OUT + (size_t)D * D, LW_MKV = LW_MQ + (size_t)D * D, LW_MO = LW_MKV + 2 * (size_t)D * D,
                 LW_UP = LW_MO + (size_t)D * D, LW_DN = LW_UP + (size_t)FF * D, LW_END = LW_DN + (size_t)D * FF;
constexpr size_t WS_W = 2 * MiB;
constexpr size_t WS_MEMB = 68 * MiB;
constexpr size_t WS_KVMEM = 76 * MiB;
constexpr size_t WS_H = 108 * MiB;
constexpr size_t WS_PROJ = 172 * MiB;
constexpr size_t WS_OBUF = 396 * MiB;
constexpr size_t WS_QMEM = 172 * MiB;
constexpr size_t WS_MASK = 460 * MiB;
constexpr size_t WS_UBUF = 172 * MiB;
constexpr size_t WS_END = 468 * MiB;
static_assert(WS_W + 2 * LW_END * 2 <= WS_MEMB && WS_UBUF + (size_t)M * FF * 2 <= WS_OBUF + 64 * MiB && WS_PROJ + (size_t)M * PINP * 2 <= WS_OBUF, "ws map");
constexpr int CW_BAR = 4096;


__device__ __forceinline__ float bf2f(bf16 v) { return __uint_as_float((unsigned)v << 16); }
__device__ __forceinline__ float wave_sum(float v) {
#pragma unroll
    for (int o = 1; o < 64; o <<= 1) v += __shfl_xor(v, o);
    return v;
}
__device__ __forceinline__ float wave_max(float v) {
#pragma unroll
    for (int o = 1; o < 64; o <<= 1) v = fmaxf(v, __shfl_xor(v, o));
    return v;
}
__device__ __forceinline__ int wave_sum_i(int v) {
#pragma unroll
    for (int o = 1; o < 64; o <<= 1) v += __shfl_xor(v, o);
    return v;
}
__device__ __forceinline__ void unpack8(const uint4 u, float (&f)[8]) {
    f[0] = __uint_as_float(u.x << 16); f[1] = __uint_as_float(u.x & 0xffff0000u); f[2] = __uint_as_float(u.y << 16); f[3] = __uint_as_float(u.y & 0xffff0000u);
    f[4] = __uint_as_float(u.z << 16); f[5] = __uint_as_float(u.z & 0xffff0000u); f[6] = __uint_as_float(u.w << 16); f[7] = __uint_as_float(u.w & 0xffff0000u);
}


struct Frame { LAS unsigned char* lds; int wave, gw, NGW, G; };
__device__ __forceinline__ int lane_id_asm() { int l; asm volatile("v_mbcnt_lo_u32_b32 %0, -1, 0\n\tv_mbcnt_hi_u32_b32 %0, -1, %0" : "=v"(l)); return l; }
#define LANE_ID() lane_id_asm()
#define WAVE_SYNC() asm volatile("s_waitcnt lgkmcnt(0)" ::: "memory")
constexpr int CW_Q = 1024;

typedef float f32x16 __attribute__((ext_vector_type(16)));
typedef short s16x4 __attribute__((ext_vector_type(4)));
typedef float f32x2_t __attribute__((ext_vector_type(2)));
typedef __bf16 bf16x2_t __attribute__((ext_vector_type(2)));
__device__ __forceinline__ unsigned cvtpk(float lo, float hi) { f32x2_t v = {lo, hi}; bf16x2_t b = __builtin_convertvector(v, bf16x2_t); return __builtin_bit_cast(unsigned, b); }
__device__ __forceinline__ bf16x8 pack8(const f32x16& p, int s8) {
    v4u w; w.x = cvtpk(p[s8 + 0], p[s8 + 1]); w.y = cvtpk(p[s8 + 2], p[s8 + 3]); w.z = cvtpk(p[s8 + 4], p[s8 + 5]); w.w = cvtpk(p[s8 + 6], p[s8 + 7]);
    return __builtin_bit_cast(bf16x8, w);
}
typedef short v4i16_t __attribute__((ext_vector_type(4)));
__device__ __forceinline__ s16x4 tr_read(LAS const unsigned char* p) { return __builtin_bit_cast(s16x4, __builtin_amdgcn_ds_read_tr16_b64_v4i16((LAS v4i16_t*)p)); }
__device__ __forceinline__ float xhalf(float v) { return __shfl_xor(v, 32); }
#define CROW(reg) (((reg) & 3) + 8 * ((reg) >> 2))
constexpr float LOG2E = 1.4426950408889634f;

constexpr int ISC_RS = 2056;
__device__ __forceinline__ void ph_idx(const Frame& F, const bf16* __restrict__ proj, unsigned* __restrict__ maskbuf) {
    int lane = LANE_ID(); asm volatile("" : "+v"(lane));
    const int r = lane & 31, h = lane >> 5, wave = F.wave;
    LAS unsigned short* isc_lds = (LAS unsigned short*)F.lds;
    for (int it = (int)blockIdx.x; it < BATCH * 64; it += F.G) {
        const int rnd = it >> 8, w = it & 255, b = w >> 4, s = w & 15;
        const int qb = (rnd == 0) ? s : (rnd == 1) ? 31 - s : (rnd == 2) ? 32 + s : 63 - s;
        const int q0 = qb * 32; const size_t tok0 = (size_t)b * SEQ + q0;
        if (qb < 8) {
#pragma unroll
            for (int qq = 0; qq < 4; ++qq) { const int t = q0 + 4 * wave + qq; int nv = t + 1 - 32 * lane; nv = nv < 0 ? 0 : (nv > 32 ? 32 : nv);
                maskbuf[(tok0 + 4 * wave + qq) * 64 + lane] = (nv == 32) ? 0xffffffffu : ((1u << nv) - 1u); }
            continue;
        }
        {
            const bf16* qrow = proj + (tok0 + r) * PINP;
            typedef unsigned u32x2v __attribute__((ext_vector_type(2)));
            for (int kb = wave; kb <= qb; kb += 2 * NWAVES) {
                const bool v2 = (kb + NWAVES) <= qb; const int kb2 = v2 ? kb + NWAVES : kb;
                const bf16* krowA = proj + ((size_t)b * SEQ + kb * 32 + r) * PINP + C_IK + h * 8;
                const bf16* krowB = proj + ((size_t)b * SEQ + kb2 * 32 + r) * PINP + C_IK + h * 8;
                bf16x8 kfA[4], kfB[4];
#pragma unroll
                for (int ks = 0; ks < 4; ++ks) { kfA[ks] = *(const bf16x8*)(krowA + ks * 16); kfB[ks] = *(const bf16x8*)(krowB + ks * 16); }
                f32x16 iscA, iscB;
#pragma unroll
                for (int i = 0; i < 16; ++i) { iscA[i] = 0.f; iscB[i] = 0.f; }
                bf16x8 qn[4]; float iwn;
#pragma unroll
                for (int ks = 0; ks < 4; ++ks) qn[ks] = *(const bf16x8*)(qrow + C_IQ + ks * 16 + h * 8);
                iwn = bf2f(qrow[C_IW]) * IDX_SCALE;
#pragma unroll 1
                for (int hd = 0; hd < 8; ++hd) {
                    bf16x8 qc[4]; const float iwc = iwn;
#pragma unroll
                    for (int ks = 0; ks < 4; ++ks) qc[ks] = qn[ks];
                    const int hn = (hd + 1) & 7;
#pragma unroll
                    for (int ks = 0; ks < 4; ++ks) qn[ks] = *(const bf16x8*)(qrow + C_IQ + hn * 64 + ks * 16 + h * 8);
                    iwn = bf2f(qrow[C_IW + hn]) * IDX_SCALE;
                    f32x16 accA, accB;
#pragma unroll
                    for (int i = 0; i < 16; ++i) { accA[i] = 0.f; accB[i] = 0.f; }
#pragma unroll
                    for (int ks = 0; ks < 4; ++ks) { accA = __builtin_amdgcn_mfma_f32_32x32x16_bf16(kfA[ks], qc[ks], accA, 0, 0, 0); accB = __builtin_amdgcn_mfma_f32_32x32x16_bf16(kfB[ks], qc[ks], accB, 0, 0, 0); }
#pragma unroll
                    for (int i = 0; i < 16; ++i) { iscA[i] += fmaxf(accA[i], 0.f) * iwc; iscB[i] += fmaxf(accB[i], 0.f) * iwc; }
                }
#pragma unroll
                for (int g = 0; g < 4; ++g) { unsigned kk[4];
#pragma unroll
                    for (int i = 0; i < 4; ++i) { const unsigned u = (unsigned)__builtin_bit_cast(unsigned short, (_Float16)iscA[4 * g + i]); kk[i] = (u & 0x8000u) ? (~u & 0xffffu) : (u | 0x8000u); }
                    u32x2v o; o.x = kk[0] | (kk[1] << 16); o.y = kk[2] | (kk[3] << 16);
                    *(LAS u32x2v*)(isc_lds + r * ISC_RS + kb * 32 + 8 * g + 4 * h) = o; }
                if (v2) {
#pragma unroll
                    for (int g = 0; g < 4; ++g) { unsigned kk[4];
#pragma unroll
                        for (int i = 0; i < 4; ++i) { const unsigned u = (unsigned)__builtin_bit_cast(unsigned short, (_Float16)iscB[4 * g + i]); kk[i] = (u & 0x8000u) ? (~u & 0xffffu) : (u | 0x8000u); }
                        u32x2v o; o.x = kk[0] | (kk[1] << 16); o.y = kk[2] | (kk[3] << 16);
                        *(LAS u32x2v*)(isc_lds + r * ISC_RS + kb2 * 32 + 8 * g + 4 * h) = o; }
                }
            }
        }
        __syncthreads();
#pragma unroll 1
        for (int qq = 0; qq < 4; ++qq) {
            const int rq = 4 * wave + qq, t = q0 + rq;
            int nv = t + 1 - 32 * lane; nv = nv < 0 ? 0 : (nv > 32 ? 32 : nv);
            unsigned key[32];
            { const LAS v4u* src = (const LAS v4u*)(isc_lds + rq * ISC_RS + 32 * lane);
#pragma unroll
              for (int c = 0; c < 4; ++c) { const v4u v = src[c];
                  key[8 * c + 0] = v.x & 0xffffu; key[8 * c + 1] = v.x >> 16; key[8 * c + 2] = v.y & 0xffffu; key[8 * c + 3] = v.y >> 16;
                  key[8 * c + 4] = v.z & 0xffffu; key[8 * c + 5] = v.z >> 16; key[8 * c + 6] = v.w & 0xffffu; key[8 * c + 7] = v.w >> 16; } }
#pragma unroll
            for (int j = 0; j < 32; ++j) key[j] = (j < nv) ? key[j] : 0u;
            unsigned prefix = 0u;
#pragma unroll 1
            for (int bit = 15; bit >= 0; --bit) {
                const unsigned cand = prefix | (1u << bit); int c = 0;
#pragma unroll
                for (int j = 0; j < 32; ++j) c += (key[j] >= cand) ? 1 : 0;
                c = wave_sum_i(c);
                if (c >= 256) prefix = cand;
            }
            int cg = 0, ce = 0;
#pragma unroll
            for (int j = 0; j < 32; ++j) { cg += (key[j] > prefix) ? 1 : 0; ce += (key[j] == prefix) ? 1 : 0; }
            const int need = 256 - wave_sum_i(cg);
            int excl = ce;
#pragma unroll
            for (int off = 1; off < 64; off <<= 1) { const int y = __shfl_up(excl, off); if (lane >= off) excl += y; }
            excl -= ce;
            unsigned word = 0u; int run = excl;
#pragma unroll
            for (int j = 0; j < 32; ++j) { const bool gt = key[j] > prefix, eq = key[j] == prefix; const bool sel = gt || (eq && run < need); run += eq ? 1 : 0; word |= sel ? (1u << j) : 0u; }
            maskbuf[(tok0 + rq) * 64 + lane] = word;
        }
        __syncthreads();
    }
}

constexpr int VT_RS = 144;
__device__ __forceinline__ void pv_block(f32x16& o0, f32x16& o1, LAS const unsigned char* vt, const bf16x8 pb0, const bf16x8 pb1, int lane) {
    const int h = lane >> 5;
    LAS const unsigned char* base = vt + (4 * h + ((lane & 15) >> 2)) * VT_RS + (16 * ((lane >> 4) & 1) + 4 * (lane & 3)) * 2;
#pragma unroll
    for (int db = 0; db < 2; ++db) {
#pragma unroll
        for (int s = 0; s < 2; ++s) {
            const s16x4 lo = tr_read(base + (16 * s) * VT_RS + db * 64), hi = tr_read(base + (16 * s + 8) * VT_RS + db * 64);
            const bf16x8 vf = (bf16x8){lo[0], lo[1], lo[2], lo[3], hi[0], hi[1], hi[2], hi[3]};
            if (db == 0) o0 = __builtin_amdgcn_mfma_f32_32x32x16_bf16(vf, s == 0 ? pb0 : pb1, o0, 0, 0, 0);
            else         o1 = __builtin_amdgcn_mfma_f32_32x32x16_bf16(vf, s == 0 ? pb0 : pb1, o1, 0, 0, 0);
        }
    }
}
__device__ __forceinline__ void store_ot(bf16* dst, const f32x16& o0, const f32x16& o1, float sc, int h) {
#pragma unroll
    for (int g = 0; g < 4; ++g) {
        uint2 a; a.x = cvtpk(o0[4 * g] * sc, o0[4 * g + 1] * sc); a.y = cvtpk(o0[4 * g + 2] * sc, o0[4 * g + 3] * sc); *(uint2*)(dst + 8 * g + 4 * h) = a;
        uint2 c; c.x = cvtpk(o1[4 * g] * sc, o1[4 * g + 1] * sc); c.y = cvtpk(o1[4 * g + 2] * sc, o1[4 * g + 3] * sc); *(uint2*)(dst + 32 + 8 * g + 4 * h) = c;
    }
}
__device__ __forceinline__ void dsa_att_item(const bf16* __restrict__ proj, const unsigned* __restrict__ maskbuf, bf16* __restrict__ obuf, int b, int qb, int hd, LAS unsigned char* wl, int lane) {
    const int r = lane & 31, h = lane >> 5;
    const size_t tok0 = (size_t)b * SEQ + qb * 32; const int t = qb * 32 + r;
    const float slope[5] = {0.32987697769322355f, 0.1088188204120155f, 0.03589682359365735f, 0.011841535675862483f, 0.00390625f};
    const float c1 = 0.125f * LOG2E, c2 = slope[hd] * LOG2E;
    bf16x8 qf[4];
#pragma unroll
    for (int ks = 0; ks < 4; ++ks) qf[ks] = *(const bf16x8*)(proj + (tok0 + r) * PINP + C_DQ + hd * 64 + ks * 16 + h * 8);
    f32x16 o0, o1;
#pragma unroll
    for (int i = 0; i < 16; ++i) { o0[i] = 0.f; o1[i] = 0.f; }
    float m = -1e30f, l = 0.f;
    const unsigned* mrow = maskbuf + (tok0 + r) * 64;
    for (int kb = 0; kb <= qb; ++kb) {
        const int key0 = kb * 32;
        const bf16* kbase = proj + ((size_t)b * SEQ + key0) * PINP;
        v4u vst[4];
#pragma unroll
        for (int i = 0; i < 4; ++i) vst[i] = *(const v4u*)(kbase + (size_t)((lane >> 3) + 8 * i) * PINP + C_VH + hd * 64 + (lane & 7) * 8);
        bf16x8 kf[4];
#pragma unroll
        for (int ks = 0; ks < 4; ++ks) kf[ks] = *(const bf16x8*)(kbase + (size_t)r * PINP + C_DK + ks * 16 + h * 8);
        const unsigned word = mrow[kb] >> (4 * h);
        f32x16 S;
#pragma unroll
        for (int i = 0; i < 16; ++i) S[i] = 0.f;
#pragma unroll
        for (int ks = 0; ks < 4; ++ks) S = __builtin_amdgcn_mfma_f32_32x32x16_bf16(kf[ks], qf[ks], S, 0, 0, 0);
        asm volatile("" ::: "memory");
#pragma unroll
        for (int i = 0; i < 4; ++i) *(LAS v4u*)(wl + ((lane >> 3) + 8 * i) * VT_RS + (lane & 7) * 16) = vst[i];
        asm volatile("" ::: "memory");
        const float dist0 = (float)(t - key0 - 4 * h);
        float mx = -INFINITY;
#pragma unroll
        for (int i = 0; i < 16; ++i) { const bool sel = (word >> CROW(i)) & 1u; S[i] = sel ? (S[i] * c1 - c2 * (dist0 - (float)CROW(i))) : -INFINITY; mx = fmaxf(mx, S[i]); }
        mx = fmaxf(mx, xhalf(mx));
        const float mn = fmaxf(m, mx), alpha = __builtin_amdgcn_exp2f(m - mn);
        float ls = 0.f;
#pragma unroll
        for (int i = 0; i < 16; ++i) { S[i] = __builtin_amdgcn_exp2f(S[i] - mn); ls += S[i]; }
        ls += xhalf(ls);
        l = l * alpha + ls; m = mn;
#pragma unroll
        for (int i = 0; i < 16; ++i) { o0[i] *= alpha; o1[i] *= alpha; }
        const bf16x8 pb0 = pack8(S, 0), pb1 = pack8(S, 8);
        pv_block(o0, o1, wl, pb0, pb1, lane);
        asm volatile("" ::: "memory");
    }
    store_ot(obuf + (tok0 + r) * D + O_DSA + hd * 64, o0, o1, 1.f / l, h);
}
__device__ __forceinline__ void ph_dsa_att(const Frame& F, const bf16* __restrict__ proj, const unsigned* __restrict__ maskbuf, bf16* __restrict__ obuf, unsigned* counter) {
    int lane = LANE_ID(); asm volatile("" : "+v"(lane));
    LAS unsigned char* wl = F.lds + F.wave * 16384;
    for (;;) {
        unsigned it = 0; if (lane == 0) it = atomicAdd(counter, 1u);
        it = (unsigned)__builtin_amdgcn_readfirstlane((int)it);
        if (it >= (unsigned)(BATCH * 64 * 5)) break;
        const int qb = 63 - (int)(it / 80u), rem = (int)(it % 80u);
        dsa_att_item(proj, maskbuf, obuf, rem / 5, qb, rem % 5, wl, lane);
    }
}
__device__ __forceinline__ void fold_vh_item(const float* __restrict__ w_in, const float* __restrict__ wuv, bf16* __restrict__ Wt, int item, int lane) {
    const int hd = item / (D / 8), k0 = (item % (D / 8)) * 8;
    float acc[8];
#pragma unroll
    for (int i = 0; i < 8; ++i) acc[i] = 0.f;
    for (int c = 0; c < 128; ++c) { const float u = wuv[((size_t)hd * 128 + c) * 64 + lane];
#pragma unroll
        for (int i = 0; i < 8; ++i) acc[i] += u * w_in[(size_t)(k0 + i) * PIN + C_DV + c]; }
    v4u o; o.x = pk2(acc[0], acc[1]); o.y = pk2(acc[2], acc[3]); o.z = pk2(acc[4], acc[5]); o.w = pk2(acc[6], acc[7]);
    *(v4u*)(Wt + (size_t)(C_VH + hd * 64 + lane) * D + k0) = o;
}

__device__ __forceinline__ void sb_att_item(const bf16* __restrict__ proj, bf16* __restrict__ obuf, int b, int qb, int hd, LAS unsigned char* wl, int lane) {
    const int r = lane & 31, h = lane >> 5;
    const size_t tok0 = (size_t)b * SEQ + qb * 32; const int t = qb * 32 + r;
    const float c1 = 0.125f * LOG2E;
    bf16x8 qf[4];
#pragma unroll
    for (int ks = 0; ks < 4; ++ks) qf[ks] = *(const bf16x8*)(proj + (tok0 + r) * PINP + C_SQ + hd * 64 + ks * 16 + h * 8);
    f32x16 o0, o1;
#pragma unroll
    for (int i = 0; i < 16; ++i) { o0[i] = 0.f; o1[i] = 0.f; }
    float carry = 0.f;
    for (int kb = qb; kb >= 0; --kb) {
        const int key0 = kb * 32;
        const bf16* kbase = proj + ((size_t)b * SEQ + key0) * PINP;
        v4u vst[4];
#pragma unroll
        for (int i = 0; i < 4; ++i) vst[i] = *(const v4u*)(kbase + (size_t)((lane >> 3) + 8 * i) * PINP + C_SV + hd * 64 + (lane & 7) * 8);
        bf16x8 kf[4];
#pragma unroll
        for (int ks = 0; ks < 4; ++ks) kf[ks] = *(const bf16x8*)(kbase + (size_t)r * PINP + C_SK + hd * 64 + ks * 16 + h * 8);
        f32x16 S;
#pragma unroll
        for (int i = 0; i < 16; ++i) S[i] = 0.f;
#pragma unroll
        for (int ks = 0; ks < 4; ++ks) S = __builtin_amdgcn_mfma_f32_32x32x16_bf16(kf[ks], qf[ks], S, 0, 0, 0);
        asm volatile("" ::: "memory");
#pragma unroll
        for (int i = 0; i < 4; ++i) *(LAS v4u*)(wl + ((lane >> 3) + 8 * i) * VT_RS + (lane & 7) * 16) = vst[i];
        asm volatile("" ::: "memory");
        const int lim = t - key0 - 4 * h;
        f32x16 lg;
#pragma unroll
        for (int i = 0; i < 16; ++i) { const float z2 = S[i] * c1; const float sp2 = fmaxf(z2, 0.f) + __builtin_amdgcn_logf(1.f + __builtin_amdgcn_exp2f(-fabsf(z2)));
            const bool strict = CROW(i) < lim; lg[i] = strict ? -sp2 : 0.f; S[i] = strict ? (z2 - sp2) : -INFINITY; }
        float To[4], Tp[4];
#pragma unroll
        for (int g = 0; g < 4; ++g) { To[g] = (lg[4 * g] + lg[4 * g + 1]) + (lg[4 * g + 2] + lg[4 * g + 3]); Tp[g] = xhalf(To[g]); }
        float R[4]; R[3] = 0.f; R[2] = To[3] + Tp[3]; R[1] = R[2] + (To[2] + Tp[2]); R[0] = R[1] + (To[1] + Tp[1]);
        const float total = R[0] + (To[0] + Tp[0]);
#pragma unroll
        for (int g = 0; g < 4; ++g) { float suf = R[g] + ((h == 0) ? Tp[g] : 0.f) + carry;
#pragma unroll
            for (int i = 3; i >= 0; --i) { const float e = S[4 * g + i] + suf; suf += lg[4 * g + i]; S[4 * g + i] = __builtin_amdgcn_exp2f(e); } }
        carry += total;
        const bf16x8 pb0 = pack8(S, 0), pb1 = pack8(S, 8);
        pv_block(o0, o1, wl, pb0, pb1, lane);
        asm volatile("" ::: "memory");
        if (__all(carry < -150.f)) break;
    }
    store_ot(obuf + (tok0 + r) * D + O_SB + hd * 64, o0, o1, 1.f, h);
}
__device__ __forceinline__ void ph_sb_att(const Frame& F, const bf16* __restrict__ proj, bf16* __restrict__ obuf, unsigned* counter) {
    int lane = LANE_ID(); asm volatile("" : "+v"(lane));
    LAS unsigned char* wl = F.lds + F.wave * 16384;
    for (;;) {
        unsigned it = 0; if (lane == 0) it = atomicAdd(counter, 1u);
        it = (unsigned)__builtin_amdgcn_readfirstlane((int)it);
        if (it >= (unsigned)(BATCH * 64 * 5)) break;
        const int qb = 63 - (int)(it / 80u), rem = (int)(it % 80u);
        sb_att_item(proj, obuf, rem / 5, qb, rem % 5, wl, lane);
    }
}

constexpr int MV_RS = 272;
__device__ __forceinline__ void mem_att_item(const bf16* __restrict__ qmem, const bf16* __restrict__ kv, bf16* __restrict__ obuf, int b, int hd, int qb, int dh, LAS unsigned char* wl, int lane) {
    const int r = lane & 31, h = lane >> 5;
    const size_t tok0 = (size_t)b * SEQ + qb * 32;
    const float c1 = 0.0625f * LOG2E;
    bf16x8 qf[16];
#pragma unroll
    for (int ks = 0; ks < 16; ++ks) qf[ks] = *(const bf16x8*)(qmem + (tok0 + r) * D + hd * 256 + ks * 16 + h * 8);
    f32x16 o[4];
#pragma unroll
    for (int d = 0; d < 4; ++d)
#pragma unroll
        for (int i = 0; i < 16; ++i) o[d][i] = 0.f;
    float m = -1e30f, l = 0.f;
    const bf16* kvb = kv + (size_t)b * MEMT * 2048;
#pragma unroll 1
    for (int kb = 0; kb < MEMT / 32; ++kb) {
        const bf16* krow = kvb + (size_t)(kb * 32 + r) * 2048 + hd * 256 + h * 8;
        v4u vst[8];
#pragma unroll
        for (int i = 0; i < 8; ++i) vst[i] = *(const v4u*)(kvb + (size_t)(kb * 32 + (lane >> 4) + 4 * i) * 2048 + 1024 + hd * 256 + dh * 128 + (lane & 15) * 8);
        f32x16 S;
#pragma unroll
        for (int i = 0; i < 16; ++i) S[i] = 0.f;
#pragma unroll
        for (int ks = 0; ks < 16; ++ks) { const bf16x8 kf = *(const bf16x8*)(krow + ks * 16); S = __builtin_amdgcn_mfma_f32_32x32x16_bf16(kf, qf[ks], S, 0, 0, 0); }
        asm volatile("" ::: "memory");
#pragma unroll
        for (int i = 0; i < 8; ++i) *(LAS v4u*)(wl + ((lane >> 4) + 4 * i) * MV_RS + (lane & 15) * 16) = vst[i];
        asm volatile("" ::: "memory");
        float mx = -INFINITY;
#pragma unroll
        for (int i = 0; i < 16; ++i) { S[i] *= c1; mx = fmaxf(mx, S[i]); }
        mx = fmaxf(mx, xhalf(mx));
        const float mn = fmaxf(m, mx), alpha = __builtin_amdgcn_exp2f(m - mn);
        float ls = 0.f;
#pragma unroll
        for (int i = 0; i < 16; ++i) { S[i] = __builtin_amdgcn_exp2f(S[i] - mn); ls += S[i]; }
        ls += xhalf(ls);
        l = l * alpha + ls; m = mn;
#pragma unroll
        for (int d = 0; d < 4; ++d)
#pragma unroll
            for (int i = 0; i < 16; ++i) o[d][i] *= alpha;
        const bf16x8 pb0 = pack8(S, 0), pb1 = pack8(S, 8);
        LAS const unsigned char* base = wl + (4 * h + ((lane & 15) >> 2)) * MV_RS + (16 * ((lane >> 4) & 1) + 4 * (lane & 3)) * 2;
#pragma unroll
        for (int d = 0; d < 4; ++d) {
#pragma unroll
            for (int s = 0; s < 2; ++s) {
                const s16x4 lo = tr_read(base + (16 * s) * MV_RS + d * 64), hi = tr_read(base + (16 * s + 8) * MV_RS + d * 64);
                const bf16x8 vf = (bf16x8){lo[0], lo[1], lo[2], lo[3], hi[0], hi[1], hi[2], hi[3]};
                o[d] = __builtin_amdgcn_mfma_f32_32x32x16_bf16(vf, s == 0 ? pb0 : pb1, o[d], 0, 0, 0);
            }
        }
        asm volatile("" ::: "memory");
    }
    const float inv = 1.f / l;
    bf16* dst = obuf + (tok0 + r) * D + hd * 256 + dh * 128;
#pragma unroll
    for (int d = 0; d < 4; ++d)
#pragma unroll
        for (int g = 0; g < 4; ++g) { uint2 a; a.x = cvtpk(o[d][4 * g] * inv, o[d][4 * g + 1] * inv); a.y = cvtpk(o[d][4 * g + 2] * inv, o[d][4 * g + 3] * inv); *(uint2*)(dst + 32 * d + 8 * g + 4 * h) = a; }
}
__device__ __forceinline__ void ph_mem_att(const Frame& F, const bf16* __restrict__ qmem, const bf16* __restrict__ kv, bf16* __restrict__ obuf) {
    int lane = LANE_ID(); asm volatile("" : "+v"(lane));
    LAS unsigned char* wl = F.lds + F.wave * 16384;
    for (int it = F.gw; it < BATCH * 4 * 64 * 2; it += F.NGW) {
        const int dh = it & 1, qb = (it >> 1) & 63, hd = (it >> 7) & 3, b = it >> 9;
        mem_att_item(qmem, kv, obuf, b, hd, qb, dh, wl, lane);
    }
}


__device__ __forceinline__ void tr_item(const float* __restrict__ W, int K, int N, int Npad, bf16* __restrict__ WT, LAS float* scr, int item, int lane) {
    const int nblk = Npad / 32, kb = item / nblk, nb = item % nblk, k0 = 64 * kb, n0 = 32 * nb;
    const int n = n0 + (lane & 31);
#pragma unroll 8
    for (int i = 0; i < 32; ++i) { const int kk = 2 * i + (lane >> 5); scr[kk * 33 + (lane & 31)] = (n < N) ? W[(size_t)(k0 + kk) * N + n] : 0.f; }
    WAVE_SYNC();
    const int c = lane & 7;
#pragma unroll
    for (int j = 0; j < 4; ++j) { const int nn = (lane >> 3) + 8 * j; const LAS float* s = scr + (8 * c) * 33 + nn;
        v4u o; o.x = pk2(s[0 * 33], s[1 * 33]); o.y = pk2(s[2 * 33], s[3 * 33]); o.z = pk2(s[4 * 33], s[5 * 33]); o.w = pk2(s[6 * 33], s[7 * 33]);
        *(v4u*)(WT + (size_t)(n0 + nn) * K + k0 + 8 * c) = o; }
    WAVE_SYNC();
}
__device__ __forceinline__ void ln_row(const float* src, const float* __restrict__ g, const float* __restrict__ b, bf16* dstb, float* dstf, int lane) {
    const float4* xr = (const float4*)src + lane;
    float4 v[4]; float s = 0.f;
#pragma unroll
    for (int j = 0; j < 4; ++j) { v[j] = xr[64 * j]; s += (v[j].x + v[j].y) + (v[j].z + v[j].w); }
    const float mean = wave_sum(s) * (1.f / D); float s2 = 0.f;
#pragma unroll
    for (int j = 0; j < 4; ++j) { v[j].x -= mean; v[j].y -= mean; v[j].z -= mean; v[j].w -= mean; s2 += (v[j].x * v[j].x + v[j].y * v[j].y) + (v[j].z * v[j].z + v[j].w * v[j].w); }
    const float rstd = 1.f / sqrtf(wave_sum(s2) * (1.f / D) + LN_EPS);
#pragma unroll
    for (int j = 0; j < 4; ++j) {
        const float4 gg = ((const float4*)g)[lane + 64 * j], bb = ((const float4*)b)[lane + 64 * j];
        float4 y; y.x = v[j].x * rstd * gg.x + bb.x; y.y = v[j].y * rstd * gg.y + bb.y; y.z = v[j].z * rstd * gg.z + bb.z; y.w = v[j].w * rstd * gg.w + bb.w;
        uint2 o; o.x = pk2(y.x, y.y); o.y = pk2(y.z, y.w); ((uint2*)dstb)[lane + 64 * j] = o;
        if (dstf) ((float4*)dstf)[lane + 64 * j] = y;
    }
}
__device__ __forceinline__ void ph_ln(const Frame& F, const float* src, const float* g, const float* b, bf16* dstb, float* dstf) {
    int lane = LANE_ID(); asm volatile("" : "+v"(lane));
    for (int m = F.gw; m < M; m += F.NGW) ln_row(src + (size_t)m * D, g, b, dstb + (size_t)m * D, dstf ? dstf + (size_t)m * D : (float*)nullptr, lane);
}
__device__ __forceinline__ void ph_prologue(const Frame& F, const float* const* in, unsigned char* ws) {
    int lane_ = LANE_ID(); asm volatile("" : "+v"(lane_));
    LAS float* scr = (LAS float*)(F.lds + F.wave * 16384);
    for (int l = 0; l < DEPTH; ++l) {
        bf16* Wl = (bf16*)(ws + WS_W) + (size_t)l * LW_END;
        for (int it = F.gw; it < (D / 64) * (C_VH / 32); it += F.NGW) tr_item(in[4] + (size_t)l * D * PIN, D, PIN, C_VH, Wl + LW_IN, scr, it, lane_);
        for (int it = F.gw; it < 5 * (D / 8); it += F.NGW) fold_vh_item(in[4] + (size_t)l * D * PIN, in[8] + (size_t)l * 5 * 128 * 64, Wl + LW_IN, it, lane_);
        for (int i = F.gw * 64 + lane_; i < (PINP - C_VH - 320) * D / 8; i += F.NGW * 64) ((v4u*)(Wl + LW_IN + (size_t)(C_VH + 320) * D))[i] = (v4u){0u, 0u, 0u, 0u};
        for (int it = F.gw; it < (D / 64) * (D / 32); it += F.NGW) tr_item(in[9] + (size_t)l * D * D, D, D, D, Wl + LW_OUT, scr, it, lane_);
        for (int it = F.gw; it < (D / 64) * (D / 32); it += F.NGW) tr_item(in[12] + (size_t)l * D * D, D, D, D, Wl + LW_MQ, scr, it, lane_);
        for (int it = F.gw; it < (D / 64) * (2 * D / 32); it += F.NGW) tr_item(in[13] + (size_t)l * D * 2 * D, D, 2 * D, 2 * D, Wl + LW_MKV, scr, it, lane_);
        for (int it = F.gw; it < (D / 64) * (D / 32); it += F.NGW) tr_item(in[14] + (size_t)l * D * D, D, D, D, Wl + LW_MO, scr, it, lane_);
        for (int it = F.gw; it < (D / 64) * (FF / 32); it += F.NGW) tr_item(in[17] + (size_t)l * D * FF, D, FF, FF, Wl + LW_UP, scr, it, lane_);
        for (int it = F.gw; it < (FF / 64) * (D / 32); it += F.NGW) tr_item(in[19] + (size_t)l * FF * D, FF, D, D, Wl + LW_DN, scr, it, lane_);
    }
    { const float4* src = (const float4*)in[1]; uint2* dst = (uint2*)(ws + WS_MEMB);
      for (size_t i = (size_t)F.gw * 64 + lane_; i < (size_t)MKV * D / 4; i += (size_t)F.NGW * 64) { const float4 v = src[i]; uint2 o; o.x = pk2(v.x, v.y); o.y = pk2(v.z, v.w); dst[i] = o; } }
    ph_ln(F, in[0], in[2], in[3], (bf16*)(ws + WS_H), (float*)nullptr);
}
__device__ __forceinline__ void ph_gla_gate(const Frame& F, const bf16* __restrict__ proj, const float* __restrict__ w2, const float* __restrict__ gb, float* __restrict__ gl) {
    int lane = LANE_ID(); asm volatile("" : "+v"(lane));
    for (size_t idx = (size_t)F.gw * 64 + lane; idx < (size_t)M * 192; idx += (size_t)F.NGW * 64) {
        const int t = (int)(idx / 192), j = (int)(idx % 192);
        float acc = 0.f;
#pragma unroll
        for (int r = 0; r < 16; ++r) acc += bf2f(proj[(size_t)t * PINP + C_GLR + r]) * w2[r * 192 + j];
        acc += gb[j];
        const float ls = fminf(acc, 0.f) - log1pf(expf(-fabsf(acc)));
        gl[idx] = ls * (1.f / 16.f);
    }
}
__device__ __forceinline__ void ph_gla_rec(const Frame& F, const bf16* __restrict__ proj, const float* __restrict__ gl, float* __restrict__ oraw) {
    if ((int)blockIdx.x >= BATCH * 4) return;
    int tid = LANE_ID() + 64 * F.wave; asm volatile("" : "+v"(tid)); const int b = blockIdx.x >> 2, h = blockIdx.x & 3;
    LAS float* sq = (LAS float*)F.lds; LAS float* sk = sq + 32 * 48; LAS float* sa = sk + 32 * 48;
    float S[48];
#pragma unroll
    for (int d = 0; d < 48; ++d) S[d] = 0.f;
    for (int t0 = 0; t0 < SEQ; t0 += 32) {
        __syncthreads();
        for (int i = tid; i < 32 * 48; i += NWAVES * 64) { const int tt = i / 48, d = i % 48; const size_t row = (size_t)b * SEQ + t0 + tt;
            sq[i] = bf2f(proj[row * PINP + C_GQ + h * 48 + d]) * GLA_QSCALE; sk[i] = bf2f(proj[row * PINP + C_GK + h * 48 + d]); sa[i] = expf(gl[row * 192 + h * 48 + d]); }
        __syncthreads();
        if (tid < 96) {
            for (int tt = 0; tt < 32; ++tt) { const size_t row = (size_t)b * SEQ + t0 + tt; const float v = bf2f(proj[row * PINP + C_GV + h * 96 + tid]); float o = 0.f;
#pragma unroll
                for (int d = 0; d < 48; ++d) { S[d] = sa[tt * 48 + d] * S[d] + sk[tt * 48 + d] * v; o += sq[tt * 48 + d] * S[d]; }
                oraw[row * 384 + h * 96 + tid] = o; }
        }
    }
    __syncthreads();
}
__device__ __forceinline__ void ph_gla_fin(const Frame& F, const bf16* __restrict__ proj, const float* __restrict__ oraw, const float* __restrict__ ng, bf16* __restrict__ obuf) {
    int lane = LANE_ID(); asm volatile("" : "+v"(lane));
    for (int gw = F.gw; gw < M * 4; gw += F.NGW) {
        const int t = gw >> 2, h = gw & 3;
        const float o0 = oraw[(size_t)t * 384 + h * 96 + lane], o1 = lane < 32 ? oraw[(size_t)t * 384 + h * 96 + 64 + lane] : 0.f;
        const float ss = wave_sum(o0 * o0 + o1 * o1);
        const float r = 1.f / sqrtf(ss * (1.f / 96.f) + LN_EPS);
        { const float g = bf2f(proj[(size_t)t * PINP + C_GG + h * 96 + lane]); const float y = o0 * r * ng[lane] * (g / (1.f + expf(-g))); obuf[(size_t)t * D + O_GLA + h * 96 + lane] = (bf16)f2bf(y); }
        if (lane < 32) { const float g = bf2f(proj[(size_t)t * PINP + C_GG + h * 96 + 64 + lane]); const float y = o1 * r * ng[64 + lane] * (g / (1.f + expf(-g))); obuf[(size_t)t * D + O_GLA + h * 96 + 64 + lane] = (bf16)f2bf(y); }
    }
}
__device__ __forceinline__ void ph_sb(const Frame& F, const bf16* __restrict__ proj, bf16* __restrict__ obuf) {
    int lane = LANE_ID(); asm volatile("" : "+v"(lane));
    for (int gw = F.gw; gw < M * 5; gw += F.NGW) {
        const int tok = gw / 5, hd = gw % 5, b = tok / SEQ, t = tok % SEQ;
        float q[64];
        { const uint4* qr = (const uint4*)(proj + (size_t)tok * PINP + C_SQ + hd * 64);
#pragma unroll
          for (int i = 0; i < 8; ++i) { float f[8]; unpack8(qr[i], f);
#pragma unroll
              for (int e = 0; e < 8; ++e) q[8 * i + e] = f[e] * 0.125f; } }
        float o = 0.f, carry = 0.f;
        for (int base = t - 1; base >= 0; base -= 64) {
            const int s = base - lane; const bool valid = s >= 0;
            float z = 0.f;
            if (valid) { const uint4* kr = (const uint4*)(proj + ((size_t)b * SEQ + s) * PINP + C_SK + hd * 64);
#pragma unroll
                for (int i = 0; i < 8; ++i) { float f[8]; unpack8(kr[i], f);
#pragma unroll
                    for (int e = 0; e < 8; ++e) z += q[8 * i + e] * f[e]; } }
            const float sp = fmaxf(z, 0.f) + log1pf(expf(-fabsf(z)));
            const float l = valid ? -sp : 0.f;
            float inc = l;
#pragma unroll
            for (int off = 1; off < 64; off <<= 1) { const float y = __shfl_up(inc, off); if (lane >= off) inc += y; }
            const float w = valid ? expf((z - sp) + (inc - l) + carry) : 0.f;
            const float tot = __shfl(inc, 63);
            const int nv = (base + 1 < 64) ? base + 1 : 64;
            for (int i = 0; i < nv; ++i) { const float wi = __shfl(w, i); o += wi * bf2f(proj[((size_t)b * SEQ + (base - i)) * PINP + C_SV + hd * 64 + lane]); }
            carry += tot;
            if (carry < -104.f) break;
        }
        obuf[(size_t)tok * D + O_SB + hd * 64 + lane] = (bf16)f2bf(o);
    }
}
__device__ __forceinline__ void ph_dsa(const Frame& F, const bf16* __restrict__ proj, const float* __restrict__ wuv, bf16* __restrict__ obuf) {
    int lane = LANE_ID(); asm volatile("" : "+v"(lane));
    LAS unsigned char* wl = F.lds + F.wave * 12544;
    LAS unsigned* s_key = (LAS unsigned*)wl;
    LAS float* s_p = (LAS float*)wl;
    LAS float* s_ol = (LAS float*)(wl + 5120);
    LAS float* s_iq = (LAS float*)(wl + 8192);
    LAS float* s_q = (LAS float*)(wl + 10240);
    LAS int* s_idx = (LAS int*)(wl + 11520);
    const unsigned long long lt_mask = (lane == 0) ? 0ull : (~0ull >> (64 - lane));
    for (int tok = F.gw; tok < M; tok += F.NGW) {
        const int b = tok / SEQ, t = tok % SEQ;
        const bf16* prow = proj + (size_t)tok * PINP;
        WAVE_SYNC();
        for (int i = lane; i < 512; i += 64) s_iq[i] = bf2f(prow[C_IQ + i]);
        for (int i = lane; i < 320; i += 64) s_q[i] = bf2f(prow[C_DQ + i]);
        float iw[8];
#pragma unroll
        for (int h = 0; h < 8; ++h) iw[h] = bf2f(prow[C_IW + h]);
        WAVE_SYNC();
        for (int j = 0; j < 32; ++j) {
            const int s = lane + 64 * j; unsigned kk = 0u;
            if (s <= t) {
                const uint4* kr = (const uint4*)(proj + ((size_t)b * SEQ + s) * PINP + C_IK);
                float dot[8];
#pragma unroll
                for (int h = 0; h < 8; ++h) dot[h] = 0.f;
#pragma unroll 1
                for (int i = 0; i < 8; ++i) { float f[8]; unpack8(kr[i], f);
#pragma unroll
                    for (int h = 0; h < 8; ++h)
#pragma unroll
                        for (int e = 0; e < 8; ++e) dot[h] += s_iq[h * 64 + 8 * i + e] * f[e]; }
                float isc = 0.f;
#pragma unroll
                for (int h = 0; h < 8; ++h) isc += fmaxf(dot[h], 0.f) * iw[h];
                isc *= IDX_SCALE;
                const unsigned u = __float_as_uint(isc); kk = (u & 0x80000000u) ? ~u : (u | 0x80000000u);
            }
            s_key[s] = kk;
        }
        WAVE_SYNC();
        int nsel;
        if (t + 1 <= 256) {
            nsel = t + 1;
            for (int i = lane; i < nsel; i += 64) s_idx[i] = i;
        } else {
            unsigned prefix = 0u;
            for (int bit = 31; bit >= 0; --bit) {
                const unsigned cand = prefix | (1u << bit); int c = 0;
                for (int j = 0; j < 32; ++j) c += (s_key[lane + 64 * j] >= cand) ? 1 : 0;
                c = wave_sum_i(c);
                if (c >= 256) prefix = cand;
            }
            int cg = 0;
            for (int j = 0; j < 32; ++j) cg += (s_key[lane + 64 * j] > prefix) ? 1 : 0;
            cg = wave_sum_i(cg);
            const int need = 256 - cg;
            int base_sel = 0, base_tie = 0;
            for (int j = 0; j < 32; ++j) {
                const unsigned k = s_key[lane + 64 * j]; const bool gt = k > prefix, eq = (k == prefix);
                const unsigned long long beq = __ballot(eq); const int tie_rank = base_tie + __popcll(beq & lt_mask);
                const bool sel = gt || (eq && tie_rank < need);
                const unsigned long long bs = __ballot(sel); const int pos = base_sel + __popcll(bs & lt_mask);
                if (sel) s_idx[pos] = lane + 64 * j;
                base_sel += __popcll(bs); base_tie += __popcll(beq);
            }
            nsel = 256;
        }
        WAVE_SYNC();
        const float slope[5] = {0.32987697769322355f, 0.1088188204120155f, 0.03589682359365735f, 0.011841535675862483f, 0.00390625f};
#pragma unroll 1
        for (int m = 0; m < 4; ++m) {
            const int kidx = lane + 64 * m;
            float dot[5];
#pragma unroll
            for (int h = 0; h < 5; ++h) dot[h] = -INFINITY;
            if (kidx < nsel) {
                const int si = s_idx[kidx];
                const uint4* kr = (const uint4*)(proj + ((size_t)b * SEQ + si) * PINP + C_DK);
#pragma unroll
                for (int h = 0; h < 5; ++h) dot[h] = 0.f;
#pragma unroll 1
                for (int i = 0; i < 8; ++i) { float f[8]; unpack8(kr[i], f);
#pragma unroll
                    for (int h = 0; h < 5; ++h)
#pragma unroll
                        for (int e = 0; e < 8; ++e) dot[h] += s_q[h * 64 + 8 * i + e] * f[e]; }
#pragma unroll
                for (int h = 0; h < 5; ++h) dot[h] = dot[h] * 0.125f - slope[h] * (float)(t - si);
            }
#pragma unroll
            for (int h = 0; h < 5; ++h) s_p[h * 256 + kidx] = dot[h];
        }
        WAVE_SYNC();
#pragma unroll 1
        for (int h = 0; h < 5; ++h) {
            float sc[4];
#pragma unroll
            for (int m = 0; m < 4; ++m) sc[m] = s_p[h * 256 + lane + 64 * m];
            const float mx = wave_max(fmaxf(fmaxf(sc[0], sc[1]), fmaxf(sc[2], sc[3])));
            float e[4], se = 0.f;
#pragma unroll
            for (int m = 0; m < 4; ++m) { e[m] = (lane + 64 * m < nsel) ? expf(sc[m] - mx) : 0.f; se += e[m]; }
            const float inv = 1.f / wave_sum(se);
#pragma unroll
            for (int m = 0; m < 4; ++m) s_p[h * 256 + lane + 64 * m] = e[m] * inv;
        }
        WAVE_SYNC();
        float a0[5], a1[5];
#pragma unroll
        for (int h = 0; h < 5; ++h) { a0[h] = 0.f; a1[h] = 0.f; }
        for (int k = 0; k < nsel; ++k) {
            const int si = s_idx[k]; const bf16* vr = proj + ((size_t)b * SEQ + si) * PINP + C_DV;
            const float v0 = bf2f(vr[lane]), v1 = bf2f(vr[lane + 64]);
#pragma unroll
            for (int h = 0; h < 5; ++h) { const float p = s_p[h * 256 + k]; a0[h] += p * v0; a1[h] += p * v1; }
        }
        WAVE_SYNC();
#pragma unroll
        for (int h = 0; h < 5; ++h) { s_ol[h * 128 + lane] = a0[h]; s_ol[h * 128 + lane + 64] = a1[h]; }
        WAVE_SYNC();
#pragma unroll
        for (int h = 0; h < 5; ++h) { float o = 0.f;
            for (int c = 0; c < 128; ++c) o += s_ol[h * 128 + c] * wuv[(h * 128 + c) * 64 + lane];
            obuf[(size_t)tok * D + O_DSA + h * 64 + lane] = (bf16)f2bf(o); }
    }
}
__device__ __forceinline__ void ph_memattn(const Frame& F, const bf16* __restrict__ qmem, const bf16* __restrict__ kv, bf16* __restrict__ obuf) {
    int lane = LANE_ID(); asm volatile("" : "+v"(lane));
    LAS float* s_q = (LAS float*)(F.lds + F.wave * 2048); LAS float* s_p = s_q + 256;
    for (int gw = F.gw; gw < M * 4; gw += F.NGW) {
        const int tok = gw >> 2, hd = gw & 3, b = tok / SEQ;
        WAVE_SYNC();
#pragma unroll
        for (int i = 0; i < 4; ++i) s_q[lane + 64 * i] = bf2f(qmem[(size_t)tok * D + hd * 256 + lane + 64 * i]);
        WAVE_SYNC();
        float sc[4];
#pragma unroll
        for (int j = 0; j < 4; ++j) { const int m = lane + 64 * j; const uint4* kr = (const uint4*)(kv + ((size_t)b * MEMT + m) * 2048 + hd * 256); float dot = 0.f;
            for (int i = 0; i < 32; ++i) { float f[8]; unpack8(kr[i], f);
#pragma unroll
                for (int e = 0; e < 8; ++e) dot += s_q[8 * i + e] * f[e]; }
            sc[j] = dot * 0.0625f; }
        const float mx = wave_max(fmaxf(fmaxf(sc[0], sc[1]), fmaxf(sc[2], sc[3])));
        float e[4], se = 0.f;
#pragma unroll
        for (int j = 0; j < 4; ++j) { e[j] = expf(sc[j] - mx); se += e[j]; }
        const float inv = 1.f / wave_sum(se);
#pragma unroll
        for (int j = 0; j < 4; ++j) s_p[lane + 64 * j] = e[j] * inv;
        WAVE_SYNC();
        float o[4] = {0.f, 0.f, 0.f, 0.f};
        for (int m = 0; m < MEMT; ++m) { const float p = s_p[m]; const bf16* vr = kv + ((size_t)b * MEMT + m) * 2048 + 1024 + hd * 256;
#pragma unroll
            for (int i = 0; i < 4; ++i) o[i] += p * bf2f(vr[lane + 64 * i]); }
#pragma unroll
        for (int i = 0; i < 4; ++i) obuf[(size_t)tok * D + hd * 256 + lane + 64 * i] = (bf16)f2bf(o[i]);
    }
}

struct Args { const float* in[23]; float* out; unsigned char* ws; int ph_lo, ph_hi; };
static_assert(sizeof(Args) == 23 * 8 + 8 + 8 + 8, "Args has no padding");
namespace cg = cooperative_groups;

constexpr int PH_PRO = 0, PH_KV = 1, PH_L0 = 2, PH_PER_LAYER = 13, PH_END = PH_L0 + DEPTH * PH_PER_LAYER;

#define GEMM_PHASE(EPI, Aptr, Bptr, MM, NN, KK, ...) do { pg8::Gemm g{Aptr, Bptr, MM, NN, KK}; pg8::StaticOrder S; S.init(MM, NN, G, (int)blockIdx.x); \
    EPI E{__VA_ARGS__}; pg8::gemm_phase<EPI, pg8::StaticOrder, true, true>(L + RING_OFF, g, S, E, F.wave); } while (0)

__global__ void __launch_bounds__(NWAVES * 64, 2) mk_fwd(Args args) {
    extern __shared__ __attribute__((aligned(16))) unsigned char lds[];
    LAS unsigned char* L = (LAS unsigned char*)lds;
    cg::grid_group grid = cg::this_grid();
    unsigned char* ws = args.ws;
    const int G = gridDim.x;
    Frame F; F.lds = L; F.wave = __builtin_amdgcn_readfirstlane((int)threadIdx.x >> 6); F.G = G; F.gw = (int)blockIdx.x * NWAVES + F.wave; F.NGW = G * NWAVES;
    bf16* Hb = (bf16*)(ws + WS_H); bf16* PROJ = (bf16*)(ws + WS_PROJ); bf16* OBUF = (bf16*)(ws + WS_OBUF); bf16* QMEM = (bf16*)(ws + WS_QMEM); bf16* UBUF = (bf16*)(ws + WS_UBUF);
    unsigned* MASK = (unsigned*)(ws + WS_MASK); bf16* MEMB = (bf16*)(ws + WS_MEMB); bf16* KVM = (bf16*)(ws + WS_KVMEM);
    float* GLOG = args.out; float* ORAW = args.out + (size_t)8 * 1024 * 1024;
    const int lo = args.ph_lo, hi = args.ph_hi;
#define IN(k) (lo <= (k) && (k) < hi)
#define SEAM(k) do { if (IN(k) && IN((k) + 1)) grid.sync(); } while (0)
    if (IN(PH_PRO)) { ph_prologue(F, args.in, ws); __syncthreads(); }
    SEAM(PH_PRO);
    if (IN(PH_KV)) {
#pragma unroll 1
        for (int l = 0; l < DEPTH; ++l) { const bf16* Wl = (const bf16*)(ws + WS_W) + (size_t)l * LW_END;
            GEMM_PHASE(pg8::EpiBf16<0>, MEMB, Wl + LW_MKV, MKV, 2 * D, D, KVM + (size_t)l * MKV * 2 * D, 2 * D, nullptr, 0, 0, 1.f); }
    }
    SEAM(PH_KV);
#pragma unroll 1
    for (int l = 0; l < DEPTH; ++l) {
        const int p0 = PH_L0 + l * PH_PER_LAYER; const bf16* Wl = (const bf16*)(ws + WS_W) + (size_t)l * LW_END;
        if (IN(p0 + 0)) GEMM_PHASE(pg8::EpiBf16<0>, Hb, Wl + LW_IN, M, PINP, D, PROJ, PINP, nullptr, 0, 0, 1.f);
        SEAM(p0 + 0);
        if (IN(p0 + 1)) { ph_gla_gate(F, PROJ, args.in[5] + (size_t)l * 16 * 192, args.in[6] + (size_t)l * 192, GLOG);
                          ph_idx(F, PROJ, MASK); __syncthreads(); }
        SEAM(p0 + 1);
        if (IN(p0 + 2)) { ph_gla_rec(F, PROJ, GLOG, ORAW); ph_dsa_att(F, PROJ, MASK, OBUF, (unsigned*)(ws + WS_CTL) + CW_Q + 64 * (l * 4 + 0));
                          ph_sb_att(F, PROJ, OBUF, (unsigned*)(ws + WS_CTL) + CW_Q + 64 * (l * 4 + 1)); __syncthreads(); }
        SEAM(p0 + 2);
        if (IN(p0 + 3)) ph_gla_fin(F, PROJ, ORAW, args.in[7] + (size_t)l * 96, OBUF);
        SEAM(p0 + 3);
        if (IN(p0 + 4)) GEMM_PHASE(pg8::EpiY, OBUF, Wl + LW_OUT, M, D, D, args.out, Hb, D, nullptr, ALPHA);
        SEAM(p0 + 4);
        if (IN(p0 + 5)) ph_ln(F, args.out, args.in[10] + (size_t)l * D, args.in[11] + (size_t)l * D, Hb, (float*)nullptr);
        SEAM(p0 + 5);
        if (IN(p0 + 6)) GEMM_PHASE(pg8::EpiBf16<0>, Hb, Wl + LW_MQ, M, D, D, QMEM, D, nullptr, 0, 0, 1.f);
        SEAM(p0 + 6);
        if (IN(p0 + 7)) { ph_mem_att(F, QMEM, KVM + (size_t)l * MKV * 2 * D, OBUF); __syncthreads(); }
        SEAM(p0 + 7);
        if (IN(p0 + 8)) GEMM_PHASE(pg8::EpiY, OBUF, Wl + LW_MO, M, D, D, args.out, Hb, D, nullptr, ALPHA);
        SEAM(p0 + 8);
        if (IN(p0 + 9)) ph_ln(F, args.out, args.in[15] + (size_t)l * D, args.in[16] + (size_t)l * D, Hb, (float*)nullptr);
        SEAM(p0 + 9);
        if (IN(p0 + 10)) GEMM_PHASE(pg8::EpiBf16<2>, Hb, Wl + LW_UP, M, FF, D, UBUF, FF, args.in[18] + (size_t)l * FF, 0, 0, 1.f);
        SEAM(p0 + 10);
        if (IN(p0 + 11)) GEMM_PHASE(pg8::EpiY, UBUF, Wl + LW_DN, M, D, FF, args.out, Hb, D, args.in[20] + (size_t)l * D, ALPHA);
        SEAM(p0 + 11);
        if (IN(p0 + 12)) ph_ln(F, args.out, args.in[21] + (size_t)l * D, args.in[22] + (size_t)l * D, Hb, (l == DEPTH - 1) ? args.out : (float*)nullptr);
        SEAM(p0 + 12);
    }
#undef IN
#undef SEAM
}

#ifndef MK_SPLIT
#define MK_SPLIT 0
#endif
extern "C" void kernel_launch(void* const* d_in, const int* in_sizes, int n_in, void* d_out, int out_size, void* d_ws, size_t ws_size, hipStream_t stream) {
    static int grid = 0;
    if (grid == 0) {
        if (n_in != 23 || in_sizes[0] != M * D || out_size != M * D || ws_size < WS_END) { fprintf(stderr, "kernel_launch: unexpected shapes (n_in %d, in0 %d, out %d, ws %zu)\n", n_in, n_in > 0 ? in_sizes[0] : -1, out_size, ws_size); grid = -1; return; }
        int dev = 0, cus = 0, per_cu = 0;
        if (hipGetDevice(&dev) != hipSuccess || hipDeviceGetAttribute(&cus, hipDeviceAttributeMultiprocessorCount, dev) != hipSuccess) { grid = -1; return; }
        if (hipFuncSetAttribute((const void*)mk_fwd, hipFuncAttributeMaxDynamicSharedMemorySize, LDS_BYTES) != hipSuccess) { fprintf(stderr, "kernel_launch: hipFuncSetAttribute failed\n"); grid = -1; return; }
        if (hipOccupancyMaxActiveBlocksPerMultiprocessor(&per_cu, (const void*)mk_fwd, NWAVES * 64, LDS_BYTES) != hipSuccess || per_cu < 1) { fprintf(stderr, "kernel_launch: occupancy query says %d blocks per CU\n", per_cu); grid = -1; return; }
        grid = cus;
    }
    if (grid < 0) return;
    Args a{}; for (int i = 0; i < 23; ++i) a.in[i] = (const float*)d_in[i]; a.out = (float*)d_out; a.ws = (unsigned char*)d_ws;
    if (hipMemsetAsync((unsigned char*)d_ws + WS_CTL, 0, CTL_ZERO_BYTES, stream) != hipSuccess) return;
#if MK_SPLIT
    for (int p = 0; p < PH_END; ++p) { a.ph_lo = p; a.ph_hi = p + 1; hipLaunchKernelGGL(mk_fwd, dim3(grid), dim3(NWAVES * 64), LDS_BYTES, stream, a); }
#else
    a.ph_lo = 0; a.ph_hi = PH_END;
    void* kargs[] = {&a};
    const hipError_t e = hipLaunchCooperativeKernel((const void*)mk_fwd, dim3(grid), dim3(NWAVES * 64), kargs, LDS_BYTES, stream);
    if (e != hipSuccess) fprintf(stderr, "kernel_launch: cooperative launch failed: %s (grid %d)\n", hipGetErrorString(e), grid);
#endif
}
```

```cpp
#include <hip/hip_runtime.h>
#include <hip/hip_cooperative_groups.h>
#include <cstdio>
#include <cstdint>
namespace pg8 {
#define PG8_LAS __attribute__((address_space(3)))
typedef unsigned short bf16_t;
typedef short bf16x8 __attribute__((ext_vector_type(8)));
typedef float f32x4 __attribute__((ext_vector_type(4)));
typedef unsigned u32x4 __attribute__((ext_vector_type(4)));
constexpr int BM = 256, BK = 64, HALF = 128, HTB = HALF * BK * 2  , STAGE_BYTES = 8 * HTB, NXCD = 8, WGM = 8;

__host__ __device__ __forceinline__ int lds_byte(int r, int c) { const int st = (r >> 4) * 2 + (c >> 5), rr = r & 15, cc = c & 31, ob = rr * 64 + cc * 2; return st * 1024 + (ob ^ (((ob >> 9) & 1) << 5)); }
__host__ __device__ __forceinline__ void stage_rc(int b, int& R, int& C) { const int st = b / 1024, sb = b % 1024, swz = sb ^ (((sb >> 9) & 1) << 5); R = (st >> 1) * 16 + swz / 64; C = (st & 1) * 32 + (swz % 64) / 2; }
__host__ __device__ __forceinline__ int perm32(int rho) { const int n = rho >> 4, i = rho & 15; return 8 * (i >> 2) + 4 * n + (i & 3); }

struct Unit { int pm, pn; };
struct Gemm { const bf16_t* A; const bf16_t* Bt; int M, N, K; };

struct StaticOrder {
    int nM, nN, nwg, G, c;
    __host__ __device__ void init(int M, int N, int G_, int c_) { nM = M / BM; nN = N / BM; nwg = nM * nN; G = G_; c = c_; }
    __host__ __device__ bool next(int i, Unit& u) const {
        const long L = (long)i * G + c; if (L >= nwg) return false;
        int wgid = (int)L; { const int q = nwg / NXCD, r = nwg % NXCD, xcd = wgid % NXCD, off = wgid / NXCD; wgid = (xcd < r ? xcd * (q + 1) : r * (q + 1) + (xcd - r) * q) + off; }
        const int nig = WGM * nN, gid = wgid / nig, fm = gid * WGM, gsz = (nM - fm) < WGM ? (nM - fm) : WGM;
        u.pm = fm + ((wgid % nig) % gsz); u.pn = (wgid % nig) / gsz; return true;
    }
    __device__ __forceinline__ void a_ready(const Unit&) const {}
    __device__ __forceinline__ void done(const Unit&) const {}
};

__device__ __forceinline__ unsigned cvt_pk_bf16(float lo, float hi) { unsigned r; asm volatile("v_cvt_pk_bf16_f32 %0, %1, %2" : "=v"(r) : "v"(lo), "v"(hi)); return r; }
typedef float f32x2 __attribute__((ext_vector_type(2)));
template <int ACT  > struct EpiBf16 {
    static constexpr bool PERM = true, AFTER_DRAIN = false; static_assert(ACT == 0 || ACT == 2, "EpiBf16: ACT is 0 (none) or 2 (squared relu)");
    bf16_t* O; int ldc; const float* bias; int split_cols; size_t split_stride; float scale0;
    __device__ __forceinline__ void operator()(const f32x4 (&acc)[2][2][4][2], const Unit& u, int wr, int wc, int fr, int fq) const {
        const int row0 = u.pm * BM + wr * 64 + fr; int colt = u.pn * BM; bf16_t* base = O;
        float sc = 1.f; if (split_cols) { const int t = colt / split_cols; base += (size_t)t * split_stride; colt -= t * split_cols; if (t == 0) sc = scale0; }
        const int col0 = colt + wc * 32 + 8 * fq, bcol0 = u.pn * BM + wc * 32 + 8 * fq;
        f32x4 bv[2][2];
#pragma unroll
        for (int bj = 0; bj < 2; ++bj)
#pragma unroll
            for (int n = 0; n < 2; ++n) bv[bj][n] = bias ? *(const f32x4*)(bias + bcol0 + bj * HALF + 4 * n) : (f32x4){0.f, 0.f, 0.f, 0.f};
#pragma unroll
        for (int ai = 0; ai < 2; ++ai)
#pragma unroll
            for (int m = 0; m < 4; ++m) { bf16_t* rowp = base + (size_t)(row0 + ai * HALF + m * 16) * ldc + col0;
#pragma unroll
                for (int bj = 0; bj < 2; ++bj) { f32x4 v0 = acc[ai][bj][m][0] + bv[bj][0], v1 = acc[ai][bj][m][1] + bv[bj][1];
                    if (ACT == 2) { const f32x4 z4 = (f32x4){0.f, 0.f, 0.f, 0.f}; v0 = __builtin_elementwise_max(v0, z4); v1 = __builtin_elementwise_max(v1, z4); v0 = v0 * v0; v1 = v1 * v1; }
                    v0 = v0 * sc; v1 = v1 * sc; u32x4 w; w.x = cvt_pk_bf16(v0[0], v0[1]); w.y = cvt_pk_bf16(v0[2], v0[3]); w.z = cvt_pk_bf16(v1[0], v1[1]); w.w = cvt_pk_bf16(v1[2], v1[3]);
                    *(u32x4*)(rowp + bj * HALF) = w; } }
    }
};

struct EpiY {
    static constexpr bool PERM = false, AFTER_DRAIN = false;
    float* Y; const bf16_t* R; int ldc; const float* bias; float alpha;
    __device__ __forceinline__ void operator()(const f32x4 (&acc)[2][2][4][2], const Unit& u, int wr, int wc, int fr, int fq) const {
        const int row0 = u.pm * BM + wr * 64 + fr, col0 = u.pn * BM + wc * 32 + 4 * fq;
#pragma unroll
        for (int ai = 0; ai < 2; ++ai)
#pragma unroll
            for (int m = 0; m < 4; ++m) { const size_t roff = (size_t)(row0 + ai * HALF + m * 16) * ldc;
#pragma unroll
                for (int bj = 0; bj < 2; ++bj)
#pragma unroll
                    for (int n = 0; n < 2; ++n) { const int col = col0 + bj * HALF + n * 16;
                        const f32x4 bv = bias ? *(const f32x4*)(bias + col) : (f32x4){0.f, 0.f, 0.f, 0.f};
                        const uint2 rr = *(const uint2*)(R + roff + col);
                        f32x4 rv; rv[0] = __uint_as_float(rr.x << 16); rv[1] = __uint_as_float(rr.x & 0xffff0000u); rv[2] = __uint_as_float(rr.y << 16); rv[3] = __uint_as_float(rr.y & 0xffff0000u);
                        *(f32x4*)(Y + roff + col) = acc[ai][bj][m][n] + bv + rv * alpha; } }
    }
};

struct PanelStats {
    unsigned* xbuf;
    unsigned* cnt;
    unsigned* tmo;
    int ntn; float eps;
    unsigned code;
    __device__ __forceinline__ bool run(const f32x4 (&v)[2][2][4][2], const Unit& u, int wr, int wc, int fr, int fq, PG8_LAS unsigned char* lds, int wid, int lane) const {
        typedef float f32x2v __attribute__((ext_vector_type(2)));
        PG8_LAS f32x2v* P = (PG8_LAS f32x2v*)lds;
        PG8_LAS f32x2v* S = (PG8_LAS f32x2v*)(lds + 8192);
        PG8_LAS unsigned* flag = (PG8_LAS unsigned*)(lds + 8192 + 2048);
#pragma unroll
        for (int ai = 0; ai < 2; ++ai)
#pragma unroll
            for (int m = 0; m < 4; ++m) {
                float s = 0.f;
#pragma unroll
                for (int bj = 0; bj < 2; ++bj)
#pragma unroll
                    for (int n = 0; n < 2; ++n) { const f32x4 x = v[ai][bj][m][n]; s += (x[0] + x[1]) + (x[2] + x[3]); }
                s += __shfl_xor(s, 16); s += __shfl_xor(s, 32);
                const float mw = s * (1.0f / 64.0f); float q = 0.f;
#pragma unroll
                for (int bj = 0; bj < 2; ++bj)
#pragma unroll
                    for (int n = 0; n < 2; ++n) { const f32x4 d = v[ai][bj][m][n] - mw; q += (d[0] * d[0] + d[1] * d[1]) + (d[2] * d[2] + d[3] * d[3]); }
                q += __shfl_xor(q, 16); q += __shfl_xor(q, 32);
                if (fq == 0) P[(ai * HALF + wr * 64 + m * 16 + fr) * 4 + wc] = (f32x2v){mw, q};
            }
        asm volatile("s_waitcnt lgkmcnt(0)" ::: "memory"); __builtin_amdgcn_s_barrier(); asm volatile("" ::: "memory");
#if defined(BROKEN_EXCHANGE_NO_WAIT)
#warning BROKEN CONTROL BUILD: the row-statistics exchange does not wait; results are wrong by design
        if (blockIdx.x >= 64) { const long long t0_ = clock64(); while (clock64() - t0_ < 60000) __builtin_amdgcn_s_sleep(8); }
#endif
        const int row = wid * 32 + (lane & 31);
        if (lane < 32) {
            const f32x2v a = P[row * 4 + 0], b = P[row * 4 + 1], c = P[row * 4 + 2], d = P[row * 4 + 3];
            const float mt = (a.x + b.x + c.x + d.x) * 0.25f;
            const float da = a.x - mt, db = b.x - mt, dc = c.x - mt, dd = d.x - mt;
            const float m2 = (a.y + b.y) + (c.y + d.y) + 64.0f * ((da * da + db * db) + (dc * dc + dd * dd));
            unsigned long long* slot = (unsigned long long*)xbuf + ((size_t)(u.pm * BM + row) * 4 + u.pn);
            __hip_atomic_store(slot, ((unsigned long long)__float_as_uint(m2) << 32) | __float_as_uint(mt), __ATOMIC_RELAXED, __HIP_MEMORY_SCOPE_AGENT);
        }
        asm volatile("s_waitcnt vmcnt(0)" ::: "memory");
        if (lane == 0) __hip_atomic_fetch_add(cnt + 64 * u.pm, 1u, __ATOMIC_RELAXED, __HIP_MEMORY_SCOPE_AGENT);
        if (wid == 0) {
            bool dead = false; const unsigned long long t0 = __builtin_amdgcn_s_memrealtime(); const unsigned want = 8u * (unsigned)ntn;
            for (;;) {
#if defined(BROKEN_EXCHANGE_NO_WAIT)
                break;
#endif
                if ((unsigned)__builtin_amdgcn_readfirstlane(__hip_atomic_load(cnt + 64 * u.pm, __ATOMIC_RELAXED, __HIP_MEMORY_SCOPE_AGENT)) >= want) break;
                if (__builtin_amdgcn_s_memrealtime() - t0 > 2000000ull) {
                    if (lane == 0) { unsigned expect = 0u; __hip_atomic_compare_exchange_strong(tmo + 1, &expect, code | (unsigned)(u.pm & 0xff), __ATOMIC_RELAXED, __ATOMIC_RELAXED, __HIP_MEMORY_SCOPE_AGENT);
                                     __hip_atomic_store(tmo, 1u, __ATOMIC_RELAXED, __HIP_MEMORY_SCOPE_AGENT); }
                    dead = true; break; }
                __builtin_amdgcn_s_sleep(2);
            }
            __builtin_amdgcn_fence(__ATOMIC_ACQUIRE, "agent");
            if (lane == 0) flag[0] = dead ? 1u : 0u;
        }
        asm volatile("s_waitcnt vmcnt(0) lgkmcnt(0)" ::: "memory"); __builtin_amdgcn_s_barrier(); asm volatile("" ::: "memory");
        const bool bad = flag[0] != 0u;
        if (lane < 32) {
            const unsigned long long* slot = (const unsigned long long*)xbuf + (size_t)(u.pm * BM + row) * 4; float mt[4], m2[4]; float ms = 0.f;
#pragma unroll
            for (int t = 0; t < 4; ++t) { if (t < ntn) { const unsigned long long w = __hip_atomic_load(slot + t, __ATOMIC_RELAXED, __HIP_MEMORY_SCOPE_AGENT); mt[t] = __uint_as_float((unsigned)w); m2[t] = __uint_as_float((unsigned)(w >> 32)); } else { mt[t] = 0.f; m2[t] = 0.f; } ms += mt[t]; }
            const float mean = ms / (float)ntn; float q = 0.f;
#pragma unroll
            for (int t = 0; t < 4; ++t) if (t < ntn) { const float dm = mt[t] - mean; q += m2[t] + 256.0f * dm * dm; }
            S[row] = (f32x2v){mean, 1.0f / sqrtf(q / (256.0f * (float)ntn) + eps)};
        }
        asm volatile("s_waitcnt lgkmcnt(0)" ::: "memory"); __builtin_amdgcn_s_barrier(); asm volatile("" ::: "memory");
        return bad;
    }
};
struct EpiLnRes {
    static constexpr bool PERM = false, AFTER_DRAIN = true;
    const float* base; float* out; int ldc; const float* bias; PanelStats st; unsigned poison;
    __device__ __forceinline__ void fused(f32x4 (&acc)[2][2][4][2], const Unit& u, int wr, int wc, int fr, int fq, PG8_LAS unsigned char* lds, int wid, int lane) const {
        typedef float f32x2v __attribute__((ext_vector_type(2)));
        const PG8_LAS f32x2v* S = (const PG8_LAS f32x2v*)(lds + 8192);
        const int col0 = u.pn * BM + wc * 32 + 4 * fq;
#pragma unroll
        for (int bj = 0; bj < 2; ++bj)
#pragma unroll
            for (int n = 0; n < 2; ++n) { const f32x4 bv = bias ? *(const f32x4*)(bias + col0 + bj * HALF + n * 16) : (f32x4){0.f, 0.f, 0.f, 0.f};
#pragma unroll
                for (int ai = 0; ai < 2; ++ai)
#pragma unroll
                    for (int m = 0; m < 4; ++m) acc[ai][bj][m][n] += bv; }
        f32x4 pre[4][2][2];
#pragma unroll
        for (int m = 0; m < 4; ++m) { const size_t off = (size_t)(u.pm * BM + wr * 64 + m * 16 + fr) * ldc + col0;
#pragma unroll
            for (int bj = 0; bj < 2; ++bj)
#pragma unroll
                for (int n = 0; n < 2; ++n) pre[m][bj][n] = *(const f32x4*)(base + off + bj * HALF + n * 16); }
        const bool bad = st.run(acc, u, wr, wc, fr, fq, lds, wid, lane) || poison != 0u;
        const float qnan = __builtin_nanf("");
#pragma unroll
        for (int ai = 0; ai < 2; ++ai)
#pragma unroll
            for (int m = 0; m < 4; ++m) { const int r = ai * HALF + wr * 64 + m * 16 + fr; const f32x2v sr = S[r]; const size_t off = (size_t)(u.pm * BM + r) * ldc + col0;
#pragma unroll
                for (int bj = 0; bj < 2; ++bj)
#pragma unroll
                    for (int n = 0; n < 2; ++n) { const f32x4 bs = ai == 0 ? pre[m][bj][n] : *(const f32x4*)(base + off + bj * HALF + n * 16); f32x4 o = bs + (acc[ai][bj][m][n] - sr.x) * sr.y;
                        if (bad) o = (f32x4){qnan, qnan, qnan, qnan}; *(f32x4*)(out + off + bj * HALF + n * 16) = o; }
                if (m & 1) asm volatile("" ::: "memory"); }
    }
};
struct EpiLnResLn {
    static constexpr bool PERM = false, AFTER_DRAIN = true;
    const float* base; float* out; bf16_t* xn; int ldc; const float* bias; PanelStats st1, st2; unsigned poison;
    __device__ __forceinline__ void fused(f32x4 (&acc)[2][2][4][2], const Unit& u, int wr, int wc, int fr, int fq, PG8_LAS unsigned char* lds, int wid, int lane) const {
        typedef float f32x2v __attribute__((ext_vector_type(2))); typedef unsigned u32x2v __attribute__((ext_vector_type(2)));
        const PG8_LAS f32x2v* S = (const PG8_LAS f32x2v*)(lds + 8192);
        const int col0 = u.pn * BM + wc * 32 + 4 * fq;
#pragma unroll
        for (int bj = 0; bj < 2; ++bj)
#pragma unroll
            for (int n = 0; n < 2; ++n) { const f32x4 bv = bias ? *(const f32x4*)(bias + col0 + bj * HALF + n * 16) : (f32x4){0.f, 0.f, 0.f, 0.f};
#pragma unroll
                for (int ai = 0; ai < 2; ++ai)
#pragma unroll
                    for (int m = 0; m < 4; ++m) acc[ai][bj][m][n] += bv; }
        bool bad = st1.run(acc, u, wr, wc, fr, fq, lds, wid, lane) || poison != 0u;
        const float qnan = __builtin_nanf("");
#pragma unroll
        for (int ai = 0; ai < 2; ++ai)
#pragma unroll
            for (int m = 0; m < 4; ++m) { const int r = ai * HALF + wr * 64 + m * 16 + fr; const f32x2v sr = S[r]; const size_t off = (size_t)(u.pm * BM + r) * ldc + col0;
#pragma unroll
                for (int bj = 0; bj < 2; ++bj)
#pragma unroll
                    for (int n = 0; n < 2; ++n) { const f32x4 bs = *(const f32x4*)(base + off + bj * HALF + n * 16); acc[ai][bj][m][n] = bs + (acc[ai][bj][m][n] - sr.x) * sr.y; }
                asm volatile("" : "+v"(acc[ai][0][m][0]), "+v"(acc[ai][0][m][1]), "+v"(acc[ai][1][m][0]), "+v"(acc[ai][1][m][1]));
                if (m & 1) asm volatile("" ::: "memory"); }
        const bool bad1 = bad;
        bad = st2.run(acc, u, wr, wc, fr, fq, lds, wid, lane) || bad;
#pragma unroll
        for (int ai = 0; ai < 2; ++ai)
#pragma unroll
            for (int m = 0; m < 4; ++m) { const int r = ai * HALF + wr * 64 + m * 16 + fr; const f32x2v sr = S[r]; const size_t off = (size_t)(u.pm * BM + r) * ldc + col0;
#pragma unroll
                for (int bj = 0; bj < 2; ++bj)
#pragma unroll
                    for (int n = 0; n < 2; ++n) { const f32x4 x1 = acc[ai][bj][m][n]; *(f32x4*)(out + off + bj * HALF + n * 16) = bad1 ? (f32x4){qnan, qnan, qnan, qnan} : x1;
                        const f32x4 o = (x1 - sr.x) * sr.y; u32x2v w; w.x = cvt_pk_bf16(o[0], o[1]); w.y = cvt_pk_bf16(o[2], o[3]);
                        if (bad) { w.x = 0x7fc07fc0u; w.y = 0x7fc07fc0u; } *(u32x2v*)(xn + off + bj * HALF + n * 16) = w; }
                asm volatile("" ::: "memory"); }
    }
};

template <class Epi, class Sched, bool ALIGN_EPI = false, bool SP2 = false>
__device__ __forceinline__ void gemm_phase(PG8_LAS unsigned char* lds, const Gemm g, const Sched& S, const Epi& E, const int wave_id) {
    int tid_; asm volatile("v_mbcnt_lo_u32_b32 %0, -1, 0\n\tv_mbcnt_hi_u32_b32 %0, -1, %0" : "=v"(tid_)); tid_ += 64 * wave_id; asm volatile("" : "+v"(tid_));
    const int tid = tid_, wid = __builtin_amdgcn_readfirstlane(tid >> 6), lane = tid & 63, wr = wid >> 2, wc = wid & 3, fr = lane & 15, fq = lane >> 4;
    const int K = g.K, nt = K / BK;
    unsigned voffA[2], voffB[2];
#pragma unroll
    for (int i = 0; i < 2; ++i) { int R, C; stage_rc(tid * 16 + i * 8192, R, C); const int Rb = Epi::PERM ? ((R & ~31) + perm32(R & 31)) : R;
        voffA[i] = (unsigned)(R * K + C) * 2u; voffB[i] = (unsigned)(Rb * K + C) * 2u; }
    const size_t kstep = (size_t)(BK * 2);
    const size_t hstep = (size_t)HALF * K * 2;
    const size_t tstep = 2 * hstep;
    const unsigned ldsw = (unsigned)wid * 1024u;
    const int aoff = lds_byte(wr * 64 + fr, fq * 8), boff = lds_byte(wc * 32 + fr, fq * 8);
#define PG8_SA(b, h) (((b) * 2 + (h)) * HTB)
#define PG8_SB(b, h) ((4 + (b) * 2 + (h)) * HTB)
#define PG8_STAGE(bufoff, gbase, voff) do { _Pragma("unroll") for (int _i = 0; _i < 2; ++_i) \
        __builtin_amdgcn_global_load_lds((const unsigned*)((const char*)(gbase) + (voff)[_i]), (PG8_LAS unsigned*)(lds + (bufoff) + ldsw + _i * 8192), 16, 0, 0); } while (0)
#define PG8_LDA(dst, b, h) do { _Pragma("unroll") for (int m = 0; m < 4; ++m) _Pragma("unroll") for (int k = 0; k < 2; ++k) dst[m][k] = *(const PG8_LAS bf16x8*)(lds + PG8_SA(b, h) + aoff + m * 2048 + k * 1024); } while (0)
#define PG8_LDB(dst, b, h) do { _Pragma("unroll") for (int n = 0; n < 2; ++n) _Pragma("unroll") for (int k = 0; k < 2; ++k) dst[n][k] = *(const PG8_LAS bf16x8*)(lds + PG8_SB(b, h) + boff + n * 2048 + k * 1024); } while (0)
#define PG8_MMA(ai, bj, At, Bt) do { __builtin_amdgcn_s_setprio(1); _Pragma("unroll") for (int m = 0; m < 4; ++m) _Pragma("unroll") for (int n = 0; n < 2; ++n) _Pragma("unroll") for (int k = 0; k < 2; ++k) \
        acc[ai][bj][m][n] = __builtin_amdgcn_mfma_f32_16x16x32_bf16(Bt[n][k], At[m][k], acc[ai][bj][m][n], 0, 0, 0); __builtin_amdgcn_s_setprio(0); } while (0)
#define PG8_WAIT_V(n) asm volatile("s_waitcnt vmcnt(" #n ")" ::: "memory")
#define PG8_WAIT_L(n) asm volatile("s_waitcnt lgkmcnt(" #n ")" ::: "memory")
#define PG8_BAR __builtin_amdgcn_s_barrier()
#define PG8_SCHED __builtin_amdgcn_sched_barrier(0)
    Unit cur, nxt; int ui = 0;
    if (!S.next(0, cur)) return;
    f32x4 acc[2][2][4][2];
#pragma unroll
    for (int a = 0; a < 2; ++a)
#pragma unroll
        for (int b = 0; b < 2; ++b)
#pragma unroll
            for (int m = 0; m < 4; ++m)
#pragma unroll
                for (int n = 0; n < 2; ++n) acc[a][b][m][n] = (f32x4){0.f, 0.f, 0.f, 0.f};
    bf16x8 At[4][2], B0[2][2], B1[2][2];
    const char* cA = (const char*)g.A + (size_t)cur.pm * tstep; const char* cB = (const char*)g.Bt + (size_t)cur.pn * tstep;
    S.a_ready(cur);
    if constexpr (SP2) {
        PG8_STAGE(PG8_SB(0, 0), cB, voffB); PG8_STAGE(PG8_SB(0, 1), cB + hstep, voffB); PG8_STAGE(PG8_SA(0, 0), cA, voffA); PG8_STAGE(PG8_SA(0, 1), cA + hstep, voffA);
        if (wr == 1) PG8_BAR;
        PG8_WAIT_V(2); PG8_BAR;
        PG8_STAGE(PG8_SB(1, 0), cB + kstep, voffB); PG8_STAGE(PG8_SA(1, 0), cA + kstep, voffA); PG8_STAGE(PG8_SB(1, 1), cB + hstep + kstep, voffB);
        PG8_WAIT_V(6); PG8_BAR;
    } else {
        PG8_STAGE(PG8_SB(0, 0), cB, voffB); PG8_STAGE(PG8_SA(0, 0), cA, voffA); PG8_STAGE(PG8_SB(0, 1), cB + hstep, voffB); PG8_STAGE(PG8_SA(0, 1), cA + hstep, voffA);
        if (wr == 1) PG8_BAR;
        PG8_WAIT_V(4); PG8_BAR;
        PG8_STAGE(PG8_SB(1, 0), cB + kstep, voffB); PG8_STAGE(PG8_SA(1, 0), cA + kstep, voffA); PG8_STAGE(PG8_SB(1, 1), cB + hstep + kstep, voffB);
        PG8_WAIT_V(6); PG8_BAR;
    }
    for (;;) {
        const bool has_next = S.next(ui + 1, nxt);
        const char* nA = has_next ? (const char*)g.A + (size_t)nxt.pm * tstep : cA; const char* nB = has_next ? (const char*)g.Bt + (size_t)nxt.pn * tstep : cB;
        for (int t = 0; t < nt; t += 2) {
            const bool last = (t == nt - 2);
            const char* a1 = cA + (size_t)(t + 1) * kstep;
            const char* a2 = last ? nA : cA + (size_t)(t + 2) * kstep; const char* b2 = last ? nB : cB + (size_t)(t + 2) * kstep;
            const char* a3 = a2 + kstep; const char* b3 = b2 + kstep;
            if (last && has_next) S.a_ready(nxt);
            if constexpr (SP2) {
            PG8_LDB(B0, 0, 0); PG8_LDB(B1, 0, 1); PG8_SCHED; PG8_LDA(At, 0, 0); PG8_STAGE(PG8_SA(1, 1), a1 + hstep, voffA);
            PG8_WAIT_V(8); PG8_WAIT_L(0); PG8_BAR; PG8_MMA(0, 0, At, B0); PG8_MMA(0, 1, At, B1); PG8_BAR; PG8_SCHED;
            PG8_LDA(At, 0, 1); PG8_STAGE(PG8_SB(0, 0), b2, voffB); PG8_STAGE(PG8_SB(0, 1), b2 + hstep, voffB); PG8_STAGE(PG8_SA(0, 0), a2, voffA);
            PG8_WAIT_V(8); PG8_WAIT_L(0); PG8_BAR; PG8_MMA(1, 0, At, B0); PG8_MMA(1, 1, At, B1); PG8_BAR; PG8_SCHED;
            PG8_LDB(B0, 1, 0); PG8_LDB(B1, 1, 1); PG8_SCHED; PG8_LDA(At, 1, 0); PG8_STAGE(PG8_SA(0, 1), a2 + hstep, voffA);
            PG8_WAIT_V(8); PG8_WAIT_L(0); PG8_BAR; PG8_MMA(0, 0, At, B0); PG8_MMA(0, 1, At, B1); PG8_BAR; PG8_SCHED;
            PG8_LDA(At, 1, 1); PG8_STAGE(PG8_SB(1, 0), b3, voffB); PG8_STAGE(PG8_SB(1, 1), b3 + hstep, voffB); PG8_STAGE(PG8_SA(1, 0), a3, voffA);
            PG8_WAIT_V(8); PG8_WAIT_L(0); PG8_BAR; PG8_MMA(1, 0, At, B0); PG8_MMA(1, 1, At, B1); PG8_BAR; PG8_SCHED;
            } else {
            PG8_LDB(B0, 0, 0); PG8_SCHED; PG8_LDA(At, 0, 0); PG8_STAGE(PG8_SA(1, 1), a1 + hstep, voffA);
            PG8_WAIT_L(8); PG8_BAR; PG8_WAIT_L(0); PG8_MMA(0, 0, At, B0); PG8_BAR; PG8_SCHED;
            PG8_LDB(B1, 0, 1); PG8_STAGE(PG8_SB(0, 0), b2, voffB);
            PG8_BAR; PG8_WAIT_L(0); PG8_MMA(0, 1, At, B1); PG8_BAR;
            PG8_LDA(At, 0, 1); PG8_STAGE(PG8_SA(0, 0), a2, voffA);
            PG8_BAR; PG8_WAIT_L(0); PG8_MMA(1, 0, At, B0); PG8_BAR; PG8_SCHED;
            PG8_STAGE(PG8_SB(0, 1), b2 + hstep, voffB);
            PG8_WAIT_V(6); PG8_BAR; PG8_MMA(1, 1, At, B1); PG8_BAR;
            PG8_LDB(B0, 1, 0); PG8_SCHED; PG8_LDA(At, 1, 0); PG8_STAGE(PG8_SA(0, 1), a2 + hstep, voffA);
            PG8_WAIT_L(8); PG8_BAR; PG8_WAIT_L(0); PG8_MMA(0, 0, At, B0); PG8_BAR; PG8_SCHED;
            PG8_LDB(B1, 1, 1); PG8_STAGE(PG8_SB(1, 0), b3, voffB);
            PG8_BAR; PG8_WAIT_L(0); PG8_MMA(0, 1, At, B1); PG8_BAR;
            PG8_LDA(At, 1, 1); PG8_STAGE(PG8_SA(1, 0), a3, voffA);
            PG8_BAR; PG8_WAIT_L(0); PG8_MMA(1, 0, At, B0); PG8_BAR; PG8_SCHED;
            PG8_STAGE(PG8_SB(1, 1), b3 + hstep, voffB);
            PG8_WAIT_V(6); PG8_BAR; PG8_MMA(1, 1, At, B1); PG8_BAR;
            }
        }
        if constexpr (ALIGN_EPI) { if (wr == 0) PG8_BAR; }
        if constexpr (!Epi::AFTER_DRAIN) { E(acc, cur, wr, wc, fr, fq); S.done(cur); }
        if (!has_next) break;
#pragma unroll
        for (int a = 0; a < 2; ++a)
#pragma unroll
            for (int b = 0; b < 2; ++b)
#pragma unroll
                for (int m = 0; m < 4; ++m)
#pragma unroll
                    for (int n = 0; n < 2; ++n) acc[a][b][m][n] = (f32x4){0.f, 0.f, 0.f, 0.f};
        cur = nxt; cA = nA; cB = nB; ++ui;
        if constexpr (ALIGN_EPI) { if (wr == 1) PG8_BAR; }
    }
    PG8_WAIT_V(0);
    if constexpr (!ALIGN_EPI) { if (wr == 0) PG8_BAR; }
    PG8_BAR;
    if constexpr (Epi::AFTER_DRAIN) { E.fused(acc, cur, wr, wc, fr, fq, lds, wid, lane); S.done(cur); }
#undef PG8_SA
#undef PG8_SB
#undef PG8_STAGE
#undef PG8_LDA
#undef PG8_LDB
#undef PG8_MMA
#undef PG8_WAIT_V
#undef PG8_WAIT_L
#undef PG8_BAR
#undef PG8_SCHED
}
}
#define GAS __attribute__((address_space(1)))
#define LAS __attribute__((address_space(3)))
typedef unsigned short bf16;
typedef unsigned v4u __attribute__((ext_vector_type(4)));
typedef float f32x4 __attribute__((ext_vector_type(4)));
typedef short bf16x8 __attribute__((ext_vector_type(8)));
typedef GAS unsigned gu32;
typedef GAS unsigned long long gu64;
#define RLX_AGENT __ATOMIC_RELAXED, __HIP_MEMORY_SCOPE_AGENT
#define LDS_WAIT() asm volatile("s_waitcnt lgkmcnt(0)" ::: "memory")
#define VM_WAIT() asm volatile("s_waitcnt vmcnt(0)" ::: "memory")
__device__ __forceinline__ unsigned long long rt() { return __builtin_amdgcn_s_memrealtime(); }
__device__ __forceinline__ unsigned f2bf(float f) { unsigned u = __builtin_bit_cast(unsigned, f); return (u + 0x7fffu + ((u >> 16) & 1u)) >> 16; }
__device__ __forceinline__ unsigned pk2(float lo, float hi) { return f2bf(lo) | (f2bf(hi) << 16); }

#define XB_TMO      128
#define XB_XCNT(j)  (256  + 64 * (j))
#define XB_XSUB(j)  (1280 + 64 * (j))
#define XB_XGEN(j)  (2304 + 64 * (j))
#define XB_TOP      3328
#define XB_TOPGEN   3392
#define XCD_BAR_WORDS 3456
#define XB_SPIN_CAP (1u << 18)

__device__ __forceinline__ unsigned xb_ld(unsigned* p)              { return __hip_atomic_load(p, __ATOMIC_RELAXED, __HIP_MEMORY_SCOPE_AGENT); }
__device__ __forceinline__ unsigned xb_add(unsigned* p, unsigned v) { return __hip_atomic_fetch_add(p, v, __ATOMIC_RELAXED, __HIP_MEMORY_SCOPE_AGENT); }
__device__ __forceinline__ unsigned xb_xcc_id() { return (unsigned)__builtin_amdgcn_s_getreg((3 << 11) | 20) & 0xFu; }
#define XB_SPIN(cond, bar) do { unsigned _sp = 0; while (cond) { __builtin_amdgcn_s_sleep(1); \
    if ((++_sp & 255u) == 0u) { if (xb_ld(&(bar)[XB_TMO])) break; if (_sp > XB_SPIN_CAP) { atomicAdd(&(bar)[XB_TMO], 1u); break; } } } } while (0)

struct XcdBarrier {
    unsigned* bar; unsigned x;
    volatile LAS unsigned* st;
};

__device__ __forceinline__ XcdBarrier xcd_barrier_post(unsigned* bar, volatile LAS unsigned* st) {
    XcdBarrier b; b.bar = bar; b.x = xb_xcc_id(); b.st = st;
    if (threadIdx.x == 0) (void)xb_add(&bar[XB_XCNT(b.x)], 1u);
    return b;
}
__device__ __forceinline__ void xcd_barrier_complete(unsigned* bar, unsigned x, unsigned& nloc, unsigned& nx) {
    const unsigned G = gridDim.x * gridDim.y * gridDim.z;
    unsigned sum, cnt, mine, sp = 0u;
    for (;;) {
        sum = 0u; cnt = 0u; mine = 0u;
#pragma unroll
        for (unsigned j = 0; j < 16; ++j) { const unsigned c = xb_ld(&bar[XB_XCNT(j)]); sum += c; cnt += (c > 0u) ? 1u : 0u; mine = (j == x) ? c : mine; }
        if (sum == G) break;
        __builtin_amdgcn_s_sleep(1);
        if ((++sp & 255u) == 0u) { if (xb_ld(&bar[XB_TMO])) break; if (sp > XB_SPIN_CAP) { atomicAdd(&bar[XB_TMO], 1u); break; } }
    }
    nloc = mine > 0u ? mine : 1u; nx = cnt > 0u ? cnt : 1u;
}

__device__ __forceinline__ void xcd_barrier(const XcdBarrier& b) {
    asm volatile("s_waitcnt vmcnt(0)" ::: "memory");
    __syncthreads();
    if (threadIdx.x == 0) {
        unsigned* bar = b.bar;
        __builtin_amdgcn_s_waitcnt(0);
        unsigned nloc = b.st[0], nx = b.st[1];
        if (nloc == 0u) { xcd_barrier_complete(bar, b.x, nloc, nx); b.st[0] = nloc; b.st[1] = nx; }
        const unsigned old = xb_add(&bar[XB_XSUB(b.x)], 1u);
        const unsigned gen = old / nloc;
        if (old + 1u == (gen + 1u) * nloc) {
            __builtin_amdgcn_fence(__ATOMIC_RELEASE, "agent");
            asm volatile("s_waitcnt vmcnt(0)" ::: "memory");
            const unsigned og = xb_add(&bar[XB_TOP], 1u);
            const unsigned tg = og / nx;
            if (og + 1u == (tg + 1u) * nx) xb_add(&bar[XB_TOPGEN], 1u);
            else XB_SPIN(xb_ld(&bar[XB_TOPGEN]) == tg, bar);
            __builtin_amdgcn_fence(__ATOMIC_ACQUIRE, "agent");
            xb_add(&bar[XB_XGEN(b.x)], 1u);
            asm volatile("s_waitcnt vmcnt(0)" ::: "memory");
        } else {
            XB_SPIN(xb_ld(&bar[XB_XGEN(b.x)]) == gen, bar);
            __builtin_amdgcn_fence(__ATOMIC_ACQUIRE, "agent");
            asm volatile("s_waitcnt vmcnt(0)" ::: "memory");
        }
    }
    __syncthreads();
}

constexpr int D = 1024, BATCH = 16, SEQ = 2048, DEPTH = 2, M = BATCH * SEQ;
constexpr int PIN = 3224, PINP = 3584;
constexpr int C_VH = 3232;
constexpr int C_GQ = 0, C_GK = 192, C_GV = 384, C_GLR = 768, C_GG = 784, C_DQ = 1168, C_DK = 1488, C_DV = 1552, C_IQ = 1680, C_IK = 2192, C_IW = 2256, C_SQ = 2264, C_SK = 2584, C_SV = 2904;
constexpr int O_GLA = 0, O_DSA = 384, O_SB = 704;
constexpr int MEMT = 256, MKV = BATCH * MEMT, FF = 4096;
constexpr float LN_EPS = 1e-5f;
constexpr float ALPHA = 1.4142135623730951f;
constexpr float IDX_SCALE = 0.04419417382415922f;
constexpr float GLA_QSCALE = 0.14433756729740643f;
constexpr int NWAVES = 8;
constexpr int LDS_BYTES = 147456;
constexpr int RING_OFF = 0, RING_BYTES = 131072, LDSCTL_OFF = RING_BYTES, MISC_OFF = LDSCTL_OFF + 320;

constexpr size_t MiB = 1u << 20;
constexpr size_t WS_CTL = 0, CTL_ZERO_BYTES = 1 * MiB;
constexpr size_t LW_IN = 0, LW_OUT = (size_t)PINP * D, LW_MQ = LW_OUT + (size_t)D * D, LW_MKV = LW_MQ + (size_t)D * D, LW_MO = LW_MKV + 2 * (size_t)D * D,
                 LW_UP = LW_MO + (size_t)D * D, LW_DN = LW_UP + (size_t)FF * D, LW_END = LW_DN + (size_t)D * FF;
constexpr size_t WS_W = 2 * MiB;
constexpr size_t WS_MEMB = 68 * MiB;
constexpr size_t WS_KVMEM = 76 * MiB;
constexpr size_t WS_H = 108 * MiB;
constexpr size_t WS_PROJ = 172 * MiB;
constexpr size_t WS_OBUF = 396 * MiB;
constexpr size_t WS_QMEM = 172 * MiB;
constexpr size_t WS_MASK = 460 * MiB;
constexpr size_t WS_UBUF = 172 * MiB;
constexpr size_t WS_END = 468 * MiB;
static_assert(WS_W + 2 * LW_END * 2 <= WS_MEMB && WS_UBUF + (size_t)M * FF * 2 <= WS_OBUF + 64 * MiB && WS_PROJ + (size_t)M * PINP * 2 <= WS_OBUF, "ws map");
constexpr int CW_BAR = 4096;


__device__ __forceinline__ float bf2f(bf16 v) { return __uint_as_float((unsigned)v << 16); }
__device__ __forceinline__ float wave_sum(float v) {
#pragma unroll
    for (int o = 1; o < 64; o <<= 1) v += __shfl_xor(v, o);
    return v;
}
__device__ __forceinline__ float wave_max(float v) {
#pragma unroll
    for (int o = 1; o < 64; o <<= 1) v = fmaxf(v, __shfl_xor(v, o));
    return v;
}
__device__ __forceinline__ int wave_sum_i(int v) {
#pragma unroll
    for (int o = 1; o < 64; o <<= 1) v += __shfl_xor(v, o);
    return v;
}
__device__ __forceinline__ void unpack8(const uint4 u, float (&f)[8]) {
    f[0] = __uint_as_float(u.x << 16); f[1] = __uint_as_float(u.x & 0xffff0000u); f[2] = __uint_as_float(u.y << 16); f[3] = __uint_as_float(u.y & 0xffff0000u);
    f[4] = __uint_as_float(u.z << 16); f[5] = __uint_as_float(u.z & 0xffff0000u); f[6] = __uint_as_float(u.w << 16); f[7] = __uint_as_float(u.w & 0xffff0000u);
}


struct Frame { LAS unsigned char* lds; int wave, gw, NGW, G; };
__device__ __forceinline__ int lane_id_asm() { int l; asm volatile("v_mbcnt_lo_u32_b32 %0, -1, 0\n\tv_mbcnt_hi_u32_b32 %0, -1, %0" : "=v"(l)); return l; }
#define LANE_ID() lane_id_asm()
#define WAVE_SYNC() asm volatile("s_waitcnt lgkmcnt(0)" ::: "memory")
constexpr int CW_Q = 1024;

typedef float f32x16 __attribute__((ext_vector_type(16)));
typedef short s16x4 __attribute__((ext_vector_type(4)));
typedef float f32x2_t __attribute__((ext_vector_type(2)));
typedef __bf16 bf16x2_t __attribute__((ext_vector_type(2)));
__device__ __forceinline__ unsigned cvtpk(float lo, float hi) { f32x2_t v = {lo, hi}; bf16x2_t b = __builtin_convertvector(v, bf16x2_t); return __builtin_bit_cast(unsigned, b); }
__device__ __forceinline__ bf16x8 pack8(const f32x16& p, int s8) {
    v4u w; w.x = cvtpk(p[s8 + 0], p[s8 + 1]); w.y = cvtpk(p[s8 + 2], p[s8 + 3]); w.z = cvtpk(p[s8 + 4], p[s8 + 5]); w.w = cvtpk(p[s8 + 6], p[s8 + 7]);
    return __builtin_bit_cast(bf16x8, w);
}
typedef short v4i16_t __attribute__((ext_vector_type(4)));
__device__ __forceinline__ s16x4 tr_read(LAS const unsigned char* p) { return __builtin_bit_cast(s16x4, __builtin_amdgcn_ds_read_tr16_b64_v4i16((LAS v4i16_t*)p)); }
__device__ __forceinline__ float xhalf(float v) { return __shfl_xor(v, 32); }
#define CROW(reg) (((reg) & 3) + 8 * ((reg) >> 2))
constexpr float LOG2E = 1.4426950408889634f;

constexpr int ISC_RS = 2056;
__device__ __forceinline__ void ph_idx(const Frame& F, const bf16* __restrict__ proj, unsigned* __restrict__ maskbuf) {
    int lane = LANE_ID(); asm volatile("" : "+v"(lane));
    const int r = lane & 31, h = lane >> 5, wave = F.wave;
    LAS unsigned short* isc_lds = (LAS unsigned short*)F.lds;
    for (int it = (int)blockIdx.x; it < BATCH * 64; it += F.G) {
        const int rnd = it >> 8, w = it & 255, b = w >> 4, s = w & 15;
        const int qb = (rnd == 0) ? s : (rnd == 1) ? 31 - s : (rnd == 2) ? 32 + s : 63 - s;
        const int q0 = qb * 32; const size_t tok0 = (size_t)b * SEQ + q0;
        if (qb < 8) {
#pragma unroll
            for (int qq = 0; qq < 4; ++qq) { const int t = q0 + 4 * wave + qq; int nv = t + 1 - 32 * lane; nv = nv < 0 ? 0 : (nv > 32 ? 32 : nv);
                maskbuf[(tok0 + 4 * wave + qq) * 64 + lane] = (nv == 32) ? 0xffffffffu : ((1u << nv) - 1u); }
            continue;
        }
        {
            const bf16* qrow = proj + (tok0 + r) * PINP;
            typedef unsigned u32x2v __attribute__((ext_vector_type(2)));
            for (int kb = wave; kb <= qb; kb += 2 * NWAVES) {
                const bool v2 = (kb + NWAVES) <= qb; const int kb2 = v2 ? kb + NWAVES : kb;
                const bf16* krowA = proj + ((size_t)b * SEQ + kb * 32 + r) * PINP + C_IK + h * 8;
                const bf16* krowB = proj + ((size_t)b * SEQ + kb2 * 32 + r) * PINP + C_IK + h * 8;
                bf16x8 kfA[4], kfB[4];
#pragma unroll
                for (int ks = 0; ks < 4; ++ks) { kfA[ks] = *(const bf16x8*)(krowA + ks * 16); kfB[ks] = *(const bf16x8*)(krowB + ks * 16); }
                f32x16 iscA, iscB;
#pragma unroll
                for (int i = 0; i < 16; ++i) { iscA[i] = 0.f; iscB[i] = 0.f; }
                bf16x8 qn[4]; float iwn;
#pragma unroll
                for (int ks = 0; ks < 4; ++ks) qn[ks] = *(const bf16x8*)(qrow + C_IQ + ks * 16 + h * 8);
                iwn = bf2f(qrow[C_IW]) * IDX_SCALE;
#pragma unroll 1
                for (int hd = 0; hd < 8; ++hd) {
                    bf16x8 qc[4]; const float iwc = iwn;
#pragma unroll
                    for (int ks = 0; ks < 4; ++ks) qc[ks] = qn[ks];
                    const int hn = (hd + 1) & 7;
#pragma unroll
                    for (int ks = 0; ks < 4; ++ks) qn[ks] = *(const bf16x8*)(qrow + C_IQ + hn * 64 + ks * 16 + h * 8);
                    iwn = bf2f(qrow[C_IW + hn]) * IDX_SCALE;
                    f32x16 accA, accB;
#pragma unroll
                    for (int i = 0; i < 16; ++i) { accA[i] = 0.f; accB[i] = 0.f; }
#pragma unroll
                    for (int ks = 0; ks < 4; ++ks) { accA = __builtin_amdgcn_mfma_f32_32x32x16_bf16(kfA[ks], qc[ks], accA, 0, 0, 0); accB = __builtin_amdgcn_mfma_f32_32x32x16_bf16(kfB[ks], qc[ks], accB, 0, 0, 0); }
#pragma unroll
                    for (int i = 0; i < 16; ++i) { iscA[i] += fmaxf(accA[i], 0.f) * iwc; iscB[i] += fmaxf(accB[i], 0.f) * iwc; }
                }
#pragma unroll
                for (int g = 0; g < 4; ++g) { unsigned kk[4];
#pragma unroll
                    for (int i = 0; i < 4; ++i) { const unsigned u = (unsigned)__builtin_bit_cast(unsigned short, (_Float16)iscA[4 * g + i]); kk[i] = (u & 0x8000u) ? (~u & 0xffffu) : (u | 0x8000u); }
                    u32x2v o; o.x = kk[0] | (kk[1] << 16); o.y = kk[2] | (kk[3] << 16);
                    *(LAS u32x2v*)(isc_lds + r * ISC_RS + kb * 32 + 8 * g + 4 * h) = o; }
                if (v2) {
#pragma unroll
                    for (int g = 0; g < 4; ++g) { unsigned kk[4];
#pragma unroll
                        for (int i = 0; i < 4; ++i) { const unsigned u = (unsigned)__builtin_bit_cast(unsigned short, (_Float16)iscB[4 * g + i]); kk[i] = (u & 0x8000u) ? (~u & 0xffffu) : (u | 0x8000u); }
                        u32x2v o; o.x = kk[0] | (kk[1] << 16); o.y = kk[2] | (kk[3] << 16);
                        *(LAS u32x2v*)(isc_lds + r * ISC_RS + kb2 * 32 + 8 * g + 4 * h) = o; }
                }
            }
        }
        __syncthreads();
#pragma unroll 1
        for (int qq = 0; qq < 4; ++qq) {
            const int rq = 4 * wave + qq, t = q0 + rq;
            int nv = t + 1 - 32 * lane; nv = nv < 0 ? 0 : (nv > 32 ? 32 : nv);
            unsigned key[32];
            { const LAS v4u* src = (const LAS v4u*)(isc_lds + rq * ISC_RS + 32 * lane);
#pragma unroll
              for (int c = 0; c < 4; ++c) { const v4u v = src[c];
                  key[8 * c + 0] = v.x & 0xffffu; key[8 * c + 1] = v.x >> 16; key[8 * c + 2] = v.y & 0xffffu; key[8 * c + 3] = v.y >> 16;
                  key[8 * c + 4] = v.z & 0xffffu; key[8 * c + 5] = v.z >> 16; key[8 * c + 6] = v.w & 0xffffu; key[8 * c + 7] = v.w >> 16; } }
#pragma unroll
            for (int j = 0; j < 32; ++j) key[j] = (j < nv) ? key[j] : 0u;
            unsigned prefix = 0u;
#pragma unroll 1
            for (int bit = 15; bit >= 0; --bit) {
                const unsigned cand = prefix | (1u << bit); int c = 0;
#pragma unroll
                for (int j = 0; j < 32; ++j) c += (key[j] >= cand) ? 1 : 0;
                c = wave_sum_i(c);
                if (c >= 256) prefix = cand;
            }
            int cg = 0, ce = 0;
#pragma unroll
            for (int j = 0; j < 32; ++j) { cg += (key[j] > prefix) ? 1 : 0; ce += (key[j] == prefix) ? 1 : 0; }
            const int need = 256 - wave_sum_i(cg);
            int excl = ce;
#pragma unroll
            for (int off = 1; off < 64; off <<= 1) { const int y = __shfl_up(excl, off); if (lane >= off) excl += y; }
            excl -= ce;
            unsigned word = 0u; int run = excl;
#pragma unroll
            for (int j = 0; j < 32; ++j) { const bool gt = key[j] > prefix, eq = key[j] == prefix; const bool sel = gt || (eq && run < need); run += eq ? 1 : 0; word |= sel ? (1u << j) : 0u; }
            maskbuf[(tok0 + rq) * 64 + lane] = word;
        }
        __syncthreads();
    }
}

constexpr int VT_RS = 144;
__device__ __forceinline__ void pv_block(f32x16& o0, f32x16& o1, LAS const unsigned char* vt, const bf16x8 pb0, const bf16x8 pb1, int lane) {
    const int h = lane >> 5;
    LAS const unsigned char* base = vt + (4 * h + ((lane & 15) >> 2)) * VT_RS + (16 * ((lane >> 4) & 1) + 4 * (lane & 3)) * 2;
#pragma unroll
    for (int db = 0; db < 2; ++db) {
#pragma unroll
        for (int s = 0; s < 2; ++s) {
            const s16x4 lo = tr_read(base + (16 * s) * VT_RS + db * 64), hi = tr_read(base + (16 * s + 8) * VT_RS + db * 64);
            const bf16x8 vf = (bf16x8){lo[0], lo[1], lo[2], lo[3], hi[0], hi[1], hi[2], hi[3]};
            if (db == 0) o0 = __builtin_amdgcn_mfma_f32_32x32x16_bf16(vf, s == 0 ? pb0 : pb1, o0, 0, 0, 0);
            else         o1 = __builtin_amdgcn_mfma_f32_32x32x16_bf16(vf, s == 0 ? pb0 : pb1, o1, 0, 0, 0);
        }
    }
}
__device__ __forceinline__ void store_ot(bf16* dst, const f32x16& o0, const f32x16& o1, float sc, int h) {
#pragma unroll
    for (int g = 0; g < 4; ++g) {
        uint2 a; a.x = cvtpk(o0[4 * g] * sc, o0[4 * g + 1] * sc); a.y = cvtpk(o0[4 * g + 2] * sc, o0[4 * g + 3] * sc); *(uint2*)(dst + 8 * g + 4 * h) = a;
        uint2 c; c.x = cvtpk(o1[4 * g] * sc, o1[4 * g + 1] * sc); c.y = cvtpk(o1[4 * g + 2] * sc, o1[4 * g + 3] * sc); *(uint2*)(dst + 32 + 8 * g + 4 * h) = c;
    }
}
__device__ __forceinline__ void dsa_att_item(const bf16* __restrict__ proj, const unsigned* __restrict__ maskbuf, bf16* __restrict__ obuf, int b, int qb, int hd, LAS unsigned char* wl, int lane) {
    const int r = lane & 31, h = lane >> 5;
    const size_t tok0 = (size_t)b * SEQ + qb * 32; const int t = qb * 32 + r;
    const float slope[5] = {0.32987697769322355f, 0.1088188204120155f, 0.03589682359365735f, 0.011841535675862483f, 0.00390625f};
    const float c1 = 0.125f * LOG2E, c2 = slope[hd] * LOG2E;
    bf16x8 qf[4];
#pragma unroll
    for (int ks = 0; ks < 4; ++ks) qf[ks] = *(const bf16x8*)(proj + (tok0 + r) * PINP + C_DQ + hd * 64 + ks * 16 + h * 8);
    f32x16 o0, o1;
#pragma unroll
    for (int i = 0; i < 16; ++i) { o0[i] = 0.f; o1[i] = 0.f; }
    float m = -1e30f, l = 0.f;
    const unsigned* mrow = maskbuf + (tok0 + r) * 64;
    for (int kb = 0; kb <= qb; ++kb) {
        const int key0 = kb * 32;
        const bf16* kbase = proj + ((size_t)b * SEQ + key0) * PINP;
        v4u vst[4];
#pragma unroll
        for (int i = 0; i < 4; ++i) vst[i] = *(const v4u*)(kbase + (size_t)((lane >> 3) + 8 * i) * PINP + C_VH + hd * 64 + (lane & 7) * 8);
        bf16x8 kf[4];
#pragma unroll
        for (int ks = 0; ks < 4; ++ks) kf[ks] = *(const bf16x8*)(kbase + (size_t)r * PINP + C_DK + ks * 16 + h * 8);
        const unsigned word = mrow[kb] >> (4 * h);
        f32x16 S;
#pragma unroll
        for (int i = 0; i < 16; ++i) S[i] = 0.f;
#pragma unroll
        for (int ks = 0; ks < 4; ++ks) S = __builtin_amdgcn_mfma_f32_32x32x16_bf16(kf[ks], qf[ks], S, 0, 0, 0);
        asm volatile("" ::: "memory");
#pragma unroll
        for (int i = 0; i < 4; ++i) *(LAS v4u*)(wl + ((lane >> 3) + 8 * i) * VT_RS + (lane & 7) * 16) = vst[i];
        asm volatile("" ::: "memory");
        const float dist0 = (float)(t - key0 - 4 * h);
        float mx = -INFINITY;
#pragma unroll
        for (int i = 0; i < 16; ++i) { const bool sel = (word >> CROW(i)) & 1u; S[i] = sel ? (S[i] * c1 - c2 * (dist0 - (float)CROW(i))) : -INFINITY; mx = fmaxf(mx, S[i]); }
        mx = fmaxf(mx, xhalf(mx));
        const float mn = fmaxf(m, mx), alpha = __builtin_amdgcn_exp2f(m - mn);
        float ls = 0.f;
#pragma unroll
        for (int i = 0; i < 16; ++i) { S[i] = __builtin_amdgcn_exp2f(S[i] - mn); ls += S[i]; }
        ls += xhalf(ls);
        l = l * alpha + ls; m = mn;
#pragma unroll
        for (int i = 0; i < 16; ++i) { o0[i] *= alpha; o1[i] *= alpha; }
        const bf16x8 pb0 = pack8(S, 0), pb1 = pack8(S, 8);
        pv_block(o0, o1, wl, pb0, pb1, lane);
        asm volatile("" ::: "memory");
    }
    store_ot(obuf + (tok0 + r) * D + O_DSA + hd * 64, o0, o1, 1.f / l, h);
}
__device__ __forceinline__ void ph_dsa_att(const Frame& F, const bf16* __restrict__ proj, const unsigned* __restrict__ maskbuf, bf16* __restrict__ obuf, unsigned* counter) {
    int lane = LANE_ID(); asm volatile("" : "+v"(lane));
    LAS unsigned char* wl = F.lds + F.wave * 16384;
    for (;;) {
        unsigned it = 0; if (lane == 0) it = atomicAdd(counter, 1u);
        it = (unsigned)__builtin_amdgcn_readfirstlane((int)it);
        if (it >= (unsigned)(BATCH * 64 * 5)) break;
        const int qb = 63 - (int)(it / 80u), rem = (int)(it % 80u);
        dsa_att_item(proj, maskbuf, obuf, rem / 5, qb, rem % 5, wl, lane);
    }
}
__device__ __forceinline__ void fold_vh_item(const float* __restrict__ w_in, const float* __restrict__ wuv, bf16* __restrict__ Wt, int item, int lane) {
    const int hd = item / (D / 8), k0 = (item % (D / 8)) * 8;
    float acc[8];
#pragma unroll
    for (int i = 0; i < 8; ++i) acc[i] = 0.f;
    for (int c = 0; c < 128; ++c) { const float u = wuv[((size_t)hd * 128 + c) * 64 + lane];
#pragma unroll
        for (int i = 0; i < 8; ++i) acc[i] += u * w_in[(size_t)(k0 + i) * PIN + C_DV + c]; }
    v4u o; o.x = pk2(acc[0], acc[1]); o.y = pk2(acc[2], acc[3]); o.z = pk2(acc[4], acc[5]); o.w = pk2(acc[6], acc[7]);
    *(v4u*)(Wt + (size_t)(C_VH + hd * 64 + lane) * D + k0) = o;
}

__device__ __forceinline__ void sb_att_item(const bf16* __restrict__ proj, bf16* __restrict__ obuf, int b, int qb, int hd, LAS unsigned char* wl, int lane) {
    const int r = lane & 31, h = lane >> 5;
    const size_t tok0 = (size_t)b * SEQ + qb * 32; const int t = qb * 32 + r;
    const float c1 = 0.125f * LOG2E;
    bf16x8 qf[4];
#pragma unroll
    for (int ks = 0; ks < 4; ++ks) qf[ks] = *(const bf16x8*)(proj + (tok0 + r) * PINP + C_SQ + hd * 64 + ks * 16 + h * 8);
    f32x16 o0, o1;
#pragma unroll
    for (int i = 0; i < 16; ++i) { o0[i] = 0.f; o1[i] = 0.f; }
    float carry = 0.f;
    for (int kb = qb; kb >= 0; --kb) {
        const int key0 = kb * 32;
        const bf16* kbase = proj + ((size_t)b * SEQ + key0) * PINP;
        v4u vst[4];
#pragma unroll
        for (int i = 0; i < 4; ++i) vst[i] = *(const v4u*)(kbase + (size_t)((lane >> 3) + 8 * i) * PINP + C_SV + hd * 64 + (lane & 7) * 8);
        bf16x8 kf[4];
#pragma unroll
        for (int ks = 0; ks < 4; ++ks) kf[ks] = *(const bf16x8*)(kbase + (size_t)r * PINP + C_SK + hd * 64 + ks * 16 + h * 8);
        f32x16 S;
#pragma unroll
        for (int i = 0; i < 16; ++i) S[i] = 0.f;
#pragma unroll
        for (int ks = 0; ks < 4; ++ks) S = __builtin_amdgcn_mfma_f32_32x32x16_bf16(kf[ks], qf[ks], S, 0, 0, 0);
        asm volatile("" ::: "memory");
#pragma unroll
        for (int i = 0; i < 4; ++i) *(LAS v4u*)(wl + ((lane >> 3) + 8 * i) * VT_RS + (lane & 7) * 16) = vst[i];
        asm volatile("" ::: "memory");
        const int lim = t - key0 - 4 * h;
        f32x16 lg;
#pragma unroll
        for (int i = 0; i < 16; ++i) { const float z2 = S[i] * c1; const float sp2 = fmaxf(z2, 0.f) + __builtin_amdgcn_logf(1.f + __builtin_amdgcn_exp2f(-fabsf(z2)));
            const bool strict = CROW(i) < lim; lg[i] = strict ? -sp2 : 0.f; S[i] = strict ? (z2 - sp2) : -INFINITY; }
        float To[4], Tp[4];
#pragma unroll
        for (int g = 0; g < 4; ++g) { To[g] = (lg[4 * g] + lg[4 * g + 1]) + (lg[4 * g + 2] + lg[4 * g + 3]); Tp[g] = xhalf(To[g]); }
        float R[4]; R[3] = 0.f; R[2] = To[3] + Tp[3]; R[1] = R[2] + (To[2] + Tp[2]); R[0] = R[1] + (To[1] + Tp[1]);
        const float total = R[0] + (To[0] + Tp[0]);
#pragma unroll
        for (int g = 0; g < 4; ++g) { float suf = R[g] + ((h == 0) ? Tp[g] : 0.f) + carry;
#pragma unroll
            for (int i = 3; i >= 0; --i) { const float e = S[4 * g + i] + suf; suf += lg[4 * g + i]; S[4 * g + i] = __builtin_amdgcn_exp2f(e); } }
        carry += total;
        const bf16x8 pb0 = pack8(S, 0), pb1 = pack8(S, 8);
        pv_block(o0, o1, wl, pb0, pb1, lane);
        asm volatile("" ::: "memory");
        if (__all(carry < -150.f)) break;
    }
    store_ot(obuf + (tok0 + r) * D + O_SB + hd * 64, o0, o1, 1.f, h);
}
__device__ __forceinline__ void ph_sb_att(const Frame& F, const bf16* __restrict__ proj, bf16* __restrict__ obuf, unsigned* counter) {
    int lane = LANE_ID(); asm volatile("" : "+v"(lane));
    LAS unsigned char* wl = F.lds + F.wave * 16384;
    for (;;) {
        unsigned it = 0; if (lane == 0) it = atomicAdd(counter, 1u);
        it = (unsigned)__builtin_amdgcn_readfirstlane((int)it);
        if (it >= (unsigned)(BATCH * 64 * 5)) break;
        const int qb = 63 - (int)(it / 80u), rem = (int)(it % 80u);
        sb_att_item(proj, obuf, rem / 5, qb, rem % 5, wl, lane);
    }
}

constexpr int MV_RS = 272;
__device__ __forceinline__ void mem_att_item(const bf16* __restrict__ qmem, const bf16* __restrict__ kv, bf16* __restrict__ obuf, int b, int hd, int qb, int dh, LAS unsigned char* wl, int lane) {
    const int r = lane & 31, h = lane >> 5;
    const size_t tok0 = (size_t)b * SEQ + qb * 32;
    const float c1 = 0.0625f * LOG2E;
    bf16x8 qf[16];
#pragma unroll
    for (int ks = 0; ks < 16; ++ks) qf[ks] = *(const bf16x8*)(qmem + (tok0 + r) * D + hd * 256 + ks * 16 + h * 8);
    f32x16 o[4];
#pragma unroll
    for (int d = 0; d < 4; ++d)
#pragma unroll
        for (int i = 0; i < 16; ++i) o[d][i] = 0.f;
    float m = -1e30f, l = 0.f;
    const bf16* kvb = kv + (size_t)b * MEMT * 2048;
#pragma unroll 1
    for (int kb = 0; kb < MEMT / 32; ++kb) {
        const bf16* krow = kvb + (size_t)(kb * 32 + r) * 2048 + hd * 256 + h * 8;
        v4u vst[8];
#pragma unroll
        for (int i = 0; i < 8; ++i) vst[i] = *(const v4u*)(kvb + (size_t)(kb * 32 + (lane >> 4) + 4 * i) * 2048 + 1024 + hd * 256 + dh * 128 + (lane & 15) * 8);
        f32x16 S;
#pragma unroll
        for (int i = 0; i < 16; ++i) S[i] = 0.f;
#pragma unroll
        for (int ks = 0; ks < 16; ++ks) { const bf16x8 kf = *(const bf16x8*)(krow + ks * 16); S = __builtin_amdgcn_mfma_f32_32x32x16_bf16(kf, qf[ks], S, 0, 0, 0); }
        asm volatile("" ::: "memory");
#pragma unroll
        for (int i = 0; i < 8; ++i) *(LAS v4u*)(wl + ((lane >> 4) + 4 * i) * MV_RS + (lane & 15) * 16) = vst[i];
        asm volatile("" ::: "memory");
        float mx = -INFINITY;
#pragma unroll
        for (int i = 0; i < 16; ++i) { S[i] *= c1; mx = fmaxf(mx, S[i]); }
        mx = fmaxf(mx, xhalf(mx));
        const float mn = fmaxf(m, mx), alpha = __builtin_amdgcn_exp2f(m - mn);
        float ls = 0.f;
#pragma unroll
        for (int i = 0; i < 16; ++i) { S[i] = __builtin_amdgcn_exp2f(S[i] - mn); ls += S[i]; }
        ls += xhalf(ls);
        l = l * alpha + ls; m = mn;
#pragma unroll
        for (int d = 0; d < 4; ++d)
#pragma unroll
            for (int i = 0; i < 16; ++i) o[d][i] *= alpha;
        const bf16x8 pb0 = pack8(S, 0), pb1 = pack8(S, 8);
        LAS const unsigned char* base = wl + (4 * h + ((lane & 15) >> 2)) * MV_RS + (16 * ((lane >> 4) & 1) + 4 * (lane & 3)) * 2;
#pragma unroll
        for (int d = 0; d < 4; ++d) {
#pragma unroll
            for (int s = 0; s < 2; ++s) {
                const s16x4 lo = tr_read(base + (16 * s) * MV_RS + d * 64), hi = tr_read(base + (16 * s + 8) * MV_RS + d * 64);
                const bf16x8 vf = (bf16x8){lo[0], lo[1], lo[2], lo[3], hi[0], hi[1], hi[2], hi[3]};
                o[d] = __builtin_amdgcn_mfma_f32_32x32x16_bf16(vf, s == 0 ? pb0 : pb1, o[d], 0, 0, 0);
            }
        }
        asm volatile("" ::: "memory");
    }
    const float inv = 1.f / l;
    bf16* dst = obuf + (tok0 + r) * D + hd * 256 + dh * 128;
#pragma unroll
    for (int d = 0; d < 4; ++d)
#pragma unroll
        for (int g = 0; g < 4; ++g) { uint2 a; a.x = cvtpk(o[d][4 * g] * inv, o[d][4 * g + 1] * inv); a.y = cvtpk(o[d][4 * g + 2] * inv, o[d][4 * g + 3] * inv); *(uint2*)(dst + 32 * d + 8 * g + 4 * h) = a; }
}
__device__ __forceinline__ void ph_mem_att(const Frame& F, const bf16* __restrict__ qmem, const bf16* __restrict__ kv, bf16* __restrict__ obuf) {
    int lane = LANE_ID(); asm volatile("" : "+v"(lane));
    LAS unsigned char* wl = F.lds + F.wave * 16384;
    for (int it = F.gw; it < BATCH * 4 * 64 * 2; it += F.NGW) {
        const int dh = it & 1, qb = (it >> 1) & 63, hd = (it >> 7) & 3, b = it >> 9;
        mem_att_item(qmem, kv, obuf, b, hd, qb, dh, wl, lane);
    }
}

constexpr int KE_RS = 144, VB_RS = 80;
constexpr int GLA_KE_OFF = 0, GLA_VB_OFF = 64 * KE_RS;
constexpr size_t GLA_DS_OFF = 0, GLA_SP_OFF = (size_t)40 << 20, GLA_DEC_OFF = (size_t)64 << 20;
__device__ __forceinline__ float scan32(float x, int r) {
#pragma unroll
    for (int off = 1; off < 32; off <<= 1) { const float y = __shfl_up(x, off, 32); if (r >= off) x += y; }
    return x;
}
__device__ __forceinline__ void unpack8s(const bf16x8 v, float (&f)[8]) {
    const v4u u = __builtin_bit_cast(v4u, v);
    f[0] = __uint_as_float(u.x << 16); f[1] = __uint_as_float(u.x & 0xffff0000u); f[2] = __uint_as_float(u.y << 16); f[3] = __uint_as_float(u.y & 0xffff0000u);
    f[4] = __uint_as_float(u.z << 16); f[5] = __uint_as_float(u.z & 0xffff0000u); f[6] = __uint_as_float(u.w << 16); f[7] = __uint_as_float(u.w & 0xffff0000u);
}
__device__ __forceinline__ bf16x8 pack8f(const float (&f)[8]) { v4u w; w.x = cvtpk(f[0], f[1]); w.y = cvtpk(f[2], f[3]); w.z = cvtpk(f[4], f[5]); w.w = cvtpk(f[6], f[7]); return __builtin_bit_cast(bf16x8, w); }
__device__ __forceinline__ void gla_bcum(const bf16* __restrict__ proj, const float* __restrict__ w2, const float* __restrict__ gb, size_t tok0, int hh, int lane, float (&bc)[2][3][8], float (&bl)[3][8]) {
    const int r = lane & 31, h = lane >> 5;
    float acc0[3][8], acc1[3][8];
#pragma unroll
    for (int ks = 0; ks < 3; ++ks) { const int col = hh * 48 + 16 * ks + 8 * h;
        const float4 b0 = *(const float4*)(gb + col), b1 = *(const float4*)(gb + col + 4);
        acc0[ks][0] = b0.x; acc0[ks][1] = b0.y; acc0[ks][2] = b0.z; acc0[ks][3] = b0.w; acc0[ks][4] = b1.x; acc0[ks][5] = b1.y; acc0[ks][6] = b1.z; acc0[ks][7] = b1.w;
#pragma unroll
        for (int j = 0; j < 8; ++j) acc1[ks][j] = acc0[ks][j]; }
    const bf16* pu = proj + tok0 * PINP;
    const int g0o = r * PINP + C_GLR, g1o = (32 + r) * PINP + C_GLR;
#pragma unroll 2
    for (int rr = 0; rr < 16; ++rr) {
        const float g0 = bf2f(pu[g0o + rr]), g1 = bf2f(pu[g1o + rr]);
#pragma unroll
        for (int ks = 0; ks < 3; ++ks) { const int col = hh * 48 + 16 * ks + 8 * h;
            const float4 w0 = *(const float4*)(w2 + rr * 192 + col), w1 = *(const float4*)(w2 + rr * 192 + col + 4);
            const float w[8] = {w0.x, w0.y, w0.z, w0.w, w1.x, w1.y, w1.z, w1.w};
#pragma unroll
            for (int j = 0; j < 8; ++j) { acc0[ks][j] += g0 * w[j]; acc1[ks][j] += g1 * w[j]; } }
    }
#pragma unroll
    for (int ks = 0; ks < 3; ++ks) {
#pragma unroll
        for (int j = 0; j < 8; ++j) {
            const float la0 = (fminf(acc0[ks][j], 0.f) - __logf(1.f + __expf(-fabsf(acc0[ks][j])))) * 0.0625f, la1 = (fminf(acc1[ks][j], 0.f) - __logf(1.f + __expf(-fabsf(acc1[ks][j])))) * 0.0625f;
            const float x0 = scan32(la0, r); const float t0 = __shfl(x0, 31, 32);
            const float x1 = scan32(la1, r) + t0;
            bc[0][ks][j] = x0; bc[1][ks][j] = x1; bl[ks][j] = __shfl(x1, 31, 32); }
    }
}
__device__ __forceinline__ void gla_stage_v(const bf16* __restrict__ proj, size_t tok0, int hh, int vb, LAS unsigned char* vt, int lane) {
    v4u t[4];
    const bf16* pu = proj + tok0 * PINP + C_GV + hh * 96 + vb * 32; const int lo = (lane >> 2) * PINP + (lane & 3) * 8;
#pragma unroll
    for (int i = 0; i < 4; ++i) t[i] = *(const v4u*)(pu + (lo + 16 * i * PINP));
    asm volatile("" ::: "memory");
#pragma unroll
    for (int i = 0; i < 4; ++i) *(LAS v4u*)(vt + ((lane >> 2) + 16 * i) * VB_RS + (lane & 3) * 16) = t[i];
    asm volatile("" ::: "memory");
}
__device__ __forceinline__ void gla_a_item(const bf16* __restrict__ proj, const float* __restrict__ w2, const float* __restrict__ gb, unsigned char* scratch, int item, LAS unsigned char* wl, int lane) {
    const int r = lane & 31, h = lane >> 5;
    const int hh = item & 3, bn = item >> 2; const size_t tok0 = (size_t)bn * 64;
    float bc[2][3][8], bl[3][8];
    gla_bcum(proj, w2, gb, tok0, hh, lane, bc, bl);
    LAS unsigned char* ke = wl + GLA_KE_OFF; LAS unsigned char* vt = wl + GLA_VB_OFF;
#pragma unroll
    for (int tb = 0; tb < 2; ++tb) {
#pragma unroll
        for (int ks = 0; ks < 3; ++ks) { float f[8]; unpack8s(*(const bf16x8*)((proj + tok0 * PINP + C_GK + hh * 48) + ((32 * tb + r) * PINP + 16 * ks + 8 * h)), f);
#pragma unroll
            for (int j = 0; j < 8; ++j) f[j] *= __expf(bl[ks][j] - bc[tb][ks][j]);
            *(LAS bf16x8*)(ke + (32 * tb + r) * KE_RS + (16 * ks + 8 * h) * 2) = pack8f(f); }
        *(LAS v4u*)(ke + (32 * tb + r) * KE_RS + (48 + 8 * h) * 2) = (v4u){0u, 0u, 0u, 0u};
    }
    if (r == 0) { float* dec = (float*)(scratch + GLA_DEC_OFF) + (size_t)item * 48;
#pragma unroll
        for (int ks = 0; ks < 3; ++ks)
#pragma unroll
            for (int j = 0; j < 8; ++j) dec[16 * ks + 8 * h + j] = __expf(bl[ks][j]); }
    float* dS = (float*)(scratch + GLA_DS_OFF) + (size_t)item * 4608;
    const int rowoff = (8 * h + ((lane & 15) >> 2));
    const int coloff = (16 * ((lane >> 4) & 1) + 4 * (lane & 3)) * 2;
#pragma unroll 1
    for (int vb = 0; vb < 3; ++vb) {
        gla_stage_v(proj, tok0, hh, vb, vt, lane);
        f32x16 a0, a1;
#pragma unroll
        for (int i = 0; i < 16; ++i) { a0[i] = 0.f; a1[i] = 0.f; }
#pragma unroll
        for (int s = 0; s < 4; ++s) {
            const s16x4 vlo = tr_read(vt + (16 * s + rowoff) * VB_RS + coloff), vhi = tr_read(vt + (16 * s + rowoff + 4) * VB_RS + coloff);
            const bf16x8 vf = (bf16x8){vlo[0], vlo[1], vlo[2], vlo[3], vhi[0], vhi[1], vhi[2], vhi[3]};
            const s16x4 k0l = tr_read(ke + (16 * s + rowoff) * KE_RS + coloff), k0h = tr_read(ke + (16 * s + rowoff + 4) * KE_RS + coloff);
            const s16x4 k1l = tr_read(ke + (16 * s + rowoff) * KE_RS + 64 + coloff), k1h = tr_read(ke + (16 * s + rowoff + 4) * KE_RS + 64 + coloff);
            a0 = __builtin_amdgcn_mfma_f32_32x32x16_bf16(vf, (bf16x8){k0l[0], k0l[1], k0l[2], k0l[3], k0h[0], k0h[1], k0h[2], k0h[3]}, a0, 0, 0, 0);
            a1 = __builtin_amdgcn_mfma_f32_32x32x16_bf16(vf, (bf16x8){k1l[0], k1l[1], k1l[2], k1l[3], k1h[0], k1h[1], k1h[2], k1h[3]}, a1, 0, 0, 0);
        }
#pragma unroll
        for (int i = 0; i < 16; ++i) { const int v = 32 * vb + CROW(i) + 4 * h; dS[v * 48 + r] = a0[i]; if (r < 16) dS[v * 48 + 32 + r] = a1[i]; }
        asm volatile("" ::: "memory");
    }
}
__device__ __forceinline__ void gla_scan_item(unsigned char* scratch, int item, int lane) {
    const int rb = item & 7, bh = item >> 3, b = bh >> 2, hh = bh & 3;
    const float* dS = (const float*)(scratch + GLA_DS_OFF); const float* dec = (const float*)(scratch + GLA_DEC_OFF); bf16* sp = (bf16*)(scratch + GLA_SP_OFF);
    float S[9];
#pragma unroll
    for (int i = 0; i < 9; ++i) S[i] = 0.f;
#pragma unroll 2
    for (int n = 0; n < 32; ++n) { const size_t it = (size_t)(b * 32 + n) * 4 + hh;
#pragma unroll
        for (int i = 0; i < 9; ++i) { const int e = rb * 576 + lane + 64 * i, d = e % 48;
            sp[it * 4608 + e] = (bf16)f2bf(S[i]); S[i] = dec[it * 48 + d] * S[i] + dS[it * 4608 + e]; } }
}
template <int CB>
__device__ __forceinline__ void gla_b_half(const bf16* __restrict__ proj, const float* __restrict__ ng, const bf16* __restrict__ sp, bf16* __restrict__ obuf, const bf16x8 (&qf)[2][3], const bf16x8 (&kf)[2][3],
                                           size_t tok0, int hh, LAS unsigned char* wl, int lane) {
    const int r = lane & 31, h = lane >> 5;
    bf16x8 pb[CB + 1][2];
#pragma unroll
    for (int sb = 0; sb <= CB; ++sb) {
        f32x16 sc;
#pragma unroll
        for (int i = 0; i < 16; ++i) sc[i] = 0.f;
#pragma unroll
        for (int ks = 0; ks < 3; ++ks) sc = __builtin_amdgcn_mfma_f32_32x32x16_bf16(kf[sb][ks], qf[CB][ks], sc, 0, 0, 0);
        if (sb == CB) {
#pragma unroll
            for (int i = 0; i < 16; ++i) sc[i] = (CROW(i) + 4 * h <= r) ? sc[i] : 0.f;
        }
        pb[sb][0] = pack8(sc, 0); pb[sb][1] = pack8(sc, 8);
    }
    f32x16 o[3];
#pragma unroll
    for (int vb = 0; vb < 3; ++vb)
#pragma unroll
        for (int i = 0; i < 16; ++i) o[vb][i] = 0.f;
    LAS unsigned char* vt = wl + GLA_VB_OFF;
    const int rowoff = 4 * h + ((lane & 15) >> 2);
    const int coloff = (16 * ((lane >> 4) & 1) + 4 * (lane & 3)) * 2;
#pragma unroll
    for (int vb = 0; vb < 3; ++vb) {
        gla_stage_v(proj, tok0, hh, vb, vt, lane);
#pragma unroll
        for (int sb = 0; sb <= CB; ++sb)
#pragma unroll
            for (int st = 0; st < 2; ++st) {
                const s16x4 vlo = tr_read(vt + (32 * sb + 16 * st + rowoff) * VB_RS + coloff), vhi = tr_read(vt + (32 * sb + 16 * st + 8 + rowoff) * VB_RS + coloff);
                const bf16x8 vf = (bf16x8){vlo[0], vlo[1], vlo[2], vlo[3], vhi[0], vhi[1], vhi[2], vhi[3]};
                o[vb] = __builtin_amdgcn_mfma_f32_32x32x16_bf16(vf, pb[sb][st], o[vb], 0, 0, 0);
            }
#pragma unroll
        for (int ks = 0; ks < 3; ++ks) { const bf16x8 sf = *(const bf16x8*)(sp + (32 * vb + r) * 48 + 16 * ks + 8 * h);
            o[vb] = __builtin_amdgcn_mfma_f32_32x32x16_bf16(sf, qf[CB][ks], o[vb], 0, 0, 0); }
        asm volatile("" ::: "memory");
    }
    float ss = 0.f;
#pragma unroll
    for (int vb = 0; vb < 3; ++vb)
#pragma unroll
        for (int i = 0; i < 16; ++i) ss += o[vb][i] * o[vb][i];
    ss += xhalf(ss);
    const float rinv = 1.f / sqrtf(ss * (1.f / 96.f) + LN_EPS);
    const bf16* gu = proj + tok0 * PINP + C_GG + hh * 96; bf16* ou = obuf + tok0 * D + O_GLA + hh * 96; const int tl = 32 * CB + r;
#pragma unroll
    for (int vb = 0; vb < 3; ++vb)
#pragma unroll
        for (int g = 0; g < 4; ++g) { const int v0 = 32 * vb + 8 * g + 4 * h;
            const uint2 gg = *(const uint2*)(gu + (tl * PINP + v0)); const float4 nn = *(const float4*)(ng + v0);
            const float g0 = __uint_as_float(gg.x << 16), g1 = __uint_as_float(gg.x & 0xffff0000u), g2 = __uint_as_float(gg.y << 16), g3 = __uint_as_float(gg.y & 0xffff0000u);
            const float y0 = o[vb][4 * g] * rinv * nn.x * (g0 / (1.f + __expf(-g0))), y1 = o[vb][4 * g + 1] * rinv * nn.y * (g1 / (1.f + __expf(-g1)));
            const float y2 = o[vb][4 * g + 2] * rinv * nn.z * (g2 / (1.f + __expf(-g2))), y3 = o[vb][4 * g + 3] * rinv * nn.w * (g3 / (1.f + __expf(-g3)));
            uint2 a; a.x = cvtpk(y0, y1); a.y = cvtpk(y2, y3); *(uint2*)(ou + (tl * D + v0)) = a; }
}
__device__ __forceinline__ void gla_b_item(const bf16* __restrict__ proj, const float* __restrict__ w2, const float* __restrict__ gb, const float* __restrict__ ng, const unsigned char* scratch, bf16* __restrict__ obuf,
                                           int item, LAS unsigned char* wl, int lane) {
    const int hh = item & 3, bn = item >> 2; const size_t tok0 = (size_t)bn * 64;
    bf16x8 qf[2][3], kf[2][3];
    { float bc[2][3][8], bl[3][8];
      gla_bcum(proj, w2, gb, tok0, hh, lane, bc, bl);
      asm volatile("" : "+v"(lane)); const int r = lane & 31, h = lane >> 5;
#pragma unroll
      for (int tb = 0; tb < 2; ++tb)
#pragma unroll
          for (int ks = 0; ks < 3; ++ks) { float fq[8], fk[8];
              unpack8s(*(const bf16x8*)((proj + tok0 * PINP + C_GQ + hh * 48) + ((32 * tb + r) * PINP + 16 * ks + 8 * h)), fq);
              unpack8s(*(const bf16x8*)((proj + tok0 * PINP + C_GK + hh * 48) + ((32 * tb + r) * PINP + 16 * ks + 8 * h)), fk);
#pragma unroll
              for (int j = 0; j < 8; ++j) { const float e = __expf(bc[tb][ks][j]); fq[j] *= GLA_QSCALE * e; fk[j] *= __builtin_amdgcn_rcpf(e); }
              qf[tb][ks] = pack8f(fq); kf[tb][ks] = pack8f(fk); } }
    const bf16* sp = (const bf16*)(scratch + GLA_SP_OFF) + (size_t)item * 4608;
    asm volatile("" : "+v"(lane));
    gla_b_half<0>(proj, ng, sp, obuf, qf, kf, tok0, hh, wl, lane);
    asm volatile("" : "+v"(lane) :: "memory");
    gla_b_half<1>(proj, ng, sp, obuf, qf, kf, tok0, hh, wl, lane);
}
__device__ __forceinline__ void ph_gla_a(const Frame& F, const bf16* __restrict__ proj, const float* __restrict__ w2, const float* __restrict__ gb, unsigned char* scratch) {
    int lane = LANE_ID(); asm volatile("" : "+v"(lane));
    LAS unsigned char* wl = F.lds + F.wave * 16384;
    for (int it = F.gw; it < BATCH * 32 * 4; it += F.NGW) { asm volatile("" : "+v"(lane)); gla_a_item(proj, w2, gb, scratch, it, wl, lane); }
}
__device__ __forceinline__ void ph_gla_scan(const Frame& F, unsigned char* scratch, unsigned* done) {
    int lane = LANE_ID(); asm volatile("" : "+v"(lane));
    for (int it = F.gw; it < BATCH * 4 * 8; it += F.NGW) {
        gla_scan_item(scratch, it, lane);
        __threadfence();
        if (lane == 0) __hip_atomic_fetch_add(done, 1u, __ATOMIC_RELAXED, __HIP_MEMORY_SCOPE_AGENT);
    }
}
__device__ __forceinline__ void ph_gla_b(const Frame& F, const bf16* __restrict__ proj, const float* __restrict__ w2, const float* __restrict__ gb, const float* __restrict__ ng, const unsigned char* scratch,
                                         bf16* __restrict__ obuf, unsigned* done) {
    int lane = LANE_ID(); asm volatile("" : "+v"(lane));
    LAS unsigned char* wl = F.lds + F.wave * 16384;
    { unsigned spins = 0; while (__hip_atomic_load(done, __ATOMIC_RELAXED, __HIP_MEMORY_SCOPE_AGENT) < (unsigned)(BATCH * 4 * 8)) { __builtin_amdgcn_s_sleep(8); if (++spins > (1u << 22)) break; }
      __builtin_amdgcn_fence(__ATOMIC_ACQUIRE, "agent"); }
    for (int it = F.gw; it < BATCH * 32 * 4; it += F.NGW) { asm volatile("" : "+v"(lane)); gla_b_item(proj, w2, gb, ng, scratch, obuf, it, wl, lane); }
}


__device__ __forceinline__ void tr_item(const float* __restrict__ W, int K, int N, int Npad, bf16* __restrict__ WT, LAS float* scr, int item, int lane) {
    const int nblk = Npad / 32, kb = item / nblk, nb = item % nblk, k0 = 64 * kb, n0 = 32 * nb;
    const int n = n0 + (lane & 31);
#pragma unroll 8
    for (int i = 0; i < 32; ++i) { const int kk = 2 * i + (lane >> 5); scr[kk * 33 + (lane & 31)] = (n < N) ? W[(size_t)(k0 + kk) * N + n] : 0.f; }
    WAVE_SYNC();
    const int c = lane & 7;
#pragma unroll
    for (int j = 0; j < 4; ++j) { const int nn = (lane >> 3) + 8 * j; const LAS float* s = scr + (8 * c) * 33 + nn;
        v4u o; o.x = pk2(s[0 * 33], s[1 * 33]); o.y = pk2(s[2 * 33], s[3 * 33]); o.z = pk2(s[4 * 33], s[5 * 33]); o.w = pk2(s[6 * 33], s[7 * 33]);
        *(v4u*)(WT + (size_t)(n0 + nn) * K + k0 + 8 * c) = o; }
    WAVE_SYNC();
}
__device__ __forceinline__ void ln_row(const float* src, const float* __restrict__ g, const float* __restrict__ b, bf16* dstb, float* dstf, int lane) {
    const float4* xr = (const float4*)src + lane;
    float4 v[4]; float s = 0.f;
#pragma unroll
    for (int j = 0; j < 4; ++j) { v[j] = xr[64 * j]; s += (v[j].x + v[j].y) + (v[j].z + v[j].w); }
    const float mean = wave_sum(s) * (1.f / D); float s2 = 0.f;
#pragma unroll
    for (int j = 0; j < 4; ++j) { v[j].x -= mean; v[j].y -= mean; v[j].z -= mean; v[j].w -= mean; s2 += (v[j].x * v[j].x + v[j].y * v[j].y) + (v[j].z * v[j].z + v[j].w * v[j].w); }
    const float rstd = 1.f / sqrtf(wave_sum(s2) * (1.f / D) + LN_EPS);
#pragma unroll
    for (int j = 0; j < 4; ++j) {
        const float4 gg = ((const float4*)g)[lane + 64 * j], bb = ((const float4*)b)[lane + 64 * j];
        float4 y; y.x = v[j].x * rstd * gg.x + bb.x; y.y = v[j].y * rstd * gg.y + bb.y; y.z = v[j].z * rstd * gg.z + bb.z; y.w = v[j].w * rstd * gg.w + bb.w;
        uint2 o; o.x = pk2(y.x, y.y); o.y = pk2(y.z, y.w); ((uint2*)dstb)[lane + 64 * j] = o;
        if (dstf) ((float4*)dstf)[lane + 64 * j] = y;
    }
}
__device__ __forceinline__ void ph_ln(const Frame& F, const float* src, const float* g, const float* b, bf16* dstb, float* dstf) {
    int lane = LANE_ID(); asm volatile("" : "+v"(lane));
    for (int m = F.gw; m < M; m += F.NGW) ln_row(src + (size_t)m * D, g, b, dstb + (size_t)m * D, dstf ? dstf + (size_t)m * D : (float*)nullptr, lane);
}
__device__ __forceinline__ void ph_prologue(const Frame& F, const float* const* in, unsigned char* ws) {
    int lane_ = LANE_ID(); asm volatile("" : "+v"(lane_));
    LAS float* scr = (LAS float*)(F.lds + F.wave * 16384);
    for (int l = 0; l < DEPTH; ++l) {
        bf16* Wl = (bf16*)(ws + WS_W) + (size_t)l * LW_END;
        for (int it = F.gw; it < (D / 64) * (C_VH / 32); it += F.NGW) tr_item(in[4] + (size_t)l * D * PIN, D, PIN, C_VH, Wl + LW_IN, scr, it, lane_);
        for (int it = F.gw; it < 5 * (D / 8); it += F.NGW) fold_vh_item(in[4] + (size_t)l * D * PIN, in[8] + (size_t)l * 5 * 128 * 64, Wl + LW_IN, it, lane_);
        for (int i = F.gw * 64 + lane_; i < (PINP - C_VH - 320) * D / 8; i += F.NGW * 64) ((v4u*)(Wl + LW_IN + (size_t)(C_VH + 320) * D))[i] = (v4u){0u, 0u, 0u, 0u};
        for (int it = F.gw; it < (D / 64) * (D / 32); it += F.NGW) tr_item(in[9] + (size_t)l * D * D, D, D, D, Wl + LW_OUT, scr, it, lane_);
        for (int it = F.gw; it < (D / 64) * (D / 32); it += F.NGW) tr_item(in[12] + (size_t)l * D * D, D, D, D, Wl + LW_MQ, scr, it, lane_);
        for (int it = F.gw; it < (D / 64) * (2 * D / 32); it += F.NGW) tr_item(in[13] + (size_t)l * D * 2 * D, D, 2 * D, 2 * D, Wl + LW_MKV, scr, it, lane_);
        for (int it = F.gw; it < (D / 64) * (D / 32); it += F.NGW) tr_item(in[14] + (size_t)l * D * D, D, D, D, Wl + LW_MO, scr, it, lane_);
        for (int it = F.gw; it < (D / 64) * (FF / 32); it += F.NGW) tr_item(in[17] + (size_t)l * D * FF, D, FF, FF, Wl + LW_UP, scr, it, lane_);
        for (int it = F.gw; it < (FF / 64) * (D / 32); it += F.NGW) tr_item(in[19] + (size_t)l * FF * D, FF, D, D, Wl + LW_DN, scr, it, lane_);
    }
    { const float4* src = (const float4*)in[1]; uint2* dst = (uint2*)(ws + WS_MEMB);
      for (size_t i = (size_t)F.gw * 64 + lane_; i < (size_t)MKV * D / 4; i += (size_t)F.NGW * 64) { const float4 v = src[i]; uint2 o; o.x = pk2(v.x, v.y); o.y = pk2(v.z, v.w); dst[i] = o; } }
    ph_ln(F, in[0], in[2], in[3], (bf16*)(ws + WS_H), (float*)nullptr);
}
__device__ __forceinline__ void ph_gla_gate(const Frame& F, const bf16* __restrict__ proj, const float* __restrict__ w2, const float* __restrict__ gb, float* __restrict__ gl) {
    int lane = LANE_ID(); asm volatile("" : "+v"(lane));
    for (size_t idx = (size_t)F.gw * 64 + lane; idx < (size_t)M * 192; idx += (size_t)F.NGW * 64) {
        const int t = (int)(idx / 192), j = (int)(idx % 192);
        float acc = 0.f;
#pragma unroll
        for (int r = 0; r < 16; ++r) acc += bf2f(proj[(size_t)t * PINP + C_GLR + r]) * w2[r * 192 + j];
        acc += gb[j];
        const float ls = fminf(acc, 0.f) - log1pf(expf(-fabsf(acc)));
        gl[idx] = ls * (1.f / 16.f);
    }
}
__device__ __forceinline__ void ph_gla_rec(const Frame& F, const bf16* __restrict__ proj, const float* __restrict__ gl, float* __restrict__ oraw) {
    if ((int)blockIdx.x >= BATCH * 4) return;
    int tid = LANE_ID() + 64 * F.wave; asm volatile("" : "+v"(tid)); const int b = blockIdx.x >> 2, h = blockIdx.x & 3;
    LAS float* sq = (LAS float*)F.lds; LAS float* sk = sq + 32 * 48; LAS float* sa = sk + 32 * 48;
    float S[48];
#pragma unroll
    for (int d = 0; d < 48; ++d) S[d] = 0.f;
    for (int t0 = 0; t0 < SEQ; t0 += 32) {
        __syncthreads();
        for (int i = tid; i < 32 * 48; i += NWAVES * 64) { const int tt = i / 48, d = i % 48; const size_t row = (size_t)b * SEQ + t0 + tt;
            sq[i] = bf2f(proj[row * PINP + C_GQ + h * 48 + d]) * GLA_QSCALE; sk[i] = bf2f(proj[row * PINP + C_GK + h * 48 + d]); sa[i] = expf(gl[row * 192 + h * 48 + d]); }
        __syncthreads();
        if (tid < 96) {
            for (int tt = 0; tt < 32; ++tt) { const size_t row = (size_t)b * SEQ + t0 + tt; const float v = bf2f(proj[row * PINP + C_GV + h * 96 + tid]); float o = 0.f;
#pragma unroll
                for (int d = 0; d < 48; ++d) { S[d] = sa[tt * 48 + d] * S[d] + sk[tt * 48 + d] * v; o += sq[tt * 48 + d] * S[d]; }
                oraw[row * 384 + h * 96 + tid] = o; }
        }
    }
    __syncthreads();
}
__device__ __forceinline__ void ph_gla_fin(const Frame& F, const bf16* __restrict__ proj, const float* __restrict__ oraw, const float* __restrict__ ng, bf16* __restrict__ obuf) {
    int lane = LANE_ID(); asm volatile("" : "+v"(lane));
    for (int gw = F.gw; gw < M * 4; gw += F.NGW) {
        const int t = gw >> 2, h = gw & 3;
        const float o0 = oraw[(size_t)t * 384 + h * 96 + lane], o1 = lane < 32 ? oraw[(size_t)t * 384 + h * 96 + 64 + lane] : 0.f;
        const float ss = wave_sum(o0 * o0 + o1 * o1);
        const float r = 1.f / sqrtf(ss * (1.f / 96.f) + LN_EPS);
        { const float g = bf2f(proj[(size_t)t * PINP + C_GG + h * 96 + lane]); const float y = o0 * r * ng[lane] * (g / (1.f + expf(-g))); obuf[(size_t)t * D + O_GLA + h * 96 + lane] = (bf16)f2bf(y); }
        if (lane < 32) { const float g = bf2f(proj[(size_t)t * PINP + C_GG + h * 96 + 64 + lane]); const float y = o1 * r * ng[64 + lane] * (g / (1.f + expf(-g))); obuf[(size_t)t * D + O_GLA + h * 96 + 64 + lane] = (bf16)f2bf(y); }
    }
}
__device__ __forceinline__ void ph_sb(const Frame& F, const bf16* __restrict__ proj, bf16* __restrict__ obuf) {
    int lane = LANE_ID(); asm volatile("" : "+v"(lane));
    for (int gw = F.gw; gw < M * 5; gw += F.NGW) {
        const int tok = gw / 5, hd = gw % 5, b = tok / SEQ, t = tok % SEQ;
        float q[64];
        { const uint4* qr = (const uint4*)(proj + (size_t)tok * PINP + C_SQ + hd * 64);
#pragma unroll
          for (int i = 0; i < 8; ++i) { float f[8]; unpack8(qr[i], f);
#pragma unroll
              for (int e = 0; e < 8; ++e) q[8 * i + e] = f[e] * 0.125f; } }
        float o = 0.f, carry = 0.f;
        for (int base = t - 1; base >= 0; base -= 64) {
            const int s = base - lane; const bool valid = s >= 0;
            float z = 0.f;
            if (valid) { const uint4* kr = (const uint4*)(proj + ((size_t)b * SEQ + s) * PINP + C_SK + hd * 64);
#pragma unroll
                for (int i = 0; i < 8; ++i) { float f[8]; unpack8(kr[i], f);
#pragma unroll
                    for (int e = 0; e < 8; ++e) z += q[8 * i + e] * f[e]; } }
            const float sp = fmaxf(z, 0.f) + log1pf(expf(-fabsf(z)));
            const float l = valid ? -sp : 0.f;
            float inc = l;
#pragma unroll
            for (int off = 1; off < 64; off <<= 1) { const float y = __shfl_up(inc, off); if (lane >= off) inc += y; }
            const float w = valid ? expf((z - sp) + (inc - l) + carry) : 0.f;
            const float tot = __shfl(inc, 63);
            const int nv = (base + 1 < 64) ? base + 1 : 64;
            for (int i = 0; i < nv; ++i) { const float wi = __shfl(w, i); o += wi * bf2f(proj[((size_t)b * SEQ + (base - i)) * PINP + C_SV + hd * 64 + lane]); }
            carry += tot;
            if (carry < -104.f) break;
        }
        obuf[(size_t)tok * D + O_SB + hd * 64 + lane] = (bf16)f2bf(o);
    }
}
__device__ __forceinline__ void ph_dsa(const Frame& F, const bf16* __restrict__ proj, const float* __restrict__ wuv, bf16* __restrict__ obuf) {
    int lane = LANE_ID(); asm volatile("" : "+v"(lane));
    LAS unsigned char* wl = F.lds + F.wave * 12544;
    LAS unsigned* s_key = (LAS unsigned*)wl;
    LAS float* s_p = (LAS float*)wl;
    LAS float* s_ol = (LAS float*)(wl + 5120);
    LAS float* s_iq = (LAS float*)(wl + 8192);
    LAS float* s_q = (LAS float*)(wl + 10240);
    LAS int* s_idx = (LAS int*)(wl + 11520);
    const unsigned long long lt_mask = (lane == 0) ? 0ull : (~0ull >> (64 - lane));
    for (int tok = F.gw; tok < M; tok += F.NGW) {
        const int b = tok / SEQ, t = tok % SEQ;
        const bf16* prow = proj + (size_t)tok * PINP;
        WAVE_SYNC();
        for (int i = lane; i < 512; i += 64) s_iq[i] = bf2f(prow[C_IQ + i]);
        for (int i = lane; i < 320; i += 64) s_q[i] = bf2f(prow[C_DQ + i]);
        float iw[8];
#pragma unroll
        for (int h = 0; h < 8; ++h) iw[h] = bf2f(prow[C_IW + h]);
        WAVE_SYNC();
        for (int j = 0; j < 32; ++j) {
            const int s = lane + 64 * j; unsigned kk = 0u;
            if (s <= t) {
                const uint4* kr = (const uint4*)(proj + ((size_t)b * SEQ + s) * PINP + C_IK);
                float dot[8];
#pragma unroll
                for (int h = 0; h < 8; ++h) dot[h] = 0.f;
#pragma unroll 1
                for (int i = 0; i < 8; ++i) { float f[8]; unpack8(kr[i], f);
#pragma unroll
                    for (int h = 0; h < 8; ++h)
#pragma unroll
                        for (int e = 0; e < 8; ++e) dot[h] += s_iq[h * 64 + 8 * i + e] * f[e]; }
                float isc = 0.f;
#pragma unroll
                for (int h = 0; h < 8; ++h) isc += fmaxf(dot[h], 0.f) * iw[h];
                isc *= IDX_SCALE;
                const unsigned u = __float_as_uint(isc); kk = (u & 0x80000000u) ? ~u : (u | 0x80000000u);
            }
            s_key[s] = kk;
        }
        WAVE_SYNC();
        int nsel;
        if (t + 1 <= 256) {
            nsel = t + 1;
            for (int i = lane; i < nsel; i += 64) s_idx[i] = i;
        } else {
            unsigned prefix = 0u;
            for (int bit = 31; bit >= 0; --bit) {
                const unsigned cand = prefix | (1u << bit); int c = 0;
                for (int j = 0; j < 32; ++j) c += (s_key[lane + 64 * j] >= cand) ? 1 : 0;
                c = wave_sum_i(c);
                if (c >= 256) prefix = cand;
            }
            int cg = 0;
            for (int j = 0; j < 32; ++j) cg += (s_key[lane + 64 * j] > prefix) ? 1 : 0;
            cg = wave_sum_i(cg);
            const int need = 256 - cg;
            int base_sel = 0, base_tie = 0;
            for (int j = 0; j < 32; ++j) {
                const unsigned k = s_key[lane + 64 * j]; const bool gt = k > prefix, eq = (k == prefix);
                const unsigned long long beq = __ballot(eq); const int tie_rank = base_tie + __popcll(beq & lt_mask);
                const bool sel = gt || (eq && tie_rank < need);
                const unsigned long long bs = __ballot(sel); const int pos = base_sel + __popcll(bs & lt_mask);
                if (sel) s_idx[pos] = lane + 64 * j;
                base_sel += __popcll(bs); base_tie += __popcll(beq);
            }
            nsel = 256;
        }
        WAVE_SYNC();
        const float slope[5] = {0.32987697769322355f, 0.1088188204120155f, 0.03589682359365735f, 0.011841535675862483f, 0.00390625f};
#pragma unroll 1
        for (int m = 0; m < 4; ++m) {
            const int kidx = lane + 64 * m;
            float dot[5];
#pragma unroll
            for (int h = 0; h < 5; ++h) dot[h] = -INFINITY;
            if (kidx < nsel) {
                const int si = s_idx[kidx];
                const uint4* kr = (const uint4*)(proj + ((size_t)b * SEQ + si) * PINP + C_DK);
#pragma unroll
                for (int h = 0; h < 5; ++h) dot[h] = 0.f;
#pragma unroll 1
                for (int i = 0; i < 8; ++i) { float f[8]; unpack8(kr[i], f);
#pragma unroll
                    for (int h = 0; h < 5; ++h)
#pragma unroll
                        for (int e = 0; e < 8; ++e) dot[h] += s_q[h * 64 + 8 * i + e] * f[e]; }
#pragma unroll
                for (int h = 0; h < 5; ++h) dot[h] = dot[h] * 0.125f - slope[h] * (float)(t - si);
            }
#pragma unroll
            for (int h = 0; h < 5; ++h) s_p[h * 256 + kidx] = dot[h];
        }
        WAVE_SYNC();
#pragma unroll 1
        for (int h = 0; h < 5; ++h) {
            float sc[4];
#pragma unroll
            for (int m = 0; m < 4; ++m) sc[m] = s_p[h * 256 + lane + 64 * m];
            const float mx = wave_max(fmaxf(fmaxf(sc[0], sc[1]), fmaxf(sc[2], sc[3])));
            float e[4], se = 0.f;
#pragma unroll
            for (int m = 0; m < 4; ++m) { e[m] = (lane + 64 * m < nsel) ? expf(sc[m] - mx) : 0.f; se += e[m]; }
            const float inv = 1.f / wave_sum(se);
#pragma unroll
            for (int m = 0; m < 4; ++m) s_p[h * 256 + lane + 64 * m] = e[m] * inv;
        }
        WAVE_SYNC();
        float a0[5], a1[5];
#pragma unroll
        for (int h = 0; h < 5; ++h) { a0[h] = 0.f; a1[h] = 0.f; }
        for (int k = 0; k < nsel; ++k) {
            const int si = s_idx[k]; const bf16* vr = proj + ((size_t)b * SEQ + si) * PINP + C_DV;
            const float v0 = bf2f(vr[lane]), v1 = bf2f(vr[lane + 64]);
#pragma unroll
            for (int h = 0; h < 5; ++h) { const float p = s_p[h * 256 + k]; a0[h] += p * v0; a1[h] += p * v1; }
        }
        WAVE_SYNC();
#pragma unroll
        for (int h = 0; h < 5; ++h) { s_ol[h * 128 + lane] = a0[h]; s_ol[h * 128 + lane + 64] = a1[h]; }
        WAVE_SYNC();
#pragma unroll
        for (int h = 0; h < 5; ++h) { float o = 0.f;
            for (int c = 0; c < 128; ++c) o += s_ol[h * 128 + c] * wuv[(h * 128 + c) * 64 + lane];
            obuf[(size_t)tok * D + O_DSA + h * 64 + lane] = (bf16)f2bf(o); }
    }
}
__device__ __forceinline__ void ph_memattn(const Frame& F, const bf16* __restrict__ qmem, const bf16* __restrict__ kv, bf16* __restrict__ obuf) {
    int lane = LANE_ID(); asm volatile("" : "+v"(lane));
    LAS float* s_q = (LAS float*)(F.lds + F.wave * 2048); LAS float* s_p = s_q + 256;
    for (int gw = F.gw; gw < M * 4; gw += F.NGW) {
        const int tok = gw >> 2, hd = gw & 3, b = tok / SEQ;
        WAVE_SYNC();
#pragma unroll
        for (int i = 0; i < 4; ++i) s_q[lane + 64 * i] = bf2f(qmem[(size_t)tok * D + hd * 256 + lane + 64 * i]);
        WAVE_SYNC();
        float sc[4];
#pragma unroll
        for (int j = 0; j < 4; ++j) { const int m = lane + 64 * j; const uint4* kr = (const uint4*)(kv + ((size_t)b * MEMT + m) * 2048 + hd * 256); float dot = 0.f;
            for (int i = 0; i < 32; ++i) { float f[8]; unpack8(kr[i], f);
#pragma unroll
                for (int e = 0; e < 8; ++e) dot += s_q[8 * i + e] * f[e]; }
            sc[j] = dot * 0.0625f; }
        const float mx = wave_max(fmaxf(fmaxf(sc[0], sc[1]), fmaxf(sc[2], sc[3])));
        float e[4], se = 0.f;
#pragma unroll
        for (int j = 0; j < 4; ++j) { e[j] = expf(sc[j] - mx); se += e[j]; }
        const float inv = 1.f / wave_sum(se);
#pragma unroll
        for (int j = 0; j < 4; ++j) s_p[lane + 64 * j] = e[j] * inv;
        WAVE_SYNC();
        float o[4] = {0.f, 0.f, 0.f, 0.f};
        for (int m = 0; m < MEMT; ++m) { const float p = s_p[m]; const bf16* vr = kv + ((size_t)b * MEMT + m) * 2048 + 1024 + hd * 256;
#pragma unroll
            for (int i = 0; i < 4; ++i) o[i] += p * bf2f(vr[lane + 64 * i]); }
#pragma unroll
        for (int i = 0; i < 4; ++i) obuf[(size_t)tok * D + hd * 256 + lane + 64 * i] = (bf16)f2bf(o[i]);
    }
}

struct Args { const float* in[23]; float* out; unsigned char* ws; int ph_lo, ph_hi; };
static_assert(sizeof(Args) == 23 * 8 + 8 + 8 + 8, "Args has no padding");
namespace cg = cooperative_groups;

constexpr int PH_PRO = 0, PH_KV = 1, PH_L0 = 2, PH_PER_LAYER = 12, PH_END = PH_L0 + DEPTH * PH_PER_LAYER;

#define GEMM_PHASE(EPI, Aptr, Bptr, MM, NN, KK, ...) do { pg8::Gemm g{Aptr, Bptr, MM, NN, KK}; pg8::StaticOrder S; S.init(MM, NN, G, (int)blockIdx.x); \
    EPI E{__VA_ARGS__}; pg8::gemm_phase<EPI, pg8::StaticOrder, true, true>(L + RING_OFF, g, S, E, F.wave); } while (0)

__global__ void __launch_bounds__(NWAVES * 64, 2) mk_fwd(Args args) {
    extern __shared__ __attribute__((aligned(16))) unsigned char lds[];
    LAS unsigned char* L = (LAS unsigned char*)lds;
    cg::grid_group grid = cg::this_grid();
    unsigned char* ws = args.ws;
    const int G = gridDim.x;
    Frame F; F.lds = L; F.wave = __builtin_amdgcn_readfirstlane((int)threadIdx.x >> 6); F.G = G; F.gw = (int)blockIdx.x * NWAVES + F.wave; F.NGW = G * NWAVES;
    bf16* Hb = (bf16*)(ws + WS_H); bf16* PROJ = (bf16*)(ws + WS_PROJ); bf16* OBUF = (bf16*)(ws + WS_OBUF); bf16* QMEM = (bf16*)(ws + WS_QMEM); bf16* UBUF = (bf16*)(ws + WS_UBUF);
    unsigned* MASK = (unsigned*)(ws + WS_MASK); bf16* MEMB = (bf16*)(ws + WS_MEMB); bf16* KVM = (bf16*)(ws + WS_KVMEM);
    const int lo = args.ph_lo, hi = args.ph_hi;
#define IN(k) (lo <= (k) && (k) < hi)
#define SEAM(k) do { if (IN(k) && IN((k) + 1)) grid.sync(); } while (0)
    if (IN(PH_PRO)) { ph_prologue(F, args.in, ws); __syncthreads(); }
    SEAM(PH_PRO);
    if (IN(PH_KV)) {
#pragma unroll 1
        for (int l = 0; l < DEPTH; ++l) { const bf16* Wl = (const bf16*)(ws + WS_W) + (size_t)l * LW_END;
            GEMM_PHASE(pg8::EpiBf16<0>, MEMB, Wl + LW_MKV, MKV, 2 * D, D, KVM + (size_t)l * MKV * 2 * D, 2 * D, nullptr, 0, 0, 1.f); }
    }
    SEAM(PH_KV);
#pragma unroll 1
    for (int l = 0; l < DEPTH; ++l) {
        const int p0 = PH_L0 + l * PH_PER_LAYER; const bf16* Wl = (const bf16*)(ws + WS_W) + (size_t)l * LW_END;
        if (IN(p0 + 0)) GEMM_PHASE(pg8::EpiBf16<0>, Hb, Wl + LW_IN, M, PINP, D, PROJ, PINP, nullptr, 0, 0, 1.f);
        SEAM(p0 + 0);
        if (IN(p0 + 1)) { ph_gla_a(F, PROJ, args.in[5] + (size_t)l * 16 * 192, args.in[6] + (size_t)l * 192, (unsigned char*)args.out); __syncthreads();
                          ph_idx(F, PROJ, MASK); __syncthreads(); }
        SEAM(p0 + 1);
        if (IN(p0 + 2)) { unsigned* qc = (unsigned*)(ws + WS_CTL) + CW_Q + 64 * (l * 4);
                          ph_gla_scan(F, (unsigned char*)args.out, qc + 128);
                          ph_dsa_att(F, PROJ, MASK, OBUF, qc); ph_sb_att(F, PROJ, OBUF, qc + 64);
                          ph_gla_b(F, PROJ, args.in[5] + (size_t)l * 16 * 192, args.in[6] + (size_t)l * 192, args.in[7] + (size_t)l * 96, (const unsigned char*)args.out, OBUF, qc + 128); __syncthreads(); }
        SEAM(p0 + 2);
        if (IN(p0 + 3)) GEMM_PHASE(pg8::EpiY, OBUF, Wl + LW_OUT, M, D, D, args.out, Hb, D, nullptr, ALPHA);
        SEAM(p0 + 3);
        if (IN(p0 + 4)) ph_ln(F, args.out, args.in[10] + (size_t)l * D, args.in[11] + (size_t)l * D, Hb, (float*)nullptr);
        SEAM(p0 + 4);
        if (IN(p0 + 5)) GEMM_PHASE(pg8::EpiBf16<0>, Hb, Wl + LW_MQ, M, D, D, QMEM, D, nullptr, 0, 0, 1.f);
        SEAM(p0 + 5);
        if (IN(p0 + 6)) { ph_mem_att(F, QMEM, KVM + (size_t)l * MKV * 2 * D, OBUF); __syncthreads(); }
        SEAM(p0 + 6);
        if (IN(p0 + 7)) GEMM_PHASE(pg8::EpiY, OBUF, Wl + LW_MO, M, D, D, args.out, Hb, D, nullptr, ALPHA);
        SEAM(p0 + 7);
        if (IN(p0 + 8)) ph_ln(F, args.out, args.in[15] + (size_t)l * D, args.in[16] + (size_t)l * D, Hb, (float*)nullptr);
        SEAM(p0 + 8);
        if (IN(p0 + 9)) GEMM_PHASE(pg8::EpiBf16<2>, Hb, Wl + LW_UP, M, FF, D, UBUF, FF, args.in[18] + (size_t)l * FF, 0, 0, 1.f);
        SEAM(p0 + 9);
        if (IN(p0 + 10)) GEMM_PHASE(pg8::EpiY, UBUF, Wl + LW_DN, M, D, FF, args.out, Hb, D, args.in[20] + (size_t)l * D, ALPHA);
        SEAM(p0 + 10);
        if (IN(p0 + 11)) ph_ln(F, args.out, args.in[21] + (size_t)l * D, args.in[22] + (size_t)l * D, Hb, (l == DEPTH - 1) ? args.out : (float*)nullptr);
        SEAM(p0 + 11);
    }
#undef IN
#undef SEAM
}

#ifndef MK_SPLIT
#define MK_SPLIT 0
#endif
extern "C" void kernel_launch(void* const* d_in, const int* in_sizes, int n_in, void* d_out, int out_size, void* d_ws, size_t ws_size, hipStream_t stream) {
    static int grid = 0;
    if (grid == 0) {
        if (n_in != 23 || in_sizes[0] != M * D || out_size != M * D || ws_size < WS_END) { fprintf(stderr, "kernel_launch: unexpected shapes (n_in %d, in0 %d, out %d, ws %zu)\n", n_in, n_in > 0 ? in_sizes[0] : -1, out_size, ws_size); grid = -1; return; }
        int dev = 0, cus = 0, per_cu = 0;
        if (hipGetDevice(&dev) != hipSuccess || hipDeviceGetAttribute(&cus, hipDeviceAttributeMultiprocessorCount, dev) != hipSuccess) { grid = -1; return; }
        if (hipFuncSetAttribute((const void*)mk_fwd, hipFuncAttributeMaxDynamicSharedMemorySize, LDS_BYTES) != hipSuccess) { fprintf(stderr, "kernel_launch: hipFuncSetAttribute failed\n"); grid = -1; return; }
        if (hipOccupancyMaxActiveBlocksPerMultiprocessor(&per_cu, (const void*)mk_fwd, NWAVES * 64, LDS_BYTES) != hipSuccess || per_cu < 1) { fprintf(stderr, "kernel_launch: occupancy query says %d blocks per CU\n", per_cu); grid = -1; return; }
        grid = cus;
    }
    if (grid < 0) return;
    Args a{}; for (int i = 0; i < 23; ++i) a.in[i] = (const float*)d_in[i]; a.out = (float*)d_out; a.ws = (unsigned char*)d_ws;
    if (hipMemsetAsync((unsigned char*)d_ws + WS_CTL, 0, CTL_ZERO_BYTES, stream) != hipSuccess) return;
#if MK_SPLIT
    for (int p = 0; p < PH_END; ++p) { a.ph_lo = p; a.ph_hi = p + 1; hipLaunchKernelGGL(mk_fwd, dim3(grid), dim3(NWAVES * 64), LDS_BYTES, stream, a); }
#else
    a.ph_lo = 0; a.ph_hi = PH_END;
    void* kargs[] = {&a};
    const hipError_t e = hipLaunchCooperativeKernel((const void*)mk_fwd, dim3(grid), dim3(NWAVES * 64), kargs, LDS_BYTES, stream);
    if (e != hipSuccess) fprintf(stderr, "kernel_launch: cooperative launch failed: %s (grid %d)\n", hipGetErrorString(e), grid);
#endif
}
```
